# Optimizing an MI355X kernel written in HIP

```python
import math
import jax, jax.numpy as jnp
from jax import lax
import numpy as np


D_MODEL = 1024
BATCH = 32
SEQ = 256
DEPTH = 2
DEC_BATCH = 8
DEC_SEQ = 2048
PAST_LEN = 512

GRID_W = 64
HEAD_DIM = 64
A_HEADS = 8
A_KV_HEADS = 2
B_GROUPS = 4
B_GROUP_DIM = 128
B_WIDTH = B_GROUPS * B_GROUP_DIM
CHUNK = 128
C_HEADS = 16
C_KV_HEADS = 4
WINDOW = 128
Q_BLOCK = 128
FFN_DIM = 2816
CONV_W = 3
ROPE_THETA = 10000.0
EPS = 1e-6
NEG = -1e30
N_EVEN = (DEPTH + 1) // 2
N_ODD = DEPTH // 2
A_Q_W = A_HEADS * HEAD_DIM
A_KV_W = A_KV_HEADS * HEAD_DIM
EVEN_IN = A_Q_W + 2 * A_KV_W + 2 * B_WIDTH
EVEN_SPLITS = (A_Q_W, A_Q_W + A_KV_W, A_Q_W + 2 * A_KV_W, A_Q_W + 2 * A_KV_W + B_WIDTH)
EVEN_MIX = A_Q_W + B_WIDTH
C_Q_W = C_HEADS * HEAD_DIM
C_KV_W = C_KV_HEADS * HEAD_DIM
ODD_IN = C_Q_W + 2 * C_KV_W
ODD_SPLITS = (C_Q_W, C_Q_W + C_KV_W)
ODD_MIX = C_Q_W

kernel_name = "hybrid_flow_prefix_trunk_step"


def rms_norm(x, gain=None):
    xf = x.astype(jnp.float32)
    y = xf * lax.rsqrt(jnp.mean(xf * xf, axis=-1, keepdims=True) + EPS)
    if gain is not None:
        y = y * gain.astype(jnp.float32)
    return y.astype(x.dtype)


def modulation(cond, w_mod, b_mod):
    m = jax.nn.silu(cond) @ w_mod + b_mod
    return jnp.split(m[:, None, :], 6, axis=-1)


def adaln(x, shift, scale):
    return rms_norm(x) * (1 + scale) + shift


def axial_rope(n_tokens):
    n_rows = n_tokens // GRID_W
    rows = jnp.repeat(jnp.arange(n_rows), GRID_W).astype(jnp.float32)
    cols = jnp.tile(jnp.arange(GRID_W), n_rows).astype(jnp.float32)
    n_freq = HEAD_DIM // 4
    inv = ROPE_THETA ** (-jnp.arange(n_freq, dtype=jnp.float32) / n_freq)
    ang = jnp.concatenate([rows[:, None] * inv, cols[:, None] * inv], axis=-1)
    return jnp.cos(ang), jnp.sin(ang)


def apply_rope(x, cos, sin):
    xf = x.astype(jnp.float32).reshape(x.shape[:-1] + (HEAD_DIM // 2, 2))
    x0, x1 = xf[..., 0], xf[..., 1]
    cc = cos[None, :, None, :]
    ss = sin[None, :, None, :]
    out = jnp.stack([x0 * cc - x1 * ss, x0 * ss + x1 * cc], axis=-1)
    return out.reshape(x.shape).astype(x.dtype)


def attend(q, k, v, mask=None, sink=None):
    s = jnp.einsum('bqhgd,bkhd->bhgqk', q, k, preferred_element_type=jnp.float32) * (HEAD_DIM ** -0.5)
    if mask is not None:
        s = jnp.where(mask, s, NEG)
    if sink is not None:
        sk = jnp.broadcast_to(sink.astype(jnp.float32)[None, :, :, None, None], s.shape[:-1] + (1,))
        p = jax.nn.softmax(jnp.concatenate([s, sk], axis=-1), axis=-1)[..., :-1]
    else:
        p = jax.nn.softmax(s, axis=-1)
    return jnp.einsum('bhgqk,bkhd->bqhgd', p.astype(v.dtype), v)


def dense_block_attention(q, k, v, sink=None):
    b, t, hq, dh = q.shape
    hkv = k.shape[2]
    g = hq // hkv
    qb = q.reshape(b, t // Q_BLOCK, Q_BLOCK, hkv, g, dh).transpose(1, 0, 2, 3, 4, 5)
    out = lax.map(lambda qi: attend(qi, k, v, None, sink), qb)
    return out.transpose(1, 0, 2, 3, 4, 5).reshape(b, t, hq * dh)


def window_attention_with_context(q, k, v, k_ctx, v_ctx, sink):
    b, t, hq, dh = q.shape
    hkv = k.shape[2]
    g = hq // hkv
    nb = t // Q_BLOCK
    span = Q_BLOCK + 2 * WINDOW
    n_ctx = k_ctx.shape[1]
    pad = ((0, 0), (WINDOW, WINDOW), (0, 0), (0, 0))
    kp = jnp.pad(k, pad)
    vp = jnp.pad(v, pad)
    qb = q.reshape(b, nb, Q_BLOCK, hkv, g, dh).transpose(1, 0, 2, 3, 4, 5)
    ctx_mask = jnp.ones((Q_BLOCK, n_ctx), dtype=bool)

    def one_block(args):
        qi, bi = args
        start = bi * Q_BLOCK
        kw = lax.dynamic_slice_in_dim(kp, start, span, axis=1)
        vw = lax.dynamic_slice_in_dim(vp, start, span, axis=1)
        qpos = start + jnp.arange(Q_BLOCK)
        kpos = start - WINDOW + jnp.arange(span)
        local = (jnp.abs(kpos[None, :] - qpos[:, None]) <= WINDOW) & (kpos[None, :] >= 0) & (kpos[None, :] < t)
        mask = jnp.concatenate([local, ctx_mask], axis=1)
        return attend(qi, jnp.concatenate([kw, k_ctx], axis=1), jnp.concatenate([vw, v_ctx], axis=1), mask, sink)

    out = lax.map(one_block, (qb, jnp.arange(nb)))
    return out.transpose(1, 0, 2, 3, 4, 5).reshape(b, t, hq * dh)


def chunk_spatial_gate(u, v, v_gain, w_s, b_s):
    b, t, _ = u.shape
    vn = rms_norm(v, v_gain).reshape(b, t // CHUNK, CHUNK, B_GROUPS, B_GROUP_DIM)
    mixed = jnp.einsum('gpq,bnqgc->bnpgc', w_s, vn) + b_s.T[None, None, :, :, None]
    return u * mixed.reshape(b, t, B_WIDTH)


def even_mixer(h, w_in, q_gain, k_gain, v_gain, w_s, b_s, w_out, rope=None, ctx_kv=None):
    b, t, _ = h.shape
    z = h @ w_in
    q, k, v, u_b, v_b = jnp.split(z, EVEN_SPLITS, axis=-1)
    q = rms_norm(q.reshape(b, t, A_HEADS, HEAD_DIM), q_gain)
    k = rms_norm(k.reshape(b, t, A_KV_HEADS, HEAD_DIM), k_gain)
    v = v.reshape(b, t, A_KV_HEADS, HEAD_DIM)
    if rope is not None:
        q = apply_rope(q, rope[0], rope[1])
        k_rot = apply_rope(k, rope[0], rope[1])
    else:
        k_rot = k
    if ctx_kv is not None:
        k_all = jnp.concatenate([k_rot, ctx_kv[0]], axis=1)
        v_all = jnp.concatenate([v, ctx_kv[1]], axis=1)
    else:
        k_all, v_all = k_rot, v
    attn = dense_block_attention(q, k_all, v_all)
    gate = chunk_spatial_gate(jax.nn.gelu(u_b), jax.nn.gelu(v_b), v_gain, w_s, b_s)
    return jnp.concatenate([attn, gate], axis=-1) @ w_out, k, v


def odd_mixer(h, w_in, q_gain, k_gain, sink, w_out, rope=None, ctx_kv=None):
    b, t, _ = h.shape
    z = h @ w_in
    q, k, v = jnp.split(z, ODD_SPLITS, axis=-1)
    q = rms_norm(q.reshape(b, t, C_HEADS, HEAD_DIM), q_gain)
    k = rms_norm(k.reshape(b, t, C_KV_HEADS, HEAD_DIM), k_gain)
    v = v.reshape(b, t, C_KV_HEADS, HEAD_DIM)
    sink_g = sink.reshape(C_KV_HEADS, C_HEADS // C_KV_HEADS)
    if ctx_kv is None:
        attn = dense_block_attention(q, k, v, sink_g)
    else:
        q = apply_rope(q, rope[0], rope[1])
        k_rot = apply_rope(k, rope[0], rope[1])
        attn = window_attention_with_context(q, k_rot, v, ctx_kv[0], ctx_kv[1], sink_g)
    return attn @ w_out, k, v


def conv_ffn(h, w_up, conv_w, conv_b, w_down):
    t = h.shape[1]
    z = h @ w_up
    half = CONV_W // 2
    zp = jnp.pad(z, ((0, 0), (half, half), (0, 0)))
    zc = conv_b + sum(zp[:, i:i + t] * conv_w[i] for i in range(CONV_W))
    a, g = jnp.split(zc, 2, axis=-1)
    return (a * jax.nn.silu(g)) @ w_down


def setup_inputs(seed: int = 0) -> dict:
    key = jax.random.key(seed)
    ks = jax.random.split(key, 32)
    f32 = jnp.float32
    nrm = lambda k, s, sc: jax.random.normal(k, s, f32) * sc
    return {
        "x_prompt": nrm(ks[0], (BATCH, SEQ, D_MODEL), 1.0),
        "x_sample": nrm(ks[1], (DEC_BATCH, DEC_SEQ, D_MODEL), 1.0),
        "cache_k_attn": nrm(ks[2], (DEC_BATCH, N_EVEN, PAST_LEN, A_KV_HEADS, HEAD_DIM), 1.0),
        "cache_v_attn": nrm(ks[3], (DEC_BATCH, N_EVEN, PAST_LEN, A_KV_HEADS, HEAD_DIM), 1.0),
        "cache_k_swa": nrm(ks[4], (DEC_BATCH, N_ODD, PAST_LEN, C_KV_HEADS, HEAD_DIM), 1.0),
        "cache_v_swa": nrm(ks[5], (DEC_BATCH, N_ODD, PAST_LEN, C_KV_HEADS, HEAD_DIM), 1.0),
        "c": nrm(ks[6], (DEC_BATCH, D_MODEL), 1.0),
        "c_ctx": nrm(ks[7], (D_MODEL,), 1.0),
        "w_mod": nrm(ks[8], (DEPTH, D_MODEL, 6 * D_MODEL), 0.5 * D_MODEL ** -0.5),
        "b_mod": nrm(ks[9], (DEPTH, 6 * D_MODEL), 0.02),
        "w_in_even": nrm(ks[10], (N_EVEN, D_MODEL, EVEN_IN), D_MODEL ** -0.5),
        "q_norm_a": 1.0 + nrm(ks[11], (N_EVEN, HEAD_DIM), 0.02),
        "k_norm_a": 1.0 + nrm(ks[12], (N_EVEN, HEAD_DIM), 0.02),
        "v_norm_b": 1.0 + nrm(ks[13], (N_EVEN, B_WIDTH), 0.02),
        "w_spatial": nrm(ks[14], (N_EVEN, B_GROUPS, CHUNK, CHUNK), CHUNK ** -0.5),
        "b_spatial": 1.0 + nrm(ks[15], (N_EVEN, B_GROUPS, CHUNK), 0.02),
        "w_out_even": nrm(ks[16], (N_EVEN, EVEN_MIX, D_MODEL), EVEN_MIX ** -0.5),
        "w_in_odd": nrm(ks[17], (N_ODD, D_MODEL, ODD_IN), D_MODEL ** -0.5),
        "q_norm_c": 1.0 + nrm(ks[18], (N_ODD, HEAD_DIM), 0.02),
        "k_norm_c": 1.0 + nrm(ks[19], (N_ODD, HEAD_DIM), 0.02),
        "sink_c": nrm(ks[20], (N_ODD, C_HEADS), 0.5),
        "w_out_odd": nrm(ks[21], (N_ODD, ODD_MIX, D_MODEL), ODD_MIX ** -0.5),
        "w_up": nrm(ks[22], (DEPTH, D_MODEL, 2 * FFN_DIM), D_MODEL ** -0.5),
        "conv_w": nrm(ks[23], (DEPTH, CONV_W, 2 * FFN_DIM), CONV_W ** -0.5),
        "conv_b": nrm(ks[24], (DEPTH, 2 * FFN_DIM), 0.02),
        "w_down": nrm(ks[25], (DEPTH, FFN_DIM, D_MODEL), FFN_DIM ** -0.5),
    }


def reference(x_prompt, x_sample, cache_k_attn, cache_v_attn, cache_k_swa, cache_v_swa, c, c_ctx,
              w_mod, b_mod, w_in_even, q_norm_a, k_norm_a, v_norm_b, w_spatial, b_spatial, w_out_even,
              w_in_odd, q_norm_c, k_norm_c, sink_c, w_out_odd, w_up, conv_w, conv_b, w_down):
    cos, sin = axial_rope(x_sample.shape[1])
    xc, xs = x_prompt, x_sample
    ks_a, vs_a, ks_c, vs_c = [], [], [], []
    for layer in range(DEPTH):
        j = layer // 2
        mod_c = modulation(c_ctx[None, :], w_mod[layer], b_mod[layer])
        mod_s = modulation(c, w_mod[layer], b_mod[layer])
        hc = adaln(xc, mod_c[0], mod_c[1])
        hs = adaln(xs, mod_s[0], mod_s[1])
        if layer % 2 == 0:
            out_c, kc, vc = even_mixer(hc, w_in_even[j], q_norm_a[j], k_norm_a[j], v_norm_b[j],
                                       w_spatial[j], b_spatial[j], w_out_even[j])
            ks_a.append(kc)
            vs_a.append(vc)
            out_s, _, _ = even_mixer(hs, w_in_even[j], q_norm_a[j], k_norm_a[j], v_norm_b[j],
                                     w_spatial[j], b_spatial[j], w_out_even[j],
                                     rope=(cos, sin), ctx_kv=(cache_k_attn[:, j], cache_v_attn[:, j]))
        else:
            out_c, kc, vc = odd_mixer(hc, w_in_odd[j], q_norm_c[j], k_norm_c[j], sink_c[j], w_out_odd[j])
            ks_c.append(kc)
            vs_c.append(vc)
            out_s, _, _ = odd_mixer(hs, w_in_odd[j], q_norm_c[j], k_norm_c[j], sink_c[j], w_out_odd[j],
                                    rope=(cos, sin), ctx_kv=(cache_k_swa[:, j], cache_v_swa[:, j]))
        xc = xc + mod_c[2] * out_c
        xs = xs + mod_s[2] * out_s
        xc = xc + mod_c[5] * conv_ffn(adaln(xc, mod_c[3], mod_c[4]), w_up[layer], conv_w[layer], conv_b[layer], w_down[layer])
        xs = xs + mod_s[5] * conv_ffn(adaln(xs, mod_s[3], mod_s[4]), w_up[layer], conv_w[layer], conv_b[layer], w_down[layer])
    new_k_attn = jnp.stack(ks_a, axis=1)
    new_v_attn = jnp.stack(vs_a, axis=1)
    new_k_swa = jnp.stack(ks_c, axis=1)
    new_v_swa = jnp.stack(vs_c, axis=1)
    return (xc, xs, new_k_attn, new_v_attn, new_k_swa, new_v_swa)
```

```cpp
#include <hip/hip_runtime.h>
#include <hip/hip_cooperative_groups.h>
#include <cstdio>
#include <cstdint>
namespace cg = cooperative_groups;

#ifndef MK_COOP
#define MK_COOP 1
#endif

#define LAS __attribute__((address_space(3)))
typedef unsigned short bf16_t;
typedef short bf16x8 __attribute__((ext_vector_type(8)));
typedef short s16x4 __attribute__((ext_vector_type(4)));
typedef float f32x4 __attribute__((ext_vector_type(4)));
typedef float f32x2 __attribute__((ext_vector_type(2)));
typedef float f32x16 __attribute__((ext_vector_type(16)));
typedef unsigned u32x4 __attribute__((ext_vector_type(4)));
typedef unsigned u32x2 __attribute__((ext_vector_type(2)));

constexpr int DM = 1024, NCTX = 8192, NLAT = 16384, MTOK = 24576;
constexpr int EVEN_IN = 1792, ODD_IN = 1536, FF = 2816, FF2 = 5632;
constexpr int NCOND = 9, MODW = 6144;
constexpr float EPS = 1e-6f;
constexpr float LOG2E = 1.4426950408889634f;

constexpr size_t MiB = 1u << 20;
constexpr size_t WS_MOD = 0;
constexpr size_t WS_SS1 = 442368, WS_SS2 = WS_SS1 + 98304, WS_SS3 = WS_SS2 + 98304, WS_SSV = WS_SS3 + 98304;
constexpr size_t WS_ZERO_BYTES = 1 * MiB;
constexpr size_t WS_SS0 = 1 * MiB;
constexpr size_t WS_ROPE = 1 * MiB + 128 * 1024;
constexpr size_t WS_BIAS = 1 * MiB + 256 * 1024;
constexpr size_t WS_ZB = 2 * MiB;
constexpr size_t WS_CK_A = 11 * MiB, WS_CVT_A = 12 * MiB, WS_CK_C = 13 * MiB, WS_CVT_C = 15 * MiB;
constexpr size_t WS_W_INE = 18 * MiB, WS_W_OUTE = 22 * MiB, WS_W_INO = 24 * MiB, WS_W_OUTO = 27 * MiB, WS_W_UP = 29 * MiB, WS_W_DN = 51 * MiB;
constexpr size_t WS_A = 62 * MiB;
constexpr size_t WS_BIG = 110 * MiB;
constexpr size_t WS_ACT = WS_BIG;
constexpr size_t WS_MIX = WS_BIG;
constexpr size_t WS_Q = WS_BIG + 48 * MiB;
constexpr size_t WS_KE = WS_Q + 24 * MiB, WS_VTE = WS_KE + 6 * MiB, WS_VBT = WS_VTE + 6 * MiB;
constexpr size_t WS_KO = WS_Q + 48 * MiB, WS_VTO = WS_KO + 12 * MiB;
constexpr size_t WS_END = 256 * MiB;
static_assert(WS_VBT + 24 * MiB <= WS_END && WS_VTO + 12 * MiB <= WS_END && WS_ACT + 132 * MiB <= WS_END, "ws map");
constexpr size_t BIAS_INE = 0, BIAS_UP0 = 9 * 1792, BIAS_INO = BIAS_UP0 + 9 * 5632, BIAS_UP1 = BIAS_INO + 9 * 1536;

constexpr int LDS_BYTES = 147456;
constexpr int LDS_SPARE = 131072;

struct Params {
    const float* in[26];
    float* out;
    unsigned char* ws;
    int ph_lo, ph_hi;
};

namespace pg8 {
constexpr int BM = 256, BK = 64, HALF = 128, HTB = HALF * BK * 2, STAGE_BYTES = 8 * HTB, NXCD = 8, WGM = 8;
__host__ __device__ __forceinline__ int lds_byte(int r, int c) { const int st = (r >> 4) * 2 + (c >> 5), rr = r & 15, cc = c & 31, ob = rr * 64 + cc * 2; return st * 1024 + (ob ^ (((ob >> 9) & 1) << 5)); }
__host__ __device__ __forceinline__ void stage_rc(int b, int& R, int& C) { const int st = b / 1024, sb = b % 1024, swz = sb ^ (((sb >> 9) & 1) << 5); R = (st >> 1) * 16 + swz / 64; C = (st & 1) * 32 + (swz % 64) / 2; }
__host__ __device__ __forceinline__ int perm32(int rho) { const int n = rho >> 4, i = rho & 15; return 8 * (i >> 2) + 4 * n + (i & 3); }
struct Unit { int pm, pn; };
struct Gemm { const bf16_t* A; const bf16_t* Bt; int M, N, K; };
struct StaticOrder {
    int nM, nN, nwg, G, c;
    __device__ void init(int M, int N, int G_, int c_) { nM = M / BM; nN = N / BM; nwg = nM * nN; G = G_; c = c_; }
    __device__ bool next(int i, Unit& u) const {
        const long L = (long)i * G + c; if (L >= nwg) return false;
        int wgid = (int)L; { const int q = nwg / NXCD, r = nwg % NXCD, xcd = wgid % NXCD, off = wgid / NXCD; wgid = (xcd < r ? xcd * (q + 1) : r * (q + 1) + (xcd - r) * q) + off; }
        const int nig = WGM * nN, gid = wgid / nig, fm = gid * WGM, gsz = (nM - fm) < WGM ? (nM - fm) : WGM;
        u.pm = fm + ((wgid % nig) % gsz); u.pn = (wgid % nig) / gsz; return true;
    }
};
__device__ __forceinline__ unsigned cvt_pk_bf16(float lo, float hi) { unsigned r; asm volatile("v_cvt_pk_bf16_f32 %0, %1, %2" : "=v"(r) : "v"(lo), "v"(hi)); return r; }

template <class Epi, bool ALIGN_EPI>
__device__ __forceinline__ void gemm_phase(LAS unsigned char* lds, const Gemm g, const StaticOrder& S, const Epi& E) {
    const int tid = threadIdx.x, wid = __builtin_amdgcn_readfirstlane(tid >> 6), lane = tid & 63, wr = wid >> 2, wc = wid & 3, fr = lane & 15, fq = lane >> 4;
    const int K = g.K, nt = K / BK;
    unsigned voffA[2], voffB[2];
#pragma unroll
    for (int i = 0; i < 2; ++i) { int R, C; stage_rc(tid * 16 + i * 8192, R, C); const int Rb = (R & ~31) + perm32(R & 31);
        voffA[i] = (unsigned)(R * K + C) * 2u; voffB[i] = (unsigned)(Rb * K + C) * 2u; }
    const size_t kstep = (size_t)(BK * 2);
    const size_t hstep = (size_t)HALF * K * 2;
    const size_t tstep = 2 * hstep;
    const unsigned ldsw = (unsigned)wid * 1024u;
    const int aoff = lds_byte(wr * 64 + fr, fq * 8), boff = lds_byte(wc * 32 + fr, fq * 8);
#define PG8_SA(b, h) (((b) * 2 + (h)) * HTB)
#define PG8_SB(b, h) ((4 + (b) * 2 + (h)) * HTB)
#define PG8_STAGE(bufoff, gbase, voff) do { _Pragma("unroll") for (int _i = 0; _i < 2; ++_i) \
        __builtin_amdgcn_global_load_lds((const unsigned*)((const char*)(gbase) + (voff)[_i]), (LAS unsigned*)(lds + (bufoff) + ldsw + _i * 8192), 16, 0, 0); } while (0)
#define PG8_LDA(dst, b, h) do { _Pragma("unroll") for (int m = 0; m < 4; ++m) _Pragma("unroll") for (int k = 0; k < 2; ++k) dst[m][k] = *(const LAS bf16x8*)(lds + PG8_SA(b, h) + aoff + m * 2048 + k * 1024); } while (0)
#define PG8_LDB(dst, b, h) do { _Pragma("unroll") for (int n = 0; n < 2; ++n) _Pragma("unroll") for (int k = 0; k < 2; ++k) dst[n][k] = *(const LAS bf16x8*)(lds + PG8_SB(b, h) + boff + n * 2048 + k * 1024); } while (0)
#define PG8_MMA(ai, bj, At, Bt) do { __builtin_amdgcn_s_setprio(1); _Pragma("unroll") for (int m = 0; m < 4; ++m) _Pragma("unroll") for (int n = 0; n < 2; ++n) _Pragma("unroll") for (int k = 0; k < 2; ++k) \
        acc[ai][bj][m][n] = __builtin_amdgcn_mfma_f32_16x16x32_bf16(Bt[n][k], At[m][k], acc[ai][bj][m][n], 0, 0, 0); __builtin_amdgcn_s_setprio(0); } while (0)
#define PG8_WAIT_V(n) asm volatile("s_waitcnt vmcnt(" #n ")" ::: "memory")
#define PG8_WAIT_L(n) asm volatile("s_waitcnt lgkmcnt(" #n ")" ::: "memory")
#define PG8_BAR __builtin_amdgcn_s_barrier()
#define PG8_SCHED __builtin_amdgcn_sched_barrier(0)
    Unit cur, nxt; int ui = 0;
    if (!S.next(0, cur)) return;
    f32x4 acc[2][2][4][2];
#pragma unroll
    for (int a = 0; a < 2; ++a)
#pragma unroll
        for (int b = 0; b < 2; ++b)
#pragma unroll
            for (int m = 0; m < 4; ++m)
#pragma unroll
                for (int n = 0; n < 2; ++n) acc[a][b][m][n] = (f32x4){0.f, 0.f, 0.f, 0.f};
    bf16x8 At[4][2], B0[2][2], B1[2][2];
    const char* cA = (const char*)g.A + (size_t)cur.pm * tstep; const char* cB = (const char*)g.Bt + (size_t)cur.pn * tstep;
    PG8_STAGE(PG8_SB(0, 0), cB, voffB); PG8_STAGE(PG8_SB(0, 1), cB + hstep, voffB); PG8_STAGE(PG8_SA(0, 0), cA, voffA); PG8_STAGE(PG8_SA(0, 1), cA + hstep, voffA);
    if (wr == 1) PG8_BAR;
    PG8_WAIT_V(2); PG8_BAR;
    PG8_STAGE(PG8_SB(1, 0), cB + kstep, voffB); PG8_STAGE(PG8_SA(1, 0), cA + kstep, voffA); PG8_STAGE(PG8_SB(1, 1), cB + hstep + kstep, voffB);
    PG8_WAIT_V(6); PG8_BAR;
    for (;;) {
        const bool has_next = S.next(ui + 1, nxt);
        const char* nA = has_next ? (const char*)g.A + (size_t)nxt.pm * tstep : cA; const char* nB = has_next ? (const char*)g.Bt + (size_t)nxt.pn * tstep : cB;
        for (int t = 0; t < nt; t += 2) {
            const bool last = (t == nt - 2);
            const char* a1 = cA + (size_t)(t + 1) * kstep;
            const char* a2 = last ? nA : cA + (size_t)(t + 2) * kstep; const char* b2 = last ? nB : cB + (size_t)(t + 2) * kstep;
            const char* a3 = a2 + kstep; const char* b3 = b2 + kstep;
            PG8_LDB(B0, 0, 0); PG8_LDB(B1, 0, 1); PG8_SCHED; PG8_LDA(At, 0, 0); PG8_STAGE(PG8_SA(1, 1), a1 + hstep, voffA);
            PG8_WAIT_V(8); PG8_WAIT_L(0); PG8_BAR; PG8_MMA(0, 0, At, B0); PG8_MMA(0, 1, At, B1); PG8_BAR; PG8_SCHED;
            PG8_LDA(At, 0, 1); PG8_STAGE(PG8_SB(0, 0), b2, voffB); PG8_STAGE(PG8_SB(0, 1), b2 + hstep, voffB); PG8_STAGE(PG8_SA(0, 0), a2, voffA);
            PG8_WAIT_V(8); PG8_WAIT_L(0); PG8_BAR; PG8_MMA(1, 0, At, B0); PG8_MMA(1, 1, At, B1); PG8_BAR; PG8_SCHED;
            PG8_LDB(B0, 1, 0); PG8_LDB(B1, 1, 1); PG8_SCHED; PG8_LDA(At, 1, 0); PG8_STAGE(PG8_SA(0, 1), a2 + hstep, voffA);
            PG8_WAIT_V(8); PG8_WAIT_L(0); PG8_BAR; PG8_MMA(0, 0, At, B0); PG8_MMA(0, 1, At, B1); PG8_BAR; PG8_SCHED;
            PG8_LDA(At, 1, 1); PG8_STAGE(PG8_SB(1, 0), b3, voffB); PG8_STAGE(PG8_SB(1, 1), b3 + hstep, voffB); PG8_STAGE(PG8_SA(1, 0), a3, voffA);
            PG8_WAIT_V(8); PG8_WAIT_L(0); PG8_BAR; PG8_MMA(1, 0, At, B0); PG8_MMA(1, 1, At, B1); PG8_BAR; PG8_SCHED;
        }
        if constexpr (ALIGN_EPI) { if (wr == 0) PG8_BAR; }
        E(acc, cur, wr, wc, fr, fq);
        if (!has_next) break;
#pragma unroll
        for (int a = 0; a < 2; ++a)
#pragma unroll
            for (int b = 0; b < 2; ++b)
#pragma unroll
                for (int m = 0; m < 4; ++m)
#pragma unroll
                    for (int n = 0; n < 2; ++n) acc[a][b][m][n] = (f32x4){0.f, 0.f, 0.f, 0.f};
        cur = nxt; cA = nA; cB = nB; ++ui;
        if constexpr (ALIGN_EPI) { if (wr == 1) PG8_BAR; }
    }
    PG8_WAIT_V(0);
    if constexpr (!ALIGN_EPI) { if (wr == 0) PG8_BAR; }
    PG8_BAR;
#undef PG8_SA
#undef PG8_SB
#undef PG8_STAGE
#undef PG8_LDA
#undef PG8_LDB
#undef PG8_MMA
#undef PG8_WAIT_V
#undef PG8_WAIT_L
#undef PG8_BAR
#undef PG8_SCHED
}
}

using pg8::cvt_pk_bf16;
typedef f32x4 (&AccRef)[2][2][4][2];

__device__ __forceinline__ int cond_of_tile(int pm) { return pm < 32 ? 0 : 1 + ((pm - 32) >> 3); }
__device__ __forceinline__ float red_fq(float v) { v += __shfl_xor(v, 16); v += __shfl_xor(v, 32); return v; }
__device__ __forceinline__ float gelu_tanh(float x) { const float u = x + 0.044715f * x * x * x; return x * __builtin_amdgcn_rcpf(1.0f + __builtin_amdgcn_exp2f(-2.302208198f * u)); }
__device__ __forceinline__ float silu_f(float x) { return x * __builtin_amdgcn_rcpf(1.0f + __builtin_amdgcn_exp2f(-LOG2E * x)); }
__device__ __forceinline__ u32x4 pack8(const f32x4 a, const f32x4 b) { u32x4 w; w.x = cvt_pk_bf16(a[0], a[1]); w.y = cvt_pk_bf16(a[2], a[3]); w.z = cvt_pk_bf16(b[0], b[1]); w.w = cvt_pk_bf16(b[2], b[3]); return w; }
__device__ __forceinline__ float bf2f(unsigned short h) { return __uint_as_float((unsigned)h << 16); }

template <class T> __device__ __forceinline__ T ldg(const void* base, unsigned off) { return *(const T*)((const char*)base + off); }
template <class T> __device__ __forceinline__ void stg(void* base, unsigned off, T v) { *(T*)((char*)base + off) = v; }
__device__ __forceinline__ float ss4(const f32x4 v) { return (v[0] * v[0] + v[1] * v[1]) + (v[2] * v[2] + v[3] * v[3]); }

struct EpiRes {
    const float* xp; const float* xs; float* out; const float* gate; const float* nscale; bf16_t* An; float* ssn;
    __device__ __forceinline__ void operator()(AccRef acc, const pg8::Unit& u, int wr, int wc, int fr, int fq) const {
        const int cond = cond_of_tile(u.pm);
        const unsigned colbase = u.pn * 256 + wc * 32 + 8 * fq;
        const bool ctx = u.pm < 32;
        const float* xb = ctx ? xp : xs;
        const unsigned rsub = ctx ? 0u : (unsigned)NCTX;
        const unsigned moff = (cond * MODW + colbase) * 4u;
#pragma unroll
        for (int ai = 0; ai < 2; ++ai)
#pragma unroll
            for (int m = 0; m < 4; ++m) {
                const unsigned row = u.pm * 256 + ai * 128 + wr * 64 + m * 16 + fr;
                const unsigned xoff = ((row - rsub) * DM + colbase) * 4u, ooff = (row * DM + colbase) * 4u;
                float ssum = 0.f;
#pragma unroll
                for (int bj = 0; bj < 2; ++bj) {
                    f32x4 xn[2];
#pragma unroll
                    for (int n = 0; n < 2; ++n) {
                        const f32x4 xo = ldg<f32x4>(xb, xoff + bj * 512 + n * 16);
                        const f32x4 gt = ldg<f32x4>(gate, moff + bj * 512 + n * 16);
                        xn[n] = xo + gt * acc[ai][bj][m][n];
                        stg<f32x4>(out, ooff + bj * 512 + n * 16, xn[n]);
                        ssum += ss4(xn[n]);
                    }
                    if (An) {
                        const f32x4 s0 = ldg<f32x4>(nscale, moff + bj * 512) + 1.0f, s1 = ldg<f32x4>(nscale, moff + bj * 512 + 16) + 1.0f;
                        stg<u32x4>(An, (row * DM + colbase) * 2u + bj * 256, pack8(xn[0] * s0, xn[1] * s1));
                    }
                }
                if (ssn) { ssum = red_fq(ssum); if (fq == 0) atomicAdd((float*)((char*)ssn + row * 4u), ssum); }
                asm volatile("" ::: "memory");
            }
    }
};

template <bool EVEN>
struct EpiIn {
    const float* ss; const float* bias;
    const float* qg; const float* kg;
    const float* rope;
    bf16_t* Q; bf16_t* K; bf16_t* Vt; bf16_t* MIX; bf16_t* VbT; float* ssv;
    float* outk; float* outv;
    __device__ __forceinline__ void operator()(AccRef acc, const pg8::Unit& u, int wr, int wc, int fr, int fq) const {
        constexpr unsigned N = EVEN ? EVEN_IN : ODD_IN, QW = EVEN ? 512 : 1024, KVH = EVEN ? 2 : 4, KW = KVH * 64;
        const int cond = cond_of_tile(u.pm);
        int role; unsigned hidx;
        if (EVEN) { if (u.pn < 2) { role = 0; hidx = 4 * u.pn + wc; } else if (u.pn == 2) { role = wc < 2 ? 1 : 2; hidx = wc & 1; } else if (u.pn < 5) { role = 3; hidx = (u.pn - 3) * 4 + wc; } else { role = 4; hidx = (u.pn - 5) * 4 + wc; } }
        else { if (u.pn < 4) { role = 0; hidx = 4 * u.pn + wc; } else if (u.pn == 4) { role = 1; hidx = wc; } else { role = 2; hidx = wc; } }
        const unsigned boff = (cond * N + u.pn * 256 + wc * 32 + 8 * fq) * 4u;
        const bool lat = u.pm >= 32;
        const unsigned c8 = hidx * 64 + 8 * fq;
        const float* gp = role == 0 ? qg : kg;
#pragma unroll
        for (int ai = 0; ai < 2; ++ai)
#pragma unroll
            for (int m = 0; m < 4; ++m) {
                const unsigned row = u.pm * 256 + ai * 128 + wr * 64 + m * 16 + fr;
                const float rr = 1.0f / sqrtf(ldg<float>(ss, row * 4u) * (1.0f / DM) + EPS);
                f32x4 z[2][2];
#pragma unroll
                for (int bj = 0; bj < 2; ++bj)
#pragma unroll
                    for (int n = 0; n < 2; ++n) z[bj][n] = acc[ai][bj][m][n] * rr + ldg<f32x4>(bias, boff + bj * 512 + n * 16);
                if (role <= 1) {
                    float s2 = (ss4(z[0][0]) + ss4(z[0][1])) + (ss4(z[1][0]) + ss4(z[1][1]));
                    s2 = red_fq(s2);
                    const float rn = 1.0f / sqrtf(s2 * (1.0f / 64.0f) + EPS);
#pragma unroll
                    for (int bj = 0; bj < 2; ++bj)
#pragma unroll
                        for (int n = 0; n < 2; ++n) z[bj][n] = z[bj][n] * rn * ldg<f32x4>(gp, (8 * fq) * 4u + bj * 128 + n * 16);
                    if (role == 1 && !lat) {
#pragma unroll
                        for (int bj = 0; bj < 2; ++bj)
#pragma unroll
                            for (int n = 0; n < 2; ++n) stg<f32x4>(outk, (row * KW + c8) * 4u + bj * 128 + n * 16, z[bj][n]);
                    }
                    if (lat) {
                        const unsigned t = (row - NCTX) & 2047u;
#pragma unroll
                        for (int bj = 0; bj < 2; ++bj) {
                            const unsigned pos = bj == 0 ? (t >> 6) : (t & 63u);
#pragma unroll
                            for (int n = 0; n < 2; ++n) {
                                const f32x4 cs = ldg<f32x4>(rope, (pos * 16 + 4 * fq) * 8u + n * 16);
                                const f32x4 v = z[bj][n];
                                z[bj][n] = (f32x4){v[0] * cs[0] - v[1] * cs[1], v[0] * cs[1] + v[1] * cs[0], v[2] * cs[2] - v[3] * cs[3], v[2] * cs[3] + v[3] * cs[2]};
                            }
                        }
                    }
                    if (role == 0) {
#pragma unroll
                        for (int bj = 0; bj < 2; ++bj) stg<u32x4>(Q, (row * QW + c8) * 2u + bj * 64, pack8(z[bj][0] * 0.125f, z[bj][1] * 0.125f));
                    } else {
#pragma unroll
                        for (int bj = 0; bj < 2; ++bj) stg<u32x4>(K, (row * KW + c8) * 2u + bj * 64, pack8(z[bj][0], z[bj][1]));
                    }
                } else if (role == 2) {
                    if (!lat) {
#pragma unroll
                        for (int bj = 0; bj < 2; ++bj)
#pragma unroll
                            for (int n = 0; n < 2; ++n) stg<f32x4>(outv, (row * KW + c8) * 4u + bj * 128 + n * 16, z[bj][n]);
                    }
                    unsigned vb, T;
                    if (!lat) { T = 256; vb = ((row >> 8) * KVH + hidx) * 64 * 256 + (row & 255u); }
                    else { T = 2048; vb = NCTX * KW + (((row - NCTX) >> 11) * KVH + hidx) * 64 * 2048 + ((row - NCTX) & 2047u); }
                    vb += 8 * fq * T;
#pragma unroll
                    for (int bj = 0; bj < 2; ++bj)
#pragma unroll
                        for (int n = 0; n < 2; ++n)
#pragma unroll
                            for (int i = 0; i < 4; ++i) stg<bf16_t>(Vt, (vb + (32 * bj + 4 * n + i) * T) * 2u, (bf16_t)(cvt_pk_bf16(z[bj][n][i], 0.f) & 0xffffu));
                } else if (EVEN && role == 3) {
#pragma unroll
                    for (int bj = 0; bj < 2; ++bj) {
                        f32x4 a = z[bj][0], b = z[bj][1];
#pragma unroll
                        for (int i = 0; i < 4; ++i) { a[i] = gelu_tanh(a[i]); b[i] = gelu_tanh(b[i]); }
                        stg<u32x4>(MIX, (row * DM + 512 + c8) * 2u + bj * 64, pack8(a, b));
                    }
                } else if (EVEN) {
                    float s2 = 0.f;
                    const unsigned cb = (row >> 7) * 512 * 128 + (row & 127u) + c8 * 128;
#pragma unroll
                    for (int bj = 0; bj < 2; ++bj)
#pragma unroll
                        for (int n = 0; n < 2; ++n)
#pragma unroll
                            for (int i = 0; i < 4; ++i) {
                                const float gv = gelu_tanh(z[bj][n][i]); s2 += gv * gv;
                                stg<bf16_t>(VbT, (cb + (32 * bj + 4 * n + i) * 128) * 2u, (bf16_t)(cvt_pk_bf16(gv, 0.f) & 0xffffu));
                            }
                    s2 = red_fq(s2);
                    if (fq == 0) atomicAdd((float*)((char*)ssv + row * 4u), s2);
                }
                asm volatile("" ::: "memory");
            }
    }
};

template <int CTRL> __device__ __forceinline__ float dpp_rot(float v) { return __builtin_bit_cast(float, __builtin_amdgcn_update_dpp(0, __builtin_bit_cast(int, v), CTRL, 0xf, 0xf, false)); }
struct EpiUp {
    const float* ss; const float* bias; const float* cw; const float* cbias;
    float* ZB; bf16_t* ACT; LAS float* xch;
    __device__ __forceinline__ void operator()(AccRef acc, const pg8::Unit& u, int wr, int wc, int fr, int fq) const {
        const int cond = cond_of_tile(u.pm);
        const unsigned nb = u.pn * 256 + wc * 32 + 8 * fq;
        const unsigned boff = (cond * FF2 + nb) * 4u;
#pragma unroll
        for (int ai = 0; ai < 2; ++ai)
#pragma unroll
            for (int m = 0; m < 4; ++m) {
                const unsigned row = u.pm * 256 + ai * 128 + wr * 64 + m * 16 + fr;
                const float rr = 1.0f / sqrtf(ldg<float>(ss, row * 4u) * (1.0f / DM) + EPS);
#pragma unroll
                for (int bj = 0; bj < 2; ++bj)
#pragma unroll
                    for (int n = 0; n < 2; ++n) acc[ai][bj][m][n] = acc[ai][bj][m][n] * rr + ldg<f32x4>(bias, boff + bj * 512 + n * 16);
            }
        if (wr == 0 && fr < 2) {
            const unsigned zo = ((u.pm * 4 + fr) * FF2 + nb) * 4u;
#pragma unroll
            for (int bj = 0; bj < 2; ++bj)
#pragma unroll
                for (int n = 0; n < 2; ++n) stg<f32x4>(ZB, zo + bj * 512 + n * 16, acc[0][bj][0][n]);
        }
        if (wr == 1 && fr >= 14) {
            const unsigned zo = ((u.pm * 4 + 2 + (fr - 14)) * FF2 + nb) * 4u;
#pragma unroll
            for (int bj = 0; bj < 2; ++bj)
#pragma unroll
                for (int n = 0; n < 2; ++n) stg<f32x4>(ZB, zo + bj * 512 + n * 16, acc[1][bj][3][n]);
        }
        LAS float* my = xch + (wr * 4 + wc) * 256 + 8 * fq;
        if (fr == 0) {
#pragma unroll
            for (int ai = 0; ai < 2; ++ai)
#pragma unroll
                for (int bj = 0; bj < 2; ++bj)
#pragma unroll
                    for (int n = 0; n < 2; ++n) *(LAS f32x4*)(my + ai * 128 + bj * 32 + 4 * n) = acc[ai][bj][0][n];
        }
        if (fr == 15) {
#pragma unroll
            for (int ai = 0; ai < 2; ++ai)
#pragma unroll
                for (int bj = 0; bj < 2; ++bj)
#pragma unroll
                    for (int n = 0; n < 2; ++n) *(LAS f32x4*)(my + ai * 128 + 64 + bj * 32 + 4 * n) = acc[ai][bj][3][n];
        }
        asm volatile("s_waitcnt lgkmcnt(0)" ::: "memory"); __builtin_amdgcn_s_barrier(); asm volatile("" ::: "memory");
        const unsigned chb = u.pn * 128 + wc * 32 + 8 * fq;
        const float* cw1 = cw + FF2; const float* cw2 = cw + 2 * FF2;
#pragma unroll
        for (int ai = 0; ai < 2; ++ai) {
            const bool hasp = !(ai == 0 && wr == 0), hasn = !(ai == 1 && wr == 1);
            const LAS float* pp = xch + ((wr == 1 ? 0 : 4) + wc) * 256 + (wr == 1 ? ai : 0) * 128 + 64 + 8 * fq;
            const LAS float* pn = xch + ((wr == 0 ? 4 : 0) + wc) * 256 + (wr == 0 ? ai : 1) * 128 + 8 * fq;
            const unsigned arow = ((u.pm * 256 + ai * 128 + wr * 64 + fr) * FF + chb) * 2u;
#pragma unroll
            for (int n = 0; n < 2; ++n) {
                f32x4 sg[4];
#pragma unroll
                for (int pass = 0; pass < 2; ++pass) {
                    const int bj = 1 - pass;
                    const unsigned ci = (bj * FF + chb + 4 * n) * 4u;
                    const f32x4 w0 = ldg<f32x4>(cw, ci), w1 = ldg<f32x4>(cw1, ci), w2 = ldg<f32x4>(cw2, ci), cb = ldg<f32x4>(cbias, ci);
                    f32x4 hp = (f32x4){0.f, 0.f, 0.f, 0.f}, hn = (f32x4){0.f, 0.f, 0.f, 0.f};
                    if (hasp) hp = *(const LAS f32x4*)(pp + bj * 32 + 4 * n);
                    if (hasn) hn = *(const LAS f32x4*)(pn + bj * 32 + 4 * n);
                    f32x4 prevsrc = hp;
#pragma unroll
                    for (int m = 0; m < 4; ++m) {
                        const f32x4 zc = acc[ai][bj][m][n];
                        const f32x4 nsrc = m < 3 ? acc[ai][bj][m < 3 ? m + 1 : 3][n] : hn;
                        f32x4 pv, nv;
#pragma unroll
                        for (int i = 0; i < 4; ++i) {
                            pv[i] = dpp_rot<0x121>(fr == 15 ? prevsrc[i] : zc[i]);
                            nv[i] = dpp_rot<0x12F>(fr == 0 ? nsrc[i] : zc[i]);
                        }
                        f32x4 res = cb + w0 * pv + w1 * zc + w2 * nv;
                        prevsrc = zc;
                        if (pass == 0) {
#pragma unroll
                            for (int i = 0; i < 4; ++i) res[i] = silu_f(res[i]);
                            sg[m] = res;
                        } else {
                            res = res * sg[m];
                            stg<u32x2>(ACT, arow + m * (16 * FF * 2) + n * 8, (u32x2){cvt_pk_bf16(res[0], res[1]), cvt_pk_bf16(res[2], res[3])});
                        }
                    }
                    asm volatile("" ::: "memory");
                }
                asm volatile("" ::: "memory");
            }
        }
    }
};

__device__ __forceinline__ int crow(int r, int hi) { return (r & 3) + 8 * (r >> 2) + 4 * hi; }
constexpr int AK_STR = 144, AV_STR = 136, AK_BYTES = 64 * AK_STR, AV_BYTES = 64 * AV_STR;
__device__ __forceinline__ void attn_unit(LAS unsigned char* lds, const bf16_t* Q, int qstride, bf16_t* O, int ostride,
                                          const bf16_t* K0, int ks0, const bf16_t* V0, int vs0, int t0lo, int nt0,
                                          const bf16_t* K1, int ks1, const bf16_t* V1, int vs1, int nt1,
                                          float m_init, float l_init, int win_q0) {
    const int tid = threadIdx.x, lane = tid & 63, r32 = lane & 31, hi = lane >> 5, wid = __builtin_amdgcn_readfirstlane(tid >> 6);
    const int qrow = wid * 32 + r32;
    bf16x8 qf[4];
#pragma unroll
    for (int d0 = 0; d0 < 4; ++d0) qf[d0] = *(const bf16x8*)(Q + (size_t)qrow * qstride + d0 * 16 + hi * 8);
    float mrun = m_init, lrun = hi == 0 ? l_init : 0.f;
    f32x16 o0 = {}, o1 = {};
    const int NT = nt0 + nt1;
    const int lrow = tid >> 3, lch = tid & 7;
    LAS unsigned char* kb0 = lds; LAS unsigned char* vb0 = lds + 2 * AK_BYTES;
    u32x4 kreg, vreg;
    auto gload = [&](int t) {
        const bf16_t* kp; const bf16_t* vp;
        if (t < nt0) { kp = K0 + (size_t)((t0lo + t) * 64 + lrow) * ks0 + lch * 8; vp = V0 + (size_t)lrow * vs0 + (t0lo + t) * 64 + lch * 8; }
        else { kp = K1 + (size_t)((t - nt0) * 64 + lrow) * ks1 + lch * 8; vp = V1 + (size_t)lrow * vs1 + (t - nt0) * 64 + lch * 8; }
        kreg = *(const u32x4*)kp; vreg = *(const u32x4*)vp;
    };
    auto lstore = [&](int buf) {
        *(LAS u32x4*)(kb0 + buf * AK_BYTES + lrow * AK_STR + lch * 16) = kreg;
        LAS unsigned char* vd = vb0 + buf * AV_BYTES + lrow * AV_STR + lch * 16;
        *(LAS u32x2*)(vd) = (u32x2){vreg.x, vreg.y}; *(LAS u32x2*)(vd + 8) = (u32x2){vreg.z, vreg.w};
    };
    gload(0); lstore(0);
    asm volatile("s_waitcnt lgkmcnt(0)" ::: "memory"); __builtin_amdgcn_s_barrier(); asm volatile("" ::: "memory");
    for (int t = 0; t < NT; ++t) {
        const int buf = t & 1;
        if (t + 1 < NT) gload(t + 1);
        bool active = true;
        int key0 = 0;
        if (win_q0 >= 0 && t < nt0) {
            key0 = (t0lo + t) * 64;
            const int qw0 = win_q0 + wid * 32;
            active = !(key0 + 63 < qw0 - 128 || key0 > qw0 + 31 + 128);
        }
        if (active) {
            const LAS unsigned char* kb = kb0 + buf * AK_BYTES + r32 * AK_STR + hi * 16;
            f32x16 p0 = {}, p1 = {};
#pragma unroll
            for (int d0 = 0; d0 < 4; ++d0) {
                const bf16x8 k0 = *(const LAS bf16x8*)(kb + d0 * 32);
                const bf16x8 k1 = *(const LAS bf16x8*)(kb + 32 * AK_STR + d0 * 32);
                p0 = __builtin_amdgcn_mfma_f32_32x32x16_bf16(k0, qf[d0], p0, 0, 0, 0);
                p1 = __builtin_amdgcn_mfma_f32_32x32x16_bf16(k1, qf[d0], p1, 0, 0, 0);
            }
#pragma unroll
            for (int r = 0; r < 16; ++r) { p0[r] *= LOG2E; p1[r] *= LOG2E; }
            if (win_q0 >= 0 && t < nt0) {
                const int qpos = win_q0 + qrow;
#pragma unroll
                for (int r = 0; r < 16; ++r) {
                    const int kp = key0 + crow(r, hi);
                    int dlt = kp - qpos; if (dlt < 0) dlt = -dlt; if (dlt > 128) p0[r] = -INFINITY;
                    dlt = kp + 32 - qpos; if (dlt < 0) dlt = -dlt; if (dlt > 128) p1[r] = -INFINITY;
                }
            }
            float mx = fmaxf(p0[0], p1[0]);
#pragma unroll
            for (int r = 1; r < 16; ++r) mx = fmaxf(mx, fmaxf(p0[r], p1[r]));
            mx = fmaxf(mx, __shfl_xor(mx, 32));
            const float mnew = fmaxf(mrun, mx);
            const float alpha = __builtin_amdgcn_exp2f(mrun - mnew);
            mrun = mnew;
            float ls = 0.f;
#pragma unroll
            for (int r = 0; r < 16; ++r) { p0[r] = __builtin_amdgcn_exp2f(p0[r] - mnew); p1[r] = __builtin_amdgcn_exp2f(p1[r] - mnew); ls += p0[r] + p1[r]; }
            lrun = lrun * alpha + ls;
#pragma unroll
            for (int r = 0; r < 16; ++r) { o0[r] *= alpha; o1[r] *= alpha; }
            bf16x8 pw[4];
#pragma unroll
            for (int ks = 0; ks < 4; ++ks) {
                u32x4 w;
                if (ks < 2) { w.x = cvt_pk_bf16(p0[8 * ks + 0], p0[8 * ks + 1]); w.y = cvt_pk_bf16(p0[8 * ks + 2], p0[8 * ks + 3]); w.z = cvt_pk_bf16(p0[8 * ks + 4], p0[8 * ks + 5]); w.w = cvt_pk_bf16(p0[8 * ks + 6], p0[8 * ks + 7]); }
                else { const int k2 = ks - 2; w.x = cvt_pk_bf16(p1[8 * k2 + 0], p1[8 * k2 + 1]); w.y = cvt_pk_bf16(p1[8 * k2 + 2], p1[8 * k2 + 3]); w.z = cvt_pk_bf16(p1[8 * k2 + 4], p1[8 * k2 + 5]); w.w = cvt_pk_bf16(p1[8 * k2 + 6], p1[8 * k2 + 7]); }
                pw[ks] = __builtin_bit_cast(bf16x8, w);
            }
            const LAS unsigned char* vb = vb0 + buf * AV_BYTES + r32 * AV_STR + hi * 8;
#pragma unroll
            for (int ks = 0; ks < 4; ++ks) {
                const u32x2 a0 = *(const LAS u32x2*)(vb + ks * 32), a1 = *(const LAS u32x2*)(vb + ks * 32 + 16);
                const u32x2 b0 = *(const LAS u32x2*)(vb + 32 * AV_STR + ks * 32), b1 = *(const LAS u32x2*)(vb + 32 * AV_STR + ks * 32 + 16);
                const bf16x8 va = __builtin_bit_cast(bf16x8, (u32x4){a0.x, a0.y, a1.x, a1.y});
                const bf16x8 vbb = __builtin_bit_cast(bf16x8, (u32x4){b0.x, b0.y, b1.x, b1.y});
                o0 = __builtin_amdgcn_mfma_f32_32x32x16_bf16(va, pw[ks], o0, 0, 0, 0);
                o1 = __builtin_amdgcn_mfma_f32_32x32x16_bf16(vbb, pw[ks], o1, 0, 0, 0);
            }
        }
        if (t + 1 < NT) lstore(buf ^ 1);
        asm volatile("s_waitcnt lgkmcnt(0)" ::: "memory"); __builtin_amdgcn_s_barrier(); asm volatile("" ::: "memory");
    }
    float lt = lrun + __shfl_xor(lrun, 32);
    const float inv = 1.0f / lt;
    bf16_t* orow = O + (size_t)qrow * ostride;
#pragma unroll
    for (int r4 = 0; r4 < 4; ++r4) {
        u32x2 w0, w1;
        w0.x = cvt_pk_bf16(o0[4 * r4 + 0] * inv, o0[4 * r4 + 1] * inv); w0.y = cvt_pk_bf16(o0[4 * r4 + 2] * inv, o0[4 * r4 + 3] * inv);
        w1.x = cvt_pk_bf16(o1[4 * r4 + 0] * inv, o1[4 * r4 + 1] * inv); w1.y = cvt_pk_bf16(o1[4 * r4 + 2] * inv, o1[4 * r4 + 3] * inv);
        *(u32x2*)(orow + 8 * r4 + 4 * hi) = w0;
        *(u32x2*)(orow + 32 + 8 * r4 + 4 * hi) = w1;
    }
}

__device__ __forceinline__ void spatial_unit(int chunk, int g, const float* w_s, const float* b_s, const float* v_gain, const float* ssv, const bf16_t* VbT, bf16_t* MIX) {
    const int tid = threadIdx.x, lane = tid & 63, r32 = lane & 31, hi = lane >> 5, wid = __builtin_amdgcn_readfirstlane(tid >> 6);
    const int pblk = wid & 3, chalf = wid >> 2;
    const int p = 32 * pblk + r32;
    bf16x8 yf[8];
#pragma unroll
    for (int ks = 0; ks < 8; ++ks) {
        const int q = 16 * ks + 8 * hi;
        const f32x4 w0 = *(const f32x4*)(w_s + ((size_t)g * 128 + p) * 128 + q), w1 = *(const f32x4*)(w_s + ((size_t)g * 128 + p) * 128 + q + 4);
        const f32x4 s0 = *(const f32x4*)(ssv + chunk * 128 + q), s1 = *(const f32x4*)(ssv + chunk * 128 + q + 4);
        f32x4 a, b;
#pragma unroll
        for (int i = 0; i < 4; ++i) { a[i] = w0[i] / sqrtf(s0[i] * (1.0f / 512.0f) + EPS); b[i] = w1[i] / sqrtf(s1[i] * (1.0f / 512.0f) + EPS); }
        yf[ks] = __builtin_bit_cast(bf16x8, pack8(a, b));
    }
    const float bs = b_s[g * 128 + p];
    const int row = chunk * 128 + p;
#pragma unroll
    for (int cbk = 0; cbk < 2; ++cbk) {
        const int cblk = 2 * chalf + cbk;
        const bf16_t* xr = VbT + ((size_t)chunk * 512 + 128 * g + 32 * cblk + r32) * 128 + 8 * hi;
        f32x16 acc = {};
#pragma unroll
        for (int ks = 0; ks < 8; ++ks) { const bf16x8 xf = *(const bf16x8*)(xr + 16 * ks); acc = __builtin_amdgcn_mfma_f32_32x32x16_bf16(xf, yf[ks], acc, 0, 0, 0); }
#pragma unroll
        for (int r4 = 0; r4 < 4; ++r4) {
            const int ch = 128 * g + 32 * cblk + 8 * r4 + 4 * hi;
            const f32x4 gn = *(const f32x4*)(v_gain + ch);
            bf16_t* up = MIX + (size_t)row * DM + 512 + ch;
            const u32x2 uu = *(const u32x2*)up;
            const float u0 = __uint_as_float(uu.x << 16), u1 = __uint_as_float(uu.x & 0xffff0000u), u2 = __uint_as_float(uu.y << 16), u3 = __uint_as_float(uu.y & 0xffff0000u);
            u32x2 w;
            w.x = cvt_pk_bf16(u0 * (gn[0] * acc[4 * r4 + 0] + bs), u1 * (gn[1] * acc[4 * r4 + 1] + bs));
            w.y = cvt_pk_bf16(u2 * (gn[2] * acc[4 * r4 + 2] + bs), u3 * (gn[3] * acc[4 * r4 + 3] + bs));
            *(u32x2*)up = w;
        }
    }
}

__device__ __forceinline__ unsigned f2bf(float f) { unsigned u = __builtin_bit_cast(unsigned, f); return (u + 0x7fffu + ((u >> 16) & 1u)) >> 16; }
__device__ __forceinline__ unsigned pk2(float lo, float hi) { return f2bf(lo) | (f2bf(hi) << 16); }
__device__ __forceinline__ float wave_sum(float v) {
#pragma unroll
    for (int o = 1; o < 64; o <<= 1) v += __shfl_xor(v, o);
    return v;
}
__device__ __forceinline__ void transpose_item(const float* W, int K, int N, bf16_t* WT, int k0, int n0, int drow, LAS float* scr, int lane) {
#pragma unroll 8
    for (int i = 0; i < 32; ++i) { const int kk = 2 * i + (lane >> 5); scr[kk * 33 + (lane & 31)] = W[(size_t)(k0 + kk) * N + n0 + (lane & 31)]; }
    asm volatile("s_waitcnt lgkmcnt(0)" ::: "memory");
    const int c = lane & 7;
#pragma unroll
    for (int j = 0; j < 4; ++j) { const int n = (lane >> 3) + 8 * j; const LAS float* s = scr + (8 * c) * 33 + n;
        u32x4 o; o.x = pk2(s[0 * 33], s[1 * 33]); o.y = pk2(s[2 * 33], s[3 * 33]); o.z = pk2(s[4 * 33], s[5 * 33]); o.w = pk2(s[6 * 33], s[7 * 33]);
        *(u32x4*)(WT + (size_t)(drow + n) * K + k0 + 8 * c) = o; }
    asm volatile("s_waitcnt lgkmcnt(0)" ::: "memory");
}
__device__ __forceinline__ int perm_in(int n0) { const int pn = n0 >> 8, rem = n0 & 255; return pn * 256 + ((rem & 63) >> 5) * 128 + (rem >> 6) * 32; }
__device__ __forceinline__ int perm_up(int n0) { const int half = n0 / FF, ch = n0 % FF; return (ch >> 7) * 256 + half * 128 + (ch & 127); }

template <bool COOP>
__global__ void __launch_bounds__(512, 2) mk_fwd(Params P) {
    extern __shared__ __attribute__((aligned(16))) unsigned char lds_raw[];
    LAS unsigned char* lds = (LAS unsigned char*)lds_raw;
    const int tid = threadIdx.x, lane = tid & 63, wave = __builtin_amdgcn_readfirstlane(tid >> 6);
    const int G = gridDim.x, bx = blockIdx.x;
    const int gw = bx * 8 + wave, NGW = G * 8;
    unsigned char* ws = P.ws;
    float* out = P.out;
    typedef const float* cfp_t; typedef __attribute__((address_space(4))) const cfp_t* kargp_t;
#define INP(i) ({ kargp_t kp_ = (kargp_t)__builtin_amdgcn_kernarg_segment_ptr(); asm volatile("" : "+s"(kp_)); kp_[i]; })
#define out_ka (out + (size_t)MTOK * DM)
#define out_va (out + (size_t)MTOK * DM + NCTX * 128)
#define out_kc (out + (size_t)MTOK * DM + NCTX * 256)
#define out_vc (out + (size_t)MTOK * DM + NCTX * 512)
#define mod ((float*)(ws + WS_MOD))
#define ss0 ((float*)(ws + WS_SS0))
#define ss1 ((float*)(ws + WS_SS1))
#define ss2 ((float*)(ws + WS_SS2))
#define ss3 ((float*)(ws + WS_SS3))
#define ssv ((float*)(ws + WS_SSV))
#define rope ((float*)(ws + WS_ROPE))
#define biasw ((float*)(ws + WS_BIAS))
#define ZB ((float*)(ws + WS_ZB))
#define CK_A ((bf16_t*)(ws + WS_CK_A))
#define CVT_A ((bf16_t*)(ws + WS_CVT_A))
#define CK_C ((bf16_t*)(ws + WS_CK_C))
#define CVT_C ((bf16_t*)(ws + WS_CVT_C))
#define W_INE ((bf16_t*)(ws + WS_W_INE))
#define W_OUTE ((bf16_t*)(ws + WS_W_OUTE))
#define W_INO ((bf16_t*)(ws + WS_W_INO))
#define W_OUTO ((bf16_t*)(ws + WS_W_OUTO))
#define W_UP ((bf16_t*)(ws + WS_W_UP))
#define W_DN ((bf16_t*)(ws + WS_W_DN))
#define Abuf ((bf16_t*)(ws + WS_A))
#define ACT ((bf16_t*)(ws + WS_ACT))
#define MIX ((bf16_t*)(ws + WS_MIX))
#define Qb ((bf16_t*)(ws + WS_Q))
#define KE ((bf16_t*)(ws + WS_KE))
#define VTE ((bf16_t*)(ws + WS_VTE))
#define VBT ((bf16_t*)(ws + WS_VBT))
#define KO ((bf16_t*)(ws + WS_KO))
#define VTO ((bf16_t*)(ws + WS_VTO))
    LAS float* spare = (LAS float*)(lds + LDS_SPARE);

    const int lo = P.ph_lo, hi = P.ph_hi;
#ifndef MK_PHMASK
#define MK_PHMASK 0x3fff
#endif
#define IN(k) ((((MK_PHMASK) >> (k)) & 1) && lo <= (k) && (k) < hi)
#define SEAM(k) do { if constexpr (COOP) { if (IN(k) && IN((k) + 1)) { cg::this_grid().sync(); } } } while (0)

    if (IN(0)) {
        const float* c_in = INP(6); const float* c_ctx = INP(7); const float* w_mod = INP(8); const float* b_mod = INP(9);
        for (int it = bx; it < 2 * 24 * 16; it += G) {
            const int l = it / 384, cbk = (it % 384) / 16, ksp = it % 16;
            __syncthreads();
            for (int i = tid; i < NCOND * 64; i += 512) { const int cd = i >> 6, k = ksp * 64 + (i & 63); const float v = cd == 0 ? c_ctx[k] : c_in[(cd - 1) * DM + k]; spare[i] = v / (1.0f + __expf(-v)); }
            __syncthreads();
            const int col = cbk * 256 + (tid & 255), kh = tid >> 8;
            float a[NCOND];
#pragma unroll
            for (int cd = 0; cd < NCOND; ++cd) a[cd] = 0.f;
            const float* wp = w_mod + ((size_t)l * DM + ksp * 64 + kh * 32) * MODW + col;
#pragma unroll 4
            for (int k = 0; k < 32; ++k) { const float w = wp[(size_t)k * MODW];
#pragma unroll
                for (int cd = 0; cd < NCOND; ++cd) a[cd] += spare[cd * 64 + kh * 32 + k] * w; }
            const float bm = (ksp == 0 && kh == 0) ? b_mod[l * MODW + col] : 0.f;
#pragma unroll
            for (int cd = 0; cd < NCOND; ++cd) atomicAdd(mod + ((size_t)l * NCOND + cd) * MODW + col, a[cd] + bm);
        }
        __syncthreads();
        {
            const float* w_in_even = INP(10); const float* w_out_even = INP(16); const float* w_in_odd = INP(17); const float* w_out_odd = INP(21); const float* w_up = INP(22); const float* w_down = INP(25);
            LAS float* scr = (LAS float*)(lds + wave * 16384);
            constexpr int I_INE = 16 * 56, I_OUT = 16 * 32, I_INO = 16 * 48, I_UP = 16 * 176, I_DN = 44 * 32;
            constexpr int NIT = I_INE + 2 * I_OUT + I_INO + 2 * I_UP + 2 * I_DN;
            for (int it = gw; it < NIT; it += NGW) {
                int r = it;
                if (r < I_INE) { const int kb = r / 56, nb = r % 56; transpose_item(w_in_even, DM, EVEN_IN, W_INE, 64 * kb, 32 * nb, perm_in(32 * nb), scr, lane); continue; } r -= I_INE;
                if (r < I_OUT) { const int kb = r / 32, nb = r % 32; transpose_item(w_out_even, DM, DM, W_OUTE, 64 * kb, 32 * nb, 32 * nb, scr, lane); continue; } r -= I_OUT;
                if (r < I_INO) { const int kb = r / 48, nb = r % 48; transpose_item(w_in_odd, DM, ODD_IN, W_INO, 64 * kb, 32 * nb, perm_in(32 * nb), scr, lane); continue; } r -= I_INO;
                if (r < I_OUT) { const int kb = r / 32, nb = r % 32; transpose_item(w_out_odd, DM, DM, W_OUTO, 64 * kb, 32 * nb, 32 * nb, scr, lane); continue; } r -= I_OUT;
                if (r < 2 * I_UP) { const int l = r / I_UP, q = r % I_UP, kb = q / 176, nb = q % 176; transpose_item(w_up + (size_t)l * DM * FF2, DM, FF2, W_UP + (size_t)l * FF2 * DM, 64 * kb, 32 * nb, perm_up(32 * nb), scr, lane); continue; } r -= 2 * I_UP;
                { const int l = r / I_DN, q = r % I_DN, kb = q / 32, nb = q % 32; transpose_item(w_down + (size_t)l * FF * DM, FF, DM, W_DN + (size_t)l * DM * FF, 64 * kb, 32 * nb, 32 * nb, scr, lane); }
            }
        }
        {
            const float* cache_k_attn = INP(2); const float* cache_v_attn = INP(3); const float* cache_k_swa = INP(4); const float* cache_v_swa = INP(5);
            const int gt = bx * 512 + tid, NT_ = G * 512;
            for (int i = gt; i < 8 * 512 * 128 / 4; i += NT_) { const f32x4 v = *(const f32x4*)(cache_k_attn + (size_t)i * 4); *(u32x2*)(CK_A + (size_t)i * 4) = (u32x2){pk2(v[0], v[1]), pk2(v[2], v[3])}; }
            for (int i = gt; i < 8 * 512 * 256 / 4; i += NT_) { const f32x4 v = *(const f32x4*)(cache_k_swa + (size_t)i * 4); *(u32x2*)(CK_C + (size_t)i * 4) = (u32x2){pk2(v[0], v[1]), pk2(v[2], v[3])}; }
            for (int i = gt; i < 8 * 64 * 128; i += NT_) { const int cd = i & 127, pc = (i >> 7) & 63, b = i >> 13; const float* s = cache_v_attn + ((size_t)b * 512 + pc * 8) * 128 + cd;
                u32x4 o; o.x = pk2(s[0], s[128]); o.y = pk2(s[256], s[384]); o.z = pk2(s[512], s[640]); o.w = pk2(s[768], s[896]);
                *(u32x4*)(CVT_A + ((size_t)b * 128 + cd) * 512 + pc * 8) = o; }
            for (int i = gt; i < 8 * 64 * 256; i += NT_) { const int cd = i & 255, pc = (i >> 8) & 63, b = i >> 14; const float* s = cache_v_swa + ((size_t)b * 512 + pc * 8) * 256 + cd;
                u32x4 o; o.x = pk2(s[0], s[256]); o.y = pk2(s[512], s[768]); o.z = pk2(s[1024], s[1280]); o.w = pk2(s[1536], s[1792]);
                *(u32x4*)(CVT_C + ((size_t)b * 256 + cd) * 512 + pc * 8) = o; }
            if (gt < 1024) { const int pos = gt >> 4, f = gt & 15; const float inv = exp2f(-(float)f * (13.287712379549449f / 16.0f)); const float ang = (float)pos * inv;
                rope[gt * 2] = cosf(ang); rope[gt * 2 + 1] = sinf(ang); }
        }
    }
    SEAM(0);
    if (IN(1)) {
        const float* x_prompt = INP(0); const float* x_sample = INP(1);
        for (int row = gw; row < MTOK; row += NGW) {
            const float* xr = row < NCTX ? x_prompt + (size_t)row * DM : x_sample + (size_t)(row - NCTX) * DM;
            const int cond = row < NCTX ? 0 : 1 + ((row - NCTX) >> 11);
            const float* sc = mod + (size_t)cond * MODW + 1024;
            f32x4 v[4]; float s = 0.f;
#pragma unroll
            for (int j = 0; j < 4; ++j) { v[j] = *(const f32x4*)(xr + 256 * j + 4 * lane); s += (v[j][0] * v[j][0] + v[j][1] * v[j][1]) + (v[j][2] * v[j][2] + v[j][3] * v[j][3]); }
            s = wave_sum(s);
            if (lane == 0) ss0[row] = s;
#pragma unroll
            for (int j = 0; j < 4; ++j) { const f32x4 s4 = *(const f32x4*)(sc + 256 * j + 4 * lane); const f32x4 h = v[j] * (s4 + 1.0f);
                *(u32x2*)(Abuf + (size_t)row * DM + 256 * j + 4 * lane) = (u32x2){cvt_pk_bf16(h[0], h[1]), cvt_pk_bf16(h[2], h[3])}; }
        }
        constexpr int NB0 = 1792 / 64, NB1 = 5632 / 64, NB2 = 1536 / 64, NBT = NB0 + 2 * NB1 + NB2;
        for (int it = gw; it < NCOND * NBT; it += NGW) {
            const int cond = it / NBT; int r = it % NBT;
            const bf16_t* Wt; const float* sh; float* dst; int N;
            if (r < NB0) { Wt = W_INE; sh = mod + (size_t)cond * MODW; dst = biasw + BIAS_INE; N = 1792; }
            else if ((r -= NB0) < NB1) { Wt = W_UP; sh = mod + (size_t)cond * MODW + 3072; dst = biasw + BIAS_UP0; N = 5632; }
            else if ((r -= NB1) < NB2) { Wt = W_INO; sh = mod + (size_t)(NCOND + cond) * MODW; dst = biasw + BIAS_INO; N = 1536; }
            else { r -= NB2; Wt = W_UP + (size_t)FF2 * DM; sh = mod + (size_t)(NCOND + cond) * MODW + 3072; dst = biasw + BIAS_UP1; N = 5632; }
            float sv[16];
#pragma unroll
            for (int j = 0; j < 4; ++j) { const f32x4 t4 = *(const f32x4*)(sh + 16 * lane + 4 * j); sv[4 * j] = t4[0]; sv[4 * j + 1] = t4[1]; sv[4 * j + 2] = t4[2]; sv[4 * j + 3] = t4[3]; }
            for (int n = 0; n < 64; ++n) {
                const bf16_t* wr_ = Wt + (size_t)(r * 64 + n) * DM + 16 * lane;
                const u32x4 w0 = *(const u32x4*)wr_, w1 = *(const u32x4*)(wr_ + 8);
                float d = 0.f;
#pragma unroll
                for (int j = 0; j < 4; ++j) { d += sv[2 * j] * __uint_as_float(w0[j] << 16) + sv[2 * j + 1] * __uint_as_float(w0[j] & 0xffff0000u); d += sv[8 + 2 * j] * __uint_as_float(w1[j] << 16) + sv[8 + 2 * j + 1] * __uint_as_float(w1[j] & 0xffff0000u); }
                d = wave_sum(d);
                if (lane == 0) dst[(size_t)cond * N + r * 64 + n] = d;
            }
        }
    }
    SEAM(1);
    pg8::StaticOrder S;
    if (IN(2)) {
        pg8::Gemm g{Abuf, W_INE, MTOK, EVEN_IN, DM}; S.init(MTOK, EVEN_IN, G, bx);
        EpiIn<true> E{ss0, biasw + BIAS_INE, INP(11), INP(12), rope, Qb, KE, VTE, MIX, VBT, ssv, out_ka, out_va};
        pg8::gemm_phase<EpiIn<true>, true>(lds, g, S, E);
    }
    SEAM(2);
    if (IN(3)) {
        const float* w_spatial = INP(14); const float* b_spatial = INP(15); const float* v_norm_b = INP(13);
        for (int it = bx; it < 512 + 256 + 768; it += G) {
            if (it < 512) {
                const int b = it >> 6, h = (it >> 3) & 7, qb = it & 7, kvh = h >> 2;
                const size_t row0 = NCTX + (size_t)b * 2048 + qb * 256;
                attn_unit(lds, Qb + row0 * 512 + h * 64, 512, MIX + row0 * DM + h * 64, DM,
                          KE + ((size_t)NCTX + (size_t)b * 2048) * 128 + kvh * 64, 128, VTE + (size_t)NCTX * 128 + (size_t)(b * 2 + kvh) * 64 * 2048, 2048, 0, 32,
                          CK_A + (size_t)b * 512 * 128 + kvh * 64, 128, CVT_A + (size_t)(b * 2 + kvh) * 64 * 512, 512, 8, -1e30f, 0.f, -1);
            } else if (it < 768) {
                const int e = it - 512, b = e >> 3, h = e & 7, kvh = h >> 2;
                const size_t row0 = (size_t)b * 256;
                attn_unit(lds, Qb + row0 * 512 + h * 64, 512, MIX + row0 * DM + h * 64, DM,
                          KE + row0 * 128 + kvh * 64, 128, VTE + (size_t)(b * 2 + kvh) * 64 * 256, 256, 0, 4,
                          nullptr, 0, nullptr, 0, 0, -1e30f, 0.f, -1);
            } else {
                const int e = it - 768;
                spatial_unit(e >> 2, e & 3, w_spatial, b_spatial, v_norm_b, ssv, VBT, MIX);
            }
        }
    }
    SEAM(3);
    if (IN(4)) {
        pg8::Gemm g{MIX, W_OUTE, MTOK, DM, DM}; S.init(MTOK, DM, G, bx);
        EpiRes E{INP(0), INP(1), out, mod + 2048, mod + 4096, Abuf, ss1};
        pg8::gemm_phase<EpiRes, true>(lds, g, S, E);
    }
    SEAM(4);
#define FFN_PHASES(P5, P6, P7, L, SSIN, BIASOFF, NSCALE, SSOUT, LASTL) \
    if (IN(P5)) { \
        pg8::Gemm g{Abuf, W_UP + (size_t)(L) * FF2 * DM, MTOK, FF2, DM}; S.init(MTOK, FF2, G, bx); \
        EpiUp E{SSIN, biasw + (BIASOFF), INP(23) + (size_t)(L) * 3 * FF2, INP(24) + (size_t)(L) * FF2, ZB, ACT, spare}; \
        pg8::gemm_phase<EpiUp, true>(lds, g, S, E); \
    } \
    SEAM(P5); \
    if (IN(P6)) { \
        const float* cw = INP(23) + (size_t)(L) * 3 * FF2; const float* cb = INP(24) + (size_t)(L) * FF2; \
        for (int i = bx * 512 + tid; i < 8 * 7 * 2 * FF; i += G * 512) { \
            const int ch = i % FF, rs = i / FF, which = rs & 1, sm = (rs >> 1) % 7, b = rs / 14; \
            const int pmA = 32 + b * 8 + sm;                         \
            const int zc = (ch >> 7) * 256 + (ch & 127); \
            const float* zA = ZB + (size_t)pmA * 4 * FF2; const float* zB = ZB + (size_t)(pmA + 1) * 4 * FF2; \
            float ra, rg; \
            if (which == 0) {   \
                ra = cb[ch] + cw[ch] * zA[2 * FF2 + zc] + cw[FF2 + ch] * zA[3 * FF2 + zc] + cw[2 * FF2 + ch] * zB[zc]; \
                rg = cb[FF + ch] + cw[FF + ch] * zA[2 * FF2 + zc + 128] + cw[FF2 + FF + ch] * zA[3 * FF2 + zc + 128] + cw[2 * FF2 + FF + ch] * zB[zc + 128]; \
            } else {            \
                ra = cb[ch] + cw[ch] * zA[3 * FF2 + zc] + cw[FF2 + ch] * zB[zc] + cw[2 * FF2 + ch] * zB[FF2 + zc]; \
                rg = cb[FF + ch] + cw[FF + ch] * zA[3 * FF2 + zc + 128] + cw[FF2 + FF + ch] * zB[zc + 128] + cw[2 * FF2 + FF + ch] * zB[FF2 + zc + 128]; \
            } \
            const int row = pmA * 256 + 255 + which; \
            ACT[(size_t)row * FF + ch] = (bf16_t)(cvt_pk_bf16(ra * silu_f(rg), 0.f) & 0xffffu); \
        } \
    } \
    SEAM(P6); \
    if (IN(P7)) { \
        pg8::Gemm g{ACT, W_DN + (size_t)(L) * DM * FF, MTOK, DM, FF}; S.init(MTOK, DM, G, bx); \
        EpiRes E{out, out + (size_t)NCTX * DM, out, mod + (size_t)(L) * NCOND * MODW + 5120, NSCALE, (LASTL) ? nullptr : Abuf, SSOUT}; \
        pg8::gemm_phase<EpiRes, true>(lds, g, S, E); \
    } \
    SEAM(P7);
    FFN_PHASES(5, 6, 7, 0, ss1, BIAS_UP0, mod + (size_t)NCOND * MODW + 1024, ss2, false)
    if (IN(8)) {
        pg8::Gemm g{Abuf, W_INO, MTOK, ODD_IN, DM}; S.init(MTOK, ODD_IN, G, bx);
        EpiIn<false> E{ss2, biasw + BIAS_INO, INP(18), INP(19), rope, Qb, KO, VTO, MIX, nullptr, nullptr, out_kc, out_vc};
        pg8::gemm_phase<EpiIn<false>, true>(lds, g, S, E);
    }
    SEAM(8);
    if (IN(9)) {
        const float* sink_c = INP(20);
        for (int it = bx; it < 1024 + 512; it += G) {
            if (it < 1024) {
                const int b = it >> 7, h = (it >> 3) & 15, qb = it & 7, kvh = h >> 2;
                const size_t row0 = NCTX + (size_t)b * 2048 + qb * 256;
                const int q0 = qb * 256; int klo = q0 - 128; if (klo < 0) klo = 0; int khi = q0 + 384; if (khi > 2048) khi = 2048;
                attn_unit(lds, Qb + row0 * 1024 + h * 64, 1024, MIX + row0 * DM + h * 64, DM,
                          KO + ((size_t)NCTX + (size_t)b * 2048) * 256 + kvh * 64, 256, VTO + (size_t)NCTX * 256 + (size_t)(b * 4 + kvh) * 64 * 2048, 2048, klo >> 6, (khi - klo) >> 6,
                          CK_C + (size_t)b * 512 * 256 + kvh * 64, 256, CVT_C + (size_t)(b * 4 + kvh) * 64 * 512, 512, 8, sink_c[h] * LOG2E, 1.0f, q0);
            } else {
                const int e = it - 1024, b = e >> 4, h = e & 15, kvh = h >> 2;
                const size_t row0 = (size_t)b * 256;
                attn_unit(lds, Qb + row0 * 1024 + h * 64, 1024, MIX + row0 * DM + h * 64, DM,
                          KO + row0 * 256 + kvh * 64, 256, VTO + (size_t)(b * 4 + kvh) * 64 * 256, 256, 0, 4,
                          nullptr, 0, nullptr, 0, 0, sink_c[h] * LOG2E, 1.0f, -1);
            }
        }
    }
    SEAM(9);
    if (IN(10)) {
        pg8::Gemm g{MIX, W_OUTO, MTOK, DM, DM}; S.init(MTOK, DM, G, bx);
        EpiRes E{out, out + (size_t)NCTX * DM, out, mod + (size_t)NCOND * MODW + 2048, mod + (size_t)NCOND * MODW + 4096, Abuf, ss3};
        pg8::gemm_phase<EpiRes, true>(lds, g, S, E);
    }
    SEAM(10);
    FFN_PHASES(11, 12, 13, 1, ss3, BIAS_UP1, nullptr, nullptr, true)
#undef IN
#undef SEAM
}

constexpr int N_PHASES = 14;

extern "C" void kernel_launch(void* const* d_in, const int* in_sizes, int n_in, void* d_out, int out_size, void* d_ws, size_t ws_size, hipStream_t stream) {
    static int grid = 0;
    if (grid == 0) {
        int dev = 0, cus = 0;
        hipGetDevice(&dev);
        hipDeviceGetAttribute(&cus, hipDeviceAttributeMultiprocessorCount, dev);
        hipFuncSetAttribute((const void*)mk_fwd<true>, hipFuncAttributeMaxDynamicSharedMemorySize, LDS_BYTES);
        hipFuncSetAttribute((const void*)mk_fwd<false>, hipFuncAttributeMaxDynamicSharedMemorySize, LDS_BYTES);
        int per_cu = 0;
        hipOccupancyMaxActiveBlocksPerMultiprocessor(&per_cu, (const void*)mk_fwd<true>, 512, LDS_BYTES);
        (void)hipGetLastError();
        if (per_cu < 1) fprintf(stderr, "kernel_launch: occupancy query says %d blocks/CU\n", per_cu);
        grid = cus > 0 ? cus : 256;
        if (n_in != 26 || ws_size < WS_END) { fprintf(stderr, "kernel_launch: unexpected n_in %d / ws %zu\n", n_in, ws_size); }
    }
    hipMemsetAsync((char*)d_ws, 0, WS_ZERO_BYTES, stream);
    Params p{};
    for (int i = 0; i < 26; ++i) p.in[i] = (const float*)d_in[i];
    p.out = (float*)d_out; p.ws = (unsigned char*)d_ws;
#if MK_COOP
    p.ph_lo = 0; p.ph_hi = N_PHASES;
    void* args[] = {&p};
    hipError_t e = hipLaunchCooperativeKernel((const void*)mk_fwd<true>, dim3(grid), dim3(512), args, LDS_BYTES, stream);
    if (e != hipSuccess) fprintf(stderr, "cooperative launch failed: %s (grid %d)\n", hipGetErrorString(e), grid);
#else
    for (int ph = 0; ph < N_PHASES; ++ph) {
        p.ph_lo = ph; p.ph_hi = ph + 1;
        hipLaunchKernelGGL(mk_fwd<false>, dim3(grid), dim3(512), LDS_BYTES, stream, p);
    }
#endif
}
```

```cpp
#include <hip/hip_runtime.h>
#include <hip/hip_cooperative_groups.h>
#include <cstdio>
#include <cstdint>
namespace cg = cooperative_groups;

#ifndef MK_COOP
#define MK_COOP 1
#endif

#define LAS __attribute__((address_space(3)))
typedef unsigned short bf16_t;
typedef short bf16x8 __attribute__((ext_vector_type(8)));
typedef short s16x4 __attribute__((ext_vector_type(4)));
typedef float f32x4 __attribute__((ext_vector_type(4)));
typedef float f32x2 __attribute__((ext_vector_type(2)));
typedef float f32x16 __attribute__((ext_vector_type(16)));
typedef unsigned u32x4 __attribute__((ext_vector_type(4)));
typedef unsigned u32x2 __attribute__((ext_vector_type(2)));

constexpr int DM = 1024, NCTX = 8192, NLAT = 16384, MTOK = 24576;
constexpr int EVEN_IN = 1792, ODD_IN = 1536, FF = 2816, FF2 = 5632;
constexpr int NCOND = 9, MODW = 6144;
constexpr float EPS = 1e-6f;
constexpr float LOG2E = 1.4426950408889634f;

constexpr size_t MiB = 1u << 20;
constexpr size_t WS_MOD = 0;
constexpr size_t WS_SS1 = 442368, WS_SS2 = WS_SS1 + 98304, WS_SS3 = WS_SS2 + 98304, WS_SSV = WS_SS3 + 98304;
constexpr size_t WS_BAR = 900 * 1024;
constexpr size_t WS_ZERO_BYTES = 1 * MiB;
constexpr size_t WS_SS0 = 1 * MiB;
constexpr size_t WS_ROPE = 1 * MiB + 128 * 1024;
constexpr size_t WS_BIAS = 1 * MiB + 256 * 1024;
constexpr size_t WS_ZB = 2 * MiB;
constexpr size_t WS_CK_A = 11 * MiB, WS_CVT_A = 12 * MiB, WS_CK_C = 13 * MiB, WS_CVT_C = 15 * MiB;
constexpr size_t WS_W_INE = 18 * MiB, WS_W_OUTE = 22 * MiB, WS_W_INO = 24 * MiB, WS_W_OUTO = 27 * MiB, WS_W_UP = 29 * MiB, WS_W_DN = 51 * MiB;
constexpr size_t WS_A = 62 * MiB;
constexpr size_t WS_BIG = 110 * MiB;
constexpr size_t WS_ACT = WS_BIG;
constexpr size_t WS_MIX = WS_BIG;
constexpr size_t WS_Q = WS_BIG + 48 * MiB;
constexpr size_t WS_KE = WS_Q + 24 * MiB, WS_VTE = WS_KE + 6 * MiB, WS_VBT = WS_VTE + 6 * MiB;
constexpr size_t WS_KO = WS_Q + 48 * MiB, WS_VTO = WS_KO + 12 * MiB;
constexpr size_t WS_END = 256 * MiB;
static_assert(WS_VBT + 24 * MiB <= WS_END && WS_VTO + 12 * MiB <= WS_END && WS_ACT + 132 * MiB <= WS_END, "ws map");
constexpr size_t BIAS_INE = 0, BIAS_UP0 = 9 * 1792, BIAS_INO = BIAS_UP0 + 9 * 5632, BIAS_UP1 = BIAS_INO + 9 * 1536;

constexpr int LDS_BYTES = 147456;
constexpr int LDS_SPARE = 131072;

struct Params {
    const float* in[26];
    float* out;
    unsigned char* ws;
    int ph_lo, ph_hi;
};

namespace pg8 {
constexpr int BM = 256, BK = 64, HALF = 128, HTB = HALF * BK * 2, STAGE_BYTES = 8 * HTB, NXCD = 8, WGM = 8;
__host__ __device__ __forceinline__ int lds_byte(int r, int c) { const int st = (r >> 4) * 2 + (c >> 5), rr = r & 15, cc = c & 31, ob = rr * 64 + cc * 2; return st * 1024 + (ob ^ (((ob >> 9) & 1) << 5)); }
__host__ __device__ __forceinline__ void stage_rc(int b, int& R, int& C) { const int st = b / 1024, sb = b % 1024, swz = sb ^ (((sb >> 9) & 1) << 5); R = (st >> 1) * 16 + swz / 64; C = (st & 1) * 32 + (swz % 64) / 2; }
__host__ __device__ __forceinline__ int perm32(int rho) { const int n = rho >> 4, i = rho & 15; return 8 * (i >> 2) + 4 * n + (i & 3); }
struct Unit { int pm, pn; };
struct Gemm { const bf16_t* A; const bf16_t* Bt; int M, N, K; };
struct StaticOrder {
    int nM, nN, nwg, G, c;
    __device__ void init(int M, int N, int G_, int c_) { nM = M / BM; nN = N / BM; nwg = nM * nN; G = G_; c = c_; }
    __device__ bool next(int i, Unit& u) const {
        const long L = (long)i * G + c; if (L >= nwg) return false;
        int wgid = (int)L; { const int q = nwg / NXCD, r = nwg % NXCD, xcd = wgid % NXCD, off = wgid / NXCD; wgid = (xcd < r ? xcd * (q + 1) : r * (q + 1) + (xcd - r) * q) + off; }
        const int nig = WGM * nN, gid = wgid / nig, fm = gid * WGM, gsz = (nM - fm) < WGM ? (nM - fm) : WGM;
        u.pm = fm + ((wgid % nig) % gsz); u.pn = (wgid % nig) / gsz; return true;
    }
};
__device__ __forceinline__ unsigned cvt_pk_bf16(float lo, float hi) { unsigned r; asm volatile("v_cvt_pk_bf16_f32 %0, %1, %2" : "=v"(r) : "v"(lo), "v"(hi)); return r; }

template <class Epi, bool ALIGN_EPI>
__device__ __forceinline__ void gemm_phase(LAS unsigned char* lds, const Gemm g, const StaticOrder& S, const Epi& E) {
    const int tid = threadIdx.x, wid = __builtin_amdgcn_readfirstlane(tid >> 6), lane = tid & 63, wr = wid >> 2, wc = wid & 3, fr = lane & 15, fq = lane >> 4;
    const int K = g.K, nt = K / BK;
    unsigned voffA[2], voffB[2];
#pragma unroll
    for (int i = 0; i < 2; ++i) { int R, C; stage_rc(tid * 16 + i * 8192, R, C); const int Rb = (R & ~31) + perm32(R & 31);
        voffA[i] = (unsigned)(R * K + C) * 2u; voffB[i] = (unsigned)(Rb * K + C) * 2u; }
    const size_t kstep = (size_t)(BK * 2);
    const size_t hstep = (size_t)HALF * K * 2;
    const size_t tstep = 2 * hstep;
    const unsigned ldsw = (unsigned)wid * 1024u;
    const int aoff = lds_byte(wr * 64 + fr, fq * 8), boff = lds_byte(wc * 32 + fr, fq * 8);
#define PG8_SA(b, h) (((b) * 2 + (h)) * HTB)
#define PG8_SB(b, h) ((4 + (b) * 2 + (h)) * HTB)
#define PG8_STAGE(bufoff, gbase, voff) do { _Pragma("unroll") for (int _i = 0; _i < 2; ++_i) \
        __builtin_amdgcn_global_load_lds((const unsigned*)((const char*)(gbase) + (voff)[_i]), (LAS unsigned*)(lds + (bufoff) + ldsw + _i * 8192), 16, 0, 0); } while (0)
#define PG8_LDA(dst, b, h) do { _Pragma("unroll") for (int m = 0; m < 4; ++m) _Pragma("unroll") for (int k = 0; k < 2; ++k) dst[m][k] = *(const LAS bf16x8*)(lds + PG8_SA(b, h) + aoff + m * 2048 + k * 1024); } while (0)
#define PG8_LDB(dst, b, h) do { _Pragma("unroll") for (int n = 0; n < 2; ++n) _Pragma("unroll") for (int k = 0; k < 2; ++k) dst[n][k] = *(const LAS bf16x8*)(lds + PG8_SB(b, h) + boff + n * 2048 + k * 1024); } while (0)
#define PG8_MMA(ai, bj, At, Bt) do { __builtin_amdgcn_s_setprio(1); _Pragma("unroll") for (int m = 0; m < 4; ++m) _Pragma("unroll") for (int n = 0; n < 2; ++n) _Pragma("unroll") for (int k = 0; k < 2; ++k) \
        acc[ai][bj][m][n] = __builtin_amdgcn_mfma_f32_16x16x32_bf16(Bt[n][k], At[m][k], acc[ai][bj][m][n], 0, 0, 0); __builtin_amdgcn_s_setprio(0); } while (0)
#define PG8_WAIT_V(n) asm volatile("s_waitcnt vmcnt(" #n ")" ::: "memory")
#define PG8_WAIT_L(n) asm volatile("s_waitcnt lgkmcnt(" #n ")" ::: "memory")
#define PG8_BAR __builtin_amdgcn_s_barrier()
#define PG8_SCHED __builtin_amdgcn_sched_barrier(0)
    Unit cur, nxt; int ui = 0;
    if (!S.next(0, cur)) return;
    f32x4 acc[2][2][4][2];
#pragma unroll
    for (int a = 0; a < 2; ++a)
#pragma unroll
        for (int b = 0; b < 2; ++b)
#pragma unroll
            for (int m = 0; m < 4; ++m)
#pragma unroll
                for (int n = 0; n < 2; ++n) acc[a][b][m][n] = (f32x4){0.f, 0.f, 0.f, 0.f};
    bf16x8 At[4][2], B0[2][2], B1[2][2];
    const char* cA = (const char*)g.A + (size_t)cur.pm * tstep; const char* cB = (const char*)g.Bt + (size_t)cur.pn * tstep;
    PG8_STAGE(PG8_SB(0, 0), cB, voffB); PG8_STAGE(PG8_SB(0, 1), cB + hstep, voffB); PG8_STAGE(PG8_SA(0, 0), cA, voffA); PG8_STAGE(PG8_SA(0, 1), cA + hstep, voffA);
    if (wr == 1) PG8_BAR;
    PG8_WAIT_V(2); PG8_BAR;
    PG8_STAGE(PG8_SB(1, 0), cB + kstep, voffB); PG8_STAGE(PG8_SA(1, 0), cA + kstep, voffA); PG8_STAGE(PG8_SB(1, 1), cB + hstep + kstep, voffB);
    PG8_WAIT_V(6); PG8_BAR;
    for (;;) {
        const bool has_next = S.next(ui + 1, nxt);
        const char* nA = has_next ? (const char*)g.A + (size_t)nxt.pm * tstep : cA; const char* nB = has_next ? (const char*)g.Bt + (size_t)nxt.pn * tstep : cB;
        for (int t = 0; t < nt; t += 2) {
            const bool last = (t == nt - 2);
            const char* a1 = cA + (size_t)(t + 1) * kstep;
            const char* a2 = last ? nA : cA + (size_t)(t + 2) * kstep; const char* b2 = last ? nB : cB + (size_t)(t + 2) * kstep;
            const char* a3 = a2 + kstep; const char* b3 = b2 + kstep;
            PG8_LDB(B0, 0, 0); PG8_LDB(B1, 0, 1); PG8_SCHED; PG8_LDA(At, 0, 0); PG8_STAGE(PG8_SA(1, 1), a1 + hstep, voffA);
            PG8_WAIT_V(8); PG8_WAIT_L(0); PG8_BAR; PG8_MMA(0, 0, At, B0); PG8_MMA(0, 1, At, B1); PG8_BAR; PG8_SCHED;
            PG8_LDA(At, 0, 1); PG8_STAGE(PG8_SB(0, 0), b2, voffB); PG8_STAGE(PG8_SB(0, 1), b2 + hstep, voffB); PG8_STAGE(PG8_SA(0, 0), a2, voffA);
            PG8_WAIT_V(8); PG8_WAIT_L(0); PG8_BAR; PG8_MMA(1, 0, At, B0); PG8_MMA(1, 1, At, B1); PG8_BAR; PG8_SCHED;
            PG8_LDB(B0, 1, 0); PG8_LDB(B1, 1, 1); PG8_SCHED; PG8_LDA(At, 1, 0); PG8_STAGE(PG8_SA(0, 1), a2 + hstep, voffA);
            PG8_WAIT_V(8); PG8_WAIT_L(0); PG8_BAR; PG8_MMA(0, 0, At, B0); PG8_MMA(0, 1, At, B1); PG8_BAR; PG8_SCHED;
            PG8_LDA(At, 1, 1); PG8_STAGE(PG8_SB(1, 0), b3, voffB); PG8_STAGE(PG8_SB(1, 1), b3 + hstep, voffB); PG8_STAGE(PG8_SA(1, 0), a3, voffA);
            PG8_WAIT_V(8); PG8_WAIT_L(0); PG8_BAR; PG8_MMA(1, 0, At, B0); PG8_MMA(1, 1, At, B1); PG8_BAR; PG8_SCHED;
        }
        if constexpr (ALIGN_EPI) { if (wr == 0) PG8_BAR; }
        E(acc, cur, wr, wc, fr, fq);
        if (!has_next) break;
#pragma unroll
        for (int a = 0; a < 2; ++a)
#pragma unroll
            for (int b = 0; b < 2; ++b)
#pragma unroll
                for (int m = 0; m < 4; ++m)
#pragma unroll
                    for (int n = 0; n < 2; ++n) acc[a][b][m][n] = (f32x4){0.f, 0.f, 0.f, 0.f};
        cur = nxt; cA = nA; cB = nB; ++ui;
        if constexpr (ALIGN_EPI) { if (wr == 1) PG8_BAR; }
    }
    PG8_WAIT_V(0);
    if constexpr (!ALIGN_EPI) { if (wr == 0) PG8_BAR; }
    PG8_BAR;
#undef PG8_SA
#undef PG8_SB
#undef PG8_STAGE
#undef PG8_LDA
#undef PG8_LDB
#undef PG8_MMA
#undef PG8_WAIT_V
#undef PG8_WAIT_L
#undef PG8_BAR
#undef PG8_SCHED
}
}

using pg8::cvt_pk_bf16;
typedef f32x4 (&AccRef)[2][2][4][2];

__device__ __forceinline__ int cond_of_tile(int pm) { return pm < 32 ? 0 : 1 + ((pm - 32) >> 3); }
__device__ __forceinline__ float red_fq(float v) { v += __shfl_xor(v, 16); v += __shfl_xor(v, 32); return v; }
__device__ __forceinline__ float gelu_tanh(float x) { const float u = x + 0.044715f * x * x * x; return x * __builtin_amdgcn_rcpf(1.0f + __builtin_amdgcn_exp2f(-2.302208198f * u)); }
__device__ __forceinline__ float silu_f(float x) { return x * __builtin_amdgcn_rcpf(1.0f + __builtin_amdgcn_exp2f(-LOG2E * x)); }
__device__ __forceinline__ u32x4 pack8(const f32x4 a, const f32x4 b) { u32x4 w; w.x = cvt_pk_bf16(a[0], a[1]); w.y = cvt_pk_bf16(a[2], a[3]); w.z = cvt_pk_bf16(b[0], b[1]); w.w = cvt_pk_bf16(b[2], b[3]); return w; }
__device__ __forceinline__ float bf2f(unsigned short h) { return __uint_as_float((unsigned)h << 16); }

template <class T> __device__ __forceinline__ T ldg(const void* base, unsigned off) { return *(const T*)((const char*)base + off); }
template <class T> __device__ __forceinline__ void stg(void* base, unsigned off, T v) { *(T*)((char*)base + off) = v; }
__device__ __forceinline__ float ss4(const f32x4 v) { return (v[0] * v[0] + v[1] * v[1]) + (v[2] * v[2] + v[3] * v[3]); }

struct EpiRes {
    const float* xp; const float* xs; float* out; const float* gate; const float* nscale; bf16_t* An; float* ssn;
    __device__ __forceinline__ void operator()(AccRef acc, const pg8::Unit& u, int wr, int wc, int fr, int fq) const {
        const int cond = cond_of_tile(u.pm);
        const unsigned colbase = u.pn * 256 + wc * 32 + 8 * fq;
        const bool ctx = u.pm < 32;
        const float* xb = ctx ? xp : xs;
        const unsigned rsub = ctx ? 0u : (unsigned)NCTX;
        const unsigned moff = (cond * MODW + colbase) * 4u;
#pragma unroll
        for (int ai = 0; ai < 2; ++ai)
#pragma unroll
            for (int m = 0; m < 4; ++m) {
                const unsigned row = u.pm * 256 + ai * 128 + wr * 64 + m * 16 + fr;
                const unsigned xoff = ((row - rsub) * DM + colbase) * 4u, ooff = (row * DM + colbase) * 4u;
                float ssum = 0.f;
#pragma unroll
                for (int bj = 0; bj < 2; ++bj) {
                    f32x4 xn[2];
#pragma unroll
                    for (int n = 0; n < 2; ++n) {
                        const f32x4 xo = ldg<f32x4>(xb, xoff + bj * 512 + n * 16);
                        const f32x4 gt = ldg<f32x4>(gate, moff + bj * 512 + n * 16);
                        xn[n] = xo + gt * acc[ai][bj][m][n];
                        stg<f32x4>(out, ooff + bj * 512 + n * 16, xn[n]);
                        ssum += ss4(xn[n]);
                    }
                    if (An) {
                        const f32x4 s0 = ldg<f32x4>(nscale, moff + bj * 512) + 1.0f, s1 = ldg<f32x4>(nscale, moff + bj * 512 + 16) + 1.0f;
                        stg<u32x4>(An, (row * DM + colbase) * 2u + bj * 256, pack8(xn[0] * s0, xn[1] * s1));
                    }
                }
                if (ssn) { ssum = red_fq(ssum); if (fq == 0) atomicAdd((float*)((char*)ssn + row * 4u), ssum); }
                asm volatile("" ::: "memory");
            }
    }
};

template <bool EVEN>
struct EpiIn {
    const float* ss; const float* bias;
    const float* qg; const float* kg;
    const float* rope;
    bf16_t* Q; bf16_t* K; bf16_t* Vt; bf16_t* MIX; bf16_t* VbT; float* ssv;
    float* outk; float* outv;
    __device__ __forceinline__ void operator()(AccRef acc, const pg8::Unit& u, int wr, int wc, int fr, int fq) const {
        constexpr unsigned N = EVEN ? EVEN_IN : ODD_IN, QW = EVEN ? 512 : 1024, KVH = EVEN ? 2 : 4, KW = KVH * 64;
        const int cond = cond_of_tile(u.pm);
        int role; unsigned hidx;
        if (EVEN) { if (u.pn < 2) { role = 0; hidx = 4 * u.pn + wc; } else if (u.pn == 2) { role = wc < 2 ? 1 : 2; hidx = wc & 1; } else if (u.pn < 5) { role = 3; hidx = (u.pn - 3) * 4 + wc; } else { role = 4; hidx = (u.pn - 5) * 4 + wc; } }
        else { if (u.pn < 4) { role = 0; hidx = 4 * u.pn + wc; } else if (u.pn == 4) { role = 1; hidx = wc; } else { role = 2; hidx = wc; } }
        const unsigned boff = (cond * N + u.pn * 256 + wc * 32 + 8 * fq) * 4u;
        const bool lat = u.pm >= 32;
        const unsigned c8 = hidx * 64 + 8 * fq;
        const float* gp = role == 0 ? qg : kg;
#pragma unroll
        for (int ai = 0; ai < 2; ++ai)
#pragma unroll
            for (int m = 0; m < 4; ++m) {
                const unsigned row = u.pm * 256 + ai * 128 + wr * 64 + m * 16 + fr;
                const float rr = 1.0f / sqrtf(ldg<float>(ss, row * 4u) * (1.0f / DM) + EPS);
                f32x4 z[2][2];
#pragma unroll
                for (int bj = 0; bj < 2; ++bj)
#pragma unroll
                    for (int n = 0; n < 2; ++n) z[bj][n] = acc[ai][bj][m][n] * rr + ldg<f32x4>(bias, boff + bj * 512 + n * 16);
                if (role <= 1) {
                    float s2 = (ss4(z[0][0]) + ss4(z[0][1])) + (ss4(z[1][0]) + ss4(z[1][1]));
                    s2 = red_fq(s2);
                    const float rn = 1.0f / sqrtf(s2 * (1.0f / 64.0f) + EPS);
#pragma unroll
                    for (int bj = 0; bj < 2; ++bj)
#pragma unroll
                        for (int n = 0; n < 2; ++n) z[bj][n] = z[bj][n] * rn * ldg<f32x4>(gp, (8 * fq) * 4u + bj * 128 + n * 16);
                    if (role == 1 && !lat) {
#pragma unroll
                        for (int bj = 0; bj < 2; ++bj)
#pragma unroll
                            for (int n = 0; n < 2; ++n) stg<f32x4>(outk, (row * KW + c8) * 4u + bj * 128 + n * 16, z[bj][n]);
                    }
                    if (lat) {
                        const unsigned t = (row - NCTX) & 2047u;
#pragma unroll
                        for (int bj = 0; bj < 2; ++bj) {
                            const unsigned pos = bj == 0 ? (t >> 6) : (t & 63u);
#pragma unroll
                            for (int n = 0; n < 2; ++n) {
                                const f32x4 cs = ldg<f32x4>(rope, (pos * 16 + 4 * fq) * 8u + n * 16);
                                const f32x4 v = z[bj][n];
                                z[bj][n] = (f32x4){v[0] * cs[0] - v[1] * cs[1], v[0] * cs[1] + v[1] * cs[0], v[2] * cs[2] - v[3] * cs[3], v[2] * cs[3] + v[3] * cs[2]};
                            }
                        }
                    }
                    if (role == 0) {
#pragma unroll
                        for (int bj = 0; bj < 2; ++bj) stg<u32x4>(Q, (row * QW + c8) * 2u + bj * 64, pack8(z[bj][0] * 0.125f, z[bj][1] * 0.125f));
                    } else {
#pragma unroll
                        for (int bj = 0; bj < 2; ++bj) stg<u32x4>(K, (row * KW + c8) * 2u + bj * 64, pack8(z[bj][0], z[bj][1]));
                    }
                } else if (role == 2) {
                    if (!lat) {
#pragma unroll
                        for (int bj = 0; bj < 2; ++bj)
#pragma unroll
                            for (int n = 0; n < 2; ++n) stg<f32x4>(outv, (row * KW + c8) * 4u + bj * 128 + n * 16, z[bj][n]);
                    }
                    unsigned vb, T;
                    if (!lat) { T = 256; vb = ((row >> 8) * KVH + hidx) * 64 * 256 + (row & 255u); }
                    else { T = 2048; vb = NCTX * KW + (((row - NCTX) >> 11) * KVH + hidx) * 64 * 2048 + ((row - NCTX) & 2047u); }
                    vb += 8 * fq * T;
#pragma unroll
                    for (int bj = 0; bj < 2; ++bj)
#pragma unroll
                        for (int n = 0; n < 2; ++n)
#pragma unroll
                            for (int i = 0; i < 4; ++i) stg<bf16_t>(Vt, (vb + (32 * bj + 4 * n + i) * T) * 2u, (bf16_t)(cvt_pk_bf16(z[bj][n][i], 0.f) & 0xffffu));
                } else if (EVEN && role == 3) {
#pragma unroll
                    for (int bj = 0; bj < 2; ++bj) {
                        f32x4 a = z[bj][0], b = z[bj][1];
#pragma unroll
                        for (int i = 0; i < 4; ++i) { a[i] = gelu_tanh(a[i]); b[i] = gelu_tanh(b[i]); }
                        stg<u32x4>(MIX, (row * DM + 512 + c8) * 2u + bj * 64, pack8(a, b));
                    }
                } else if (EVEN) {
                    float s2 = 0.f;
                    const unsigned cb = (row >> 7) * 512 * 128 + (row & 127u) + c8 * 128;
#pragma unroll
                    for (int bj = 0; bj < 2; ++bj)
#pragma unroll
                        for (int n = 0; n < 2; ++n)
#pragma unroll
                            for (int i = 0; i < 4; ++i) {
                                const float gv = gelu_tanh(z[bj][n][i]); s2 += gv * gv;
                                stg<bf16_t>(VbT, (cb + (32 * bj + 4 * n + i) * 128) * 2u, (bf16_t)(cvt_pk_bf16(gv, 0.f) & 0xffffu));
                            }
                    s2 = red_fq(s2);
                    if (fq == 0) atomicAdd((float*)((char*)ssv + row * 4u), s2);
                }
                asm volatile("" ::: "memory");
            }
    }
};

template <int CTRL> __device__ __forceinline__ float dpp_rot(float v) { return __builtin_bit_cast(float, __builtin_amdgcn_update_dpp(0, __builtin_bit_cast(int, v), CTRL, 0xf, 0xf, false)); }
struct EpiUp {
    const float* ss; const float* bias; const float* cw; const float* cbias;
    float* ZB; bf16_t* ACT; LAS float* xch;
    __device__ __forceinline__ void operator()(AccRef acc, const pg8::Unit& u, int wr, int wc, int fr, int fq) const {
        const int cond = cond_of_tile(u.pm);
        const unsigned nb = u.pn * 256 + wc * 32 + 8 * fq;
        const unsigned boff = (cond * FF2 + nb) * 4u;
#pragma unroll
        for (int ai = 0; ai < 2; ++ai)
#pragma unroll
            for (int m = 0; m < 4; ++m) {
                const unsigned row = u.pm * 256 + ai * 128 + wr * 64 + m * 16 + fr;
                const float rr = 1.0f / sqrtf(ldg<float>(ss, row * 4u) * (1.0f / DM) + EPS);
#pragma unroll
                for (int bj = 0; bj < 2; ++bj)
#pragma unroll
                    for (int n = 0; n < 2; ++n) acc[ai][bj][m][n] = acc[ai][bj][m][n] * rr + ldg<f32x4>(bias, boff + bj * 512 + n * 16);
            }
        if (wr == 0 && fr < 2) {
            const unsigned zo = ((u.pm * 4 + fr) * FF2 + nb) * 4u;
#pragma unroll
            for (int bj = 0; bj < 2; ++bj)
#pragma unroll
                for (int n = 0; n < 2; ++n) stg<f32x4>(ZB, zo + bj * 512 + n * 16, acc[0][bj][0][n]);
        }
        if (wr == 1 && fr >= 14) {
            const unsigned zo = ((u.pm * 4 + 2 + (fr - 14)) * FF2 + nb) * 4u;
#pragma unroll
            for (int bj = 0; bj < 2; ++bj)
#pragma unroll
                for (int n = 0; n < 2; ++n) stg<f32x4>(ZB, zo + bj * 512 + n * 16, acc[1][bj][3][n]);
        }
        LAS float* my = xch + (wr * 4 + wc) * 256 + 8 * fq;
        if (fr == 0) {
#pragma unroll
            for (int ai = 0; ai < 2; ++ai)
#pragma unroll
                for (int bj = 0; bj < 2; ++bj)
#pragma unroll
                    for (int n = 0; n < 2; ++n) *(LAS f32x4*)(my + ai * 128 + bj * 32 + 4 * n) = acc[ai][bj][0][n];
        }
        if (fr == 15) {
#pragma unroll
            for (int ai = 0; ai < 2; ++ai)
#pragma unroll
                for (int bj = 0; bj < 2; ++bj)
#pragma unroll
                    for (int n = 0; n < 2; ++n) *(LAS f32x4*)(my + ai * 128 + 64 + bj * 32 + 4 * n) = acc[ai][bj][3][n];
        }
        asm volatile("s_waitcnt lgkmcnt(0)" ::: "memory"); __builtin_amdgcn_s_barrier(); asm volatile("" ::: "memory");
        const unsigned chb = u.pn * 128 + wc * 32 + 8 * fq;
        const float* cw1 = cw + FF2; const float* cw2 = cw + 2 * FF2;
#pragma unroll
        for (int ai = 0; ai < 2; ++ai) {
            const bool hasp = !(ai == 0 && wr == 0), hasn = !(ai == 1 && wr == 1);
            const LAS float* pp = xch + ((wr == 1 ? 0 : 4) + wc) * 256 + (wr == 1 ? ai : 0) * 128 + 64 + 8 * fq;
            const LAS float* pn = xch + ((wr == 0 ? 4 : 0) + wc) * 256 + (wr == 0 ? ai : 1) * 128 + 8 * fq;
            const unsigned arow = ((u.pm * 256 + ai * 128 + wr * 64 + fr) * FF + chb) * 2u;
#pragma unroll
            for (int n = 0; n < 2; ++n) {
                f32x4 sg[4];
#pragma unroll
                for (int pass = 0; pass < 2; ++pass) {
                    const int bj = 1 - pass;
                    const unsigned ci = (bj * FF + chb + 4 * n) * 4u;
                    const f32x4 w0 = ldg<f32x4>(cw, ci), w1 = ldg<f32x4>(cw1, ci), w2 = ldg<f32x4>(cw2, ci), cb = ldg<f32x4>(cbias, ci);
                    f32x4 hp = (f32x4){0.f, 0.f, 0.f, 0.f}, hn = (f32x4){0.f, 0.f, 0.f, 0.f};
                    if (hasp) hp = *(const LAS f32x4*)(pp + bj * 32 + 4 * n);
                    if (hasn) hn = *(const LAS f32x4*)(pn + bj * 32 + 4 * n);
                    f32x4 prevsrc = hp;
#pragma unroll
                    for (int m = 0; m < 4; ++m) {
                        const f32x4 zc = acc[ai][bj][m][n];
                        const f32x4 nsrc = m < 3 ? acc[ai][bj][m < 3 ? m + 1 : 3][n] : hn;
                        f32x4 pv, nv;
#pragma unroll
                        for (int i = 0; i < 4; ++i) {
                            pv[i] = dpp_rot<0x121>(fr == 15 ? prevsrc[i] : zc[i]);
                            nv[i] = dpp_rot<0x12F>(fr == 0 ? nsrc[i] : zc[i]);
                        }
                        f32x4 res = cb + w0 * pv + w1 * zc + w2 * nv;
                        prevsrc = zc;
                        if (pass == 0) {
#pragma unroll
                            for (int i = 0; i < 4; ++i) res[i] = silu_f(res[i]);
                            sg[m] = res;
                        } else {
                            res = res * sg[m];
                            stg<u32x2>(ACT, arow + m * (16 * FF * 2) + n * 8, (u32x2){cvt_pk_bf16(res[0], res[1]), cvt_pk_bf16(res[2], res[3])});
                        }
                    }
                    asm volatile("" ::: "memory");
                }
                asm volatile("" ::: "memory");
            }
        }
    }
};

__device__ __forceinline__ int crow(int r, int hi) { return (r & 3) + 8 * (r >> 2) + 4 * hi; }
constexpr int AK_STR = 144, AV_STR = 136, AK_BYTES = 64 * AK_STR, AV_BYTES = 64 * AV_STR;
__device__ __forceinline__ void attn_unit(LAS unsigned char* lds, const bf16_t* Q, int qstride, bf16_t* O, int ostride,
                                          const bf16_t* K0, int ks0, const bf16_t* V0, int vs0, int t0lo, int nt0,
                                          const bf16_t* K1, int ks1, const bf16_t* V1, int vs1, int nt1,
                                          float m_init, float l_init, int win_q0) {
    const int tid = threadIdx.x, lane = tid & 63, r32 = lane & 31, hi = lane >> 5, wid = __builtin_amdgcn_readfirstlane(tid >> 6);
    const int qrow = wid * 32 + r32;
    bf16x8 qf[4];
#pragma unroll
    for (int d0 = 0; d0 < 4; ++d0) qf[d0] = *(const bf16x8*)(Q + (size_t)qrow * qstride + d0 * 16 + hi * 8);
    float mrun = m_init, lrun = hi == 0 ? l_init : 0.f;
    f32x16 o0 = {}, o1 = {};
    const int NT = nt0 + nt1;
    const int lrow = tid >> 3, lch = tid & 7;
    LAS unsigned char* kb0 = lds; LAS unsigned char* vb0 = lds + 2 * AK_BYTES;
    u32x4 kreg, vreg;
    auto gload = [&](int t) {
        const bf16_t* kp; const bf16_t* vp;
        if (t < nt0) { kp = K0 + (size_t)((t0lo + t) * 64 + lrow) * ks0 + lch * 8; vp = V0 + (size_t)lrow * vs0 + (t0lo + t) * 64 + lch * 8; }
        else { kp = K1 + (size_t)((t - nt0) * 64 + lrow) * ks1 + lch * 8; vp = V1 + (size_t)lrow * vs1 + (t - nt0) * 64 + lch * 8; }
        kreg = *(const u32x4*)kp; vreg = *(const u32x4*)vp;
    };
    auto lstore = [&](int buf) {
        *(LAS u32x4*)(kb0 + buf * AK_BYTES + lrow * AK_STR + lch * 16) = kreg;
        LAS unsigned char* vd = vb0 + buf * AV_BYTES + lrow * AV_STR + lch * 16;
        *(LAS u32x2*)(vd) = (u32x2){vreg.x, vreg.y}; *(LAS u32x2*)(vd + 8) = (u32x2){vreg.z, vreg.w};
    };
    gload(0); lstore(0);
    asm volatile("s_waitcnt lgkmcnt(0)" ::: "memory"); __builtin_amdgcn_s_barrier(); asm volatile("" ::: "memory");
    for (int t = 0; t < NT; ++t) {
        const int buf = t & 1;
        if (t + 1 < NT) gload(t + 1);
        bool active = true;
        int key0 = 0;
        if (win_q0 >= 0 && t < nt0) {
            key0 = (t0lo + t) * 64;
            const int qw0 = win_q0 + wid * 32;
            active = !(key0 + 63 < qw0 - 128 || key0 > qw0 + 31 + 128);
        }
        if (active) {
            const LAS unsigned char* kb = kb0 + buf * AK_BYTES + r32 * AK_STR + hi * 16;
            f32x16 p0 = {}, p1 = {};
#pragma unroll
            for (int d0 = 0; d0 < 4; ++d0) {
                const bf16x8 k0 = *(const LAS bf16x8*)(kb + d0 * 32);
                const bf16x8 k1 = *(const LAS bf16x8*)(kb + 32 * AK_STR + d0 * 32);
                p0 = __builtin_amdgcn_mfma_f32_32x32x16_bf16(k0, qf[d0], p0, 0, 0, 0);
                p1 = __builtin_amdgcn_mfma_f32_32x32x16_bf16(k1, qf[d0], p1, 0, 0, 0);
            }
#pragma unroll
            for (int r = 0; r < 16; ++r) { p0[r] *= LOG2E; p1[r] *= LOG2E; }
            if (win_q0 >= 0 && t < nt0) {
                const int qpos = win_q0 + qrow;
#pragma unroll
                for (int r = 0; r < 16; ++r) {
                    const int kp = key0 + crow(r, hi);
                    int dlt = kp - qpos; if (dlt < 0) dlt = -dlt; if (dlt > 128) p0[r] = -INFINITY;
                    dlt = kp + 32 - qpos; if (dlt < 0) dlt = -dlt; if (dlt > 128) p1[r] = -INFINITY;
                }
            }
            float mx = fmaxf(p0[0], p1[0]);
#pragma unroll
            for (int r = 1; r < 16; ++r) mx = fmaxf(mx, fmaxf(p0[r], p1[r]));
            mx = fmaxf(mx, __shfl_xor(mx, 32));
            const float mnew = fmaxf(mrun, mx);
            const float alpha = __builtin_amdgcn_exp2f(mrun - mnew);
            mrun = mnew;
            float ls = 0.f;
#pragma unroll
            for (int r = 0; r < 16; ++r) { p0[r] = __builtin_amdgcn_exp2f(p0[r] - mnew); p1[r] = __builtin_amdgcn_exp2f(p1[r] - mnew); ls += p0[r] + p1[r]; }
            lrun = lrun * alpha + ls;
#pragma unroll
            for (int r = 0; r < 16; ++r) { o0[r] *= alpha; o1[r] *= alpha; }
            bf16x8 pw[4];
#pragma unroll
            for (int ks = 0; ks < 4; ++ks) {
                u32x4 w;
                if (ks < 2) { w.x = cvt_pk_bf16(p0[8 * ks + 0], p0[8 * ks + 1]); w.y = cvt_pk_bf16(p0[8 * ks + 2], p0[8 * ks + 3]); w.z = cvt_pk_bf16(p0[8 * ks + 4], p0[8 * ks + 5]); w.w = cvt_pk_bf16(p0[8 * ks + 6], p0[8 * ks + 7]); }
                else { const int k2 = ks - 2; w.x = cvt_pk_bf16(p1[8 * k2 + 0], p1[8 * k2 + 1]); w.y = cvt_pk_bf16(p1[8 * k2 + 2], p1[8 * k2 + 3]); w.z = cvt_pk_bf16(p1[8 * k2 + 4], p1[8 * k2 + 5]); w.w = cvt_pk_bf16(p1[8 * k2 + 6], p1[8 * k2 + 7]); }
                pw[ks] = __builtin_bit_cast(bf16x8, w);
            }
            const LAS unsigned char* vb = vb0 + buf * AV_BYTES + r32 * AV_STR + hi * 8;
#pragma unroll
            for (int ks = 0; ks < 4; ++ks) {
                const u32x2 a0 = *(const LAS u32x2*)(vb + ks * 32), a1 = *(const LAS u32x2*)(vb + ks * 32 + 16);
                const u32x2 b0 = *(const LAS u32x2*)(vb + 32 * AV_STR + ks * 32), b1 = *(const LAS u32x2*)(vb + 32 * AV_STR + ks * 32 + 16);
                const bf16x8 va = __builtin_bit_cast(bf16x8, (u32x4){a0.x, a0.y, a1.x, a1.y});
                const bf16x8 vbb = __builtin_bit_cast(bf16x8, (u32x4){b0.x, b0.y, b1.x, b1.y});
                o0 = __builtin_amdgcn_mfma_f32_32x32x16_bf16(va, pw[ks], o0, 0, 0, 0);
                o1 = __builtin_amdgcn_mfma_f32_32x32x16_bf16(vbb, pw[ks], o1, 0, 0, 0);
            }
        }
        if (t + 1 < NT) lstore(buf ^ 1);
        asm volatile("s_waitcnt lgkmcnt(0)" ::: "memory"); __builtin_amdgcn_s_barrier(); asm volatile("" ::: "memory");
    }
    float lt = lrun + __shfl_xor(lrun, 32);
    const float inv = 1.0f / lt;
    bf16_t* orow = O + (size_t)qrow * ostride;
#pragma unroll
    for (int r4 = 0; r4 < 4; ++r4) {
        u32x2 w0, w1;
        w0.x = cvt_pk_bf16(o0[4 * r4 + 0] * inv, o0[4 * r4 + 1] * inv); w0.y = cvt_pk_bf16(o0[4 * r4 + 2] * inv, o0[4 * r4 + 3] * inv);
        w1.x = cvt_pk_bf16(o1[4 * r4 + 0] * inv, o1[4 * r4 + 1] * inv); w1.y = cvt_pk_bf16(o1[4 * r4 + 2] * inv, o1[4 * r4 + 3] * inv);
        *(u32x2*)(orow + 8 * r4 + 4 * hi) = w0;
        *(u32x2*)(orow + 32 + 8 * r4 + 4 * hi) = w1;
    }
}

__device__ __forceinline__ void spatial_unit(int chunk, int g, const float* w_s, const float* b_s, const float* v_gain, const float* ssv, const bf16_t* VbT, bf16_t* MIX) {
    const int tid = threadIdx.x, lane = tid & 63, r32 = lane & 31, hi = lane >> 5, wid = __builtin_amdgcn_readfirstlane(tid >> 6);
    const int pblk = wid & 3, chalf = wid >> 2;
    const int p = 32 * pblk + r32;
    bf16x8 yf[8];
#pragma unroll
    for (int ks = 0; ks < 8; ++ks) {
        const int q = 16 * ks + 8 * hi;
        const f32x4 w0 = *(const f32x4*)(w_s + ((size_t)g * 128 + p) * 128 + q), w1 = *(const f32x4*)(w_s + ((size_t)g * 128 + p) * 128 + q + 4);
        const f32x4 s0 = *(const f32x4*)(ssv + chunk * 128 + q), s1 = *(const f32x4*)(ssv + chunk * 128 + q + 4);
        f32x4 a, b;
#pragma unroll
        for (int i = 0; i < 4; ++i) { a[i] = w0[i] / sqrtf(s0[i] * (1.0f / 512.0f) + EPS); b[i] = w1[i] / sqrtf(s1[i] * (1.0f / 512.0f) + EPS); }
        yf[ks] = __builtin_bit_cast(bf16x8, pack8(a, b));
    }
    const float bs = b_s[g * 128 + p];
    const int row = chunk * 128 + p;
#pragma unroll
    for (int cbk = 0; cbk < 2; ++cbk) {
        const int cblk = 2 * chalf + cbk;
        const bf16_t* xr = VbT + ((size_t)chunk * 512 + 128 * g + 32 * cblk + r32) * 128 + 8 * hi;
        f32x16 acc = {};
#pragma unroll
        for (int ks = 0; ks < 8; ++ks) { const bf16x8 xf = *(const bf16x8*)(xr + 16 * ks); acc = __builtin_amdgcn_mfma_f32_32x32x16_bf16(xf, yf[ks], acc, 0, 0, 0); }
#pragma unroll
        for (int r4 = 0; r4 < 4; ++r4) {
            const int ch = 128 * g + 32 * cblk + 8 * r4 + 4 * hi;
            const f32x4 gn = *(const f32x4*)(v_gain + ch);
            bf16_t* up = MIX + (size_t)row * DM + 512 + ch;
            const u32x2 uu = *(const u32x2*)up;
            const float u0 = __uint_as_float(uu.x << 16), u1 = __uint_as_float(uu.x & 0xffff0000u), u2 = __uint_as_float(uu.y << 16), u3 = __uint_as_float(uu.y & 0xffff0000u);
            u32x2 w;
            w.x = cvt_pk_bf16(u0 * (gn[0] * acc[4 * r4 + 0] + bs), u1 * (gn[1] * acc[4 * r4 + 1] + bs));
            w.y = cvt_pk_bf16(u2 * (gn[2] * acc[4 * r4 + 2] + bs), u3 * (gn[3] * acc[4 * r4 + 3] + bs));
            *(u32x2*)up = w;
        }
    }
}

__device__ __forceinline__ unsigned f2bf(float f) { unsigned u = __builtin_bit_cast(unsigned, f); return (u + 0x7fffu + ((u >> 16) & 1u)) >> 16; }
__device__ __forceinline__ unsigned pk2(float lo, float hi) { return f2bf(lo) | (f2bf(hi) << 16); }
__device__ __forceinline__ float wave_sum(float v) {
#pragma unroll
    for (int o = 1; o < 64; o <<= 1) v += __shfl_xor(v, o);
    return v;
}
__device__ __forceinline__ void transpose_item(const float* W, int K, int N, bf16_t* WT, int k0, int n0, int drow, LAS float* scr, int lane) {
#pragma unroll 8
    for (int i = 0; i < 32; ++i) { const int kk = 2 * i + (lane >> 5); scr[kk * 33 + (lane & 31)] = W[(size_t)(k0 + kk) * N + n0 + (lane & 31)]; }
    asm volatile("s_waitcnt lgkmcnt(0)" ::: "memory");
    const int c = lane & 7;
#pragma unroll
    for (int j = 0; j < 4; ++j) { const int n = (lane >> 3) + 8 * j; const LAS float* s = scr + (8 * c) * 33 + n;
        u32x4 o; o.x = pk2(s[0 * 33], s[1 * 33]); o.y = pk2(s[2 * 33], s[3 * 33]); o.z = pk2(s[4 * 33], s[5 * 33]); o.w = pk2(s[6 * 33], s[7 * 33]);
        *(u32x4*)(WT + (size_t)(drow + n) * K + k0 + 8 * c) = o; }
    asm volatile("s_waitcnt lgkmcnt(0)" ::: "memory");
}
__device__ __forceinline__ int perm_in(int n0) { const int pn = n0 >> 8, rem = n0 & 255; return pn * 256 + ((rem & 63) >> 5) * 128 + (rem >> 6) * 32; }
__device__ __forceinline__ int perm_up(int n0) { const int half = n0 / FF, ch = n0 % FF; return (ch >> 7) * 256 + half * 128 + (ch & 127); }


#define XB_TMO      128
#define XB_XCNT(j)  (256  + 64 * (j))
#define XB_XSUB(j)  (1280 + 64 * (j))
#define XB_XGEN(j)  (2304 + 64 * (j))
#define XB_TOP      3328
#define XB_TOPGEN   3392
#define XCD_BAR_WORDS 3456
#define XB_SPIN_CAP (1u << 18)
__device__ __forceinline__ unsigned xb_ld(unsigned* p)              { return __hip_atomic_load(p, __ATOMIC_RELAXED, __HIP_MEMORY_SCOPE_AGENT); }
__device__ __forceinline__ unsigned xb_add(unsigned* p, unsigned v) { return __hip_atomic_fetch_add(p, v, __ATOMIC_RELAXED, __HIP_MEMORY_SCOPE_AGENT); }
__device__ __forceinline__ unsigned xb_xcc_id() { return (unsigned)__builtin_amdgcn_s_getreg((3 << 11) | 20) & 0xFu; }
#define XB_SPIN(cond, bar) do { unsigned _sp = 0; while (cond) { __builtin_amdgcn_s_sleep(1); \
    if ((++_sp & 255u) == 0u) { if (xb_ld(&(bar)[XB_TMO])) break; if (_sp > XB_SPIN_CAP) { atomicAdd(&(bar)[XB_TMO], 1u); break; } } } } while (0)
struct XcdBarrier { unsigned* bar; unsigned x; volatile LAS unsigned* st; };
__device__ __forceinline__ XcdBarrier xcd_barrier_post(unsigned* bar, volatile LAS unsigned* st) {
    XcdBarrier b; b.bar = bar; b.x = xb_xcc_id(); b.st = st;
    if (threadIdx.x == 0) (void)xb_add(&bar[XB_XCNT(b.x)], 1u);
    return b;
}
__device__ __forceinline__ void xcd_barrier_complete(unsigned* bar, unsigned x, unsigned& nloc, unsigned& nx) {
    const unsigned G = gridDim.x * gridDim.y * gridDim.z;
    unsigned sum, cnt, mine, sp = 0u;
    for (;;) {
        sum = 0u; cnt = 0u; mine = 0u;
#pragma unroll
        for (unsigned j = 0; j < 16; ++j) { const unsigned c = xb_ld(&bar[XB_XCNT(j)]); sum += c; cnt += (c > 0u) ? 1u : 0u; mine = (j == x) ? c : mine; }
        if (sum == G) break;
        __builtin_amdgcn_s_sleep(1);
        if ((++sp & 255u) == 0u) { if (xb_ld(&bar[XB_TMO])) break; if (sp > XB_SPIN_CAP) { atomicAdd(&bar[XB_TMO], 1u); break; } }
    }
    nloc = mine > 0u ? mine : 1u; nx = cnt > 0u ? cnt : 1u;
}
__device__ __forceinline__ void xcd_barrier(const XcdBarrier& b) {
    asm volatile("s_waitcnt vmcnt(0)" ::: "memory");
    __syncthreads();
    if (threadIdx.x == 0) {
        unsigned* bar = b.bar;
        __builtin_amdgcn_s_waitcnt(0);
        unsigned nloc = b.st[0], nx = b.st[1];
        if (nloc == 0u) { xcd_barrier_complete(bar, b.x, nloc, nx); b.st[0] = nloc; b.st[1] = nx; }
        const unsigned old = xb_add(&bar[XB_XSUB(b.x)], 1u);
        const unsigned gen = old / nloc;
        if (old + 1u == (gen + 1u) * nloc) {
            __builtin_amdgcn_fence(__ATOMIC_RELEASE, "agent");
            asm volatile("s_waitcnt vmcnt(0)" ::: "memory");
            const unsigned og = xb_add(&bar[XB_TOP], 1u);
            const unsigned tg = og / nx;
            if (og + 1u == (tg + 1u) * nx) xb_add(&bar[XB_TOPGEN], 1u);
            else XB_SPIN(xb_ld(&bar[XB_TOPGEN]) == tg, bar);
            __builtin_amdgcn_fence(__ATOMIC_ACQUIRE, "agent");
            xb_add(&bar[XB_XGEN(b.x)], 1u);
            asm volatile("s_waitcnt vmcnt(0)" ::: "memory");
        } else {
            XB_SPIN(xb_ld(&bar[XB_XGEN(b.x)]) == gen, bar);
            __builtin_amdgcn_fence(__ATOMIC_ACQUIRE, "agent");
            asm volatile("s_waitcnt vmcnt(0)" ::: "memory");
        }
    }
    __syncthreads();
}

template <bool COOP>
__global__ void __launch_bounds__(512, 2) mk_fwd(Params P) {
    extern __shared__ __attribute__((aligned(16))) unsigned char lds_raw[];
    LAS unsigned char* lds = (LAS unsigned char*)lds_raw;
    const int tid = threadIdx.x, lane = tid & 63, wave = __builtin_amdgcn_readfirstlane(tid >> 6);
    const int G = gridDim.x, bx = blockIdx.x;
    const int gw = bx * 8 + wave, NGW = G * 8;
    unsigned char* ws = P.ws;
    float* out = P.out;
    typedef const float* cfp_t; typedef __attribute__((address_space(4))) const cfp_t* kargp_t;
#define INP(i) ({ kargp_t kp_ = (kargp_t)__builtin_amdgcn_kernarg_segment_ptr(); asm volatile("" : "+s"(kp_)); kp_[i]; })
#define out_ka (out + (size_t)MTOK * DM)
#define out_va (out + (size_t)MTOK * DM + NCTX * 128)
#define out_kc (out + (size_t)MTOK * DM + NCTX * 256)
#define out_vc (out + (size_t)MTOK * DM + NCTX * 512)
#define mod ((float*)(ws + WS_MOD))
#define ss0 ((float*)(ws + WS_SS0))
#define ss1 ((float*)(ws + WS_SS1))
#define ss2 ((float*)(ws + WS_SS2))
#define ss3 ((float*)(ws + WS_SS3))
#define ssv ((float*)(ws + WS_SSV))
#define rope ((float*)(ws + WS_ROPE))
#define biasw ((float*)(ws + WS_BIAS))
#define ZB ((float*)(ws + WS_ZB))
#define CK_A ((bf16_t*)(ws + WS_CK_A))
#define CVT_A ((bf16_t*)(ws + WS_CVT_A))
#define CK_C ((bf16_t*)(ws + WS_CK_C))
#define CVT_C ((bf16_t*)(ws + WS_CVT_C))
#define W_INE ((bf16_t*)(ws + WS_W_INE))
#define W_OUTE ((bf16_t*)(ws + WS_W_OUTE))
#define W_INO ((bf16_t*)(ws + WS_W_INO))
#define W_OUTO ((bf16_t*)(ws + WS_W_OUTO))
#define W_UP ((bf16_t*)(ws + WS_W_UP))
#define W_DN ((bf16_t*)(ws + WS_W_DN))
#define Abuf ((bf16_t*)(ws + WS_A))
#define ACT ((bf16_t*)(ws + WS_ACT))
#define MIX ((bf16_t*)(ws + WS_MIX))
#define Qb ((bf16_t*)(ws + WS_Q))
#define KE ((bf16_t*)(ws + WS_KE))
#define VTE ((bf16_t*)(ws + WS_VTE))
#define VBT ((bf16_t*)(ws + WS_VBT))
#define KO ((bf16_t*)(ws + WS_KO))
#define VTO ((bf16_t*)(ws + WS_VTO))
    LAS float* spare = (LAS float*)(lds + LDS_SPARE);

    const int lo = P.ph_lo, hi = P.ph_hi;
    XcdBarrier xbar; xbar.bar = (unsigned*)(ws + WS_BAR); xbar.x = 0; xbar.st = (volatile LAS unsigned*)(lds + LDS_SPARE + 12288);
    if constexpr (COOP) {
        if (tid < 2) ((LAS unsigned*)(lds + LDS_SPARE + 12288))[tid] = 0u;
        __syncthreads();
        xbar = xcd_barrier_post((unsigned*)(ws + WS_BAR), (volatile LAS unsigned*)(lds + LDS_SPARE + 12288));
    }
#ifndef MK_PHMASK
#define MK_PHMASK 0x3fff
#endif
#define IN(k) ((((MK_PHMASK) >> (k)) & 1) && lo <= (k) && (k) < hi)
#define SEAM(k) do { if constexpr (COOP) { if (IN(k) && IN((k) + 1)) { if ((k) == 0) cg::this_grid().sync(); else xcd_barrier(xbar); } } } while (0)

    if (IN(0)) {
        const float* c_in = INP(6); const float* c_ctx = INP(7); const float* w_mod = INP(8); const float* b_mod = INP(9);
        for (int it = bx; it < 2 * 24 * 16; it += G) {
            const int l = it / 384, cbk = (it % 384) / 16, ksp = it % 16;
            __syncthreads();
            for (int i = tid; i < NCOND * 64; i += 512) { const int cd = i >> 6, k = ksp * 64 + (i & 63); const float v = cd == 0 ? c_ctx[k] : c_in[(cd - 1) * DM + k]; spare[i] = v / (1.0f + __expf(-v)); }
            __syncthreads();
            const int col = cbk * 256 + (tid & 255), kh = tid >> 8;
            float a[NCOND];
#pragma unroll
            for (int cd = 0; cd < NCOND; ++cd) a[cd] = 0.f;
            const float* wp = w_mod + ((size_t)l * DM + ksp * 64 + kh * 32) * MODW + col;
#pragma unroll 4
            for (int k = 0; k < 32; ++k) { const float w = wp[(size_t)k * MODW];
#pragma unroll
                for (int cd = 0; cd < NCOND; ++cd) a[cd] += spare[cd * 64 + kh * 32 + k] * w; }
            const float bm = (ksp == 0 && kh == 0) ? b_mod[l * MODW + col] : 0.f;
#pragma unroll
            for (int cd = 0; cd < NCOND; ++cd) atomicAdd(mod + ((size_t)l * NCOND + cd) * MODW + col, a[cd] + bm);
        }
        __syncthreads();
        {
            const float* w_in_even = INP(10); const float* w_out_even = INP(16); const float* w_in_odd = INP(17); const float* w_out_odd = INP(21); const float* w_up = INP(22); const float* w_down = INP(25);
            LAS float* scr = (LAS float*)(lds + wave * 16384);
            constexpr int I_INE = 16 * 56, I_OUT = 16 * 32, I_INO = 16 * 48, I_UP = 16 * 176, I_DN = 44 * 32;
            constexpr int NIT = I_INE + 2 * I_OUT + I_INO + 2 * I_UP + 2 * I_DN;
            for (int it = gw; it < NIT; it += NGW) {
                int r = it;
                if (r < I_INE) { const int kb = r / 56, nb = r % 56; transpose_item(w_in_even, DM, EVEN_IN, W_INE, 64 * kb, 32 * nb, perm_in(32 * nb), scr, lane); continue; } r -= I_INE;
                if (r < I_OUT) { const int kb = r / 32, nb = r % 32; transpose_item(w_out_even, DM, DM, W_OUTE, 64 * kb, 32 * nb, 32 * nb, scr, lane); continue; } r -= I_OUT;
                if (r < I_INO) { const int kb = r / 48, nb = r % 48; transpose_item(w_in_odd, DM, ODD_IN, W_INO, 64 * kb, 32 * nb, perm_in(32 * nb), scr, lane); continue; } r -= I_INO;
                if (r < I_OUT) { const int kb = r / 32, nb = r % 32; transpose_item(w_out_odd, DM, DM, W_OUTO, 64 * kb, 32 * nb, 32 * nb, scr, lane); continue; } r -= I_OUT;
                if (r < 2 * I_UP) { const int l = r / I_UP, q = r % I_UP, kb = q / 176, nb = q % 176; transpose_item(w_up + (size_t)l * DM * FF2, DM, FF2, W_UP + (size_t)l * FF2 * DM, 64 * kb, 32 * nb, perm_up(32 * nb), scr, lane); continue; } r -= 2 * I_UP;
                { const int l = r / I_DN, q = r % I_DN, kb = q / 32, nb = q % 32; transpose_item(w_down + (size_t)l * FF * DM, FF, DM, W_DN + (size_t)l * DM * FF, 64 * kb, 32 * nb, 32 * nb, scr, lane); }
            }
        }
        {
            const float* cache_k_attn = INP(2); const float* cache_v_attn = INP(3); const float* cache_k_swa = INP(4); const float* cache_v_swa = INP(5);
            const int gt = bx * 512 + tid, NT_ = G * 512;
            for (int i = gt; i < 8 * 512 * 128 / 4; i += NT_) { const f32x4 v = *(const f32x4*)(cache_k_attn + (size_t)i * 4); *(u32x2*)(CK_A + (size_t)i * 4) = (u32x2){pk2(v[0], v[1]), pk2(v[2], v[3])}; }
            for (int i = gt; i < 8 * 512 * 256 / 4; i += NT_) { const f32x4 v = *(const f32x4*)(cache_k_swa + (size_t)i * 4); *(u32x2*)(CK_C + (size_t)i * 4) = (u32x2){pk2(v[0], v[1]), pk2(v[2], v[3])}; }
            for (int i = gt; i < 8 * 64 * 128; i += NT_) { const int cd = i & 127, pc = (i >> 7) & 63, b = i >> 13; const float* s = cache_v_attn + ((size_t)b * 512 + pc * 8) * 128 + cd;
                u32x4 o; o.x = pk2(s[0], s[128]); o.y = pk2(s[256], s[384]); o.z = pk2(s[512], s[640]); o.w = pk2(s[768], s[896]);
                *(u32x4*)(CVT_A + ((size_t)b * 128 + cd) * 512 + pc * 8) = o; }
            for (int i = gt; i < 8 * 64 * 256; i += NT_) { const int cd = i & 255, pc = (i >> 8) & 63, b = i >> 14; const float* s = cache_v_swa + ((size_t)b * 512 + pc * 8) * 256 + cd;
                u32x4 o; o.x = pk2(s[0], s[256]); o.y = pk2(s[512], s[768]); o.z = pk2(s[1024], s[1280]); o.w = pk2(s[1536], s[1792]);
                *(u32x4*)(CVT_C + ((size_t)b * 256 + cd) * 512 + pc * 8) = o; }
            if (gt < 1024) { const int pos = gt >> 4, f = gt & 15; const float inv = exp2f(-(float)f * (13.287712379549449f / 16.0f)); const float ang = (float)pos * inv;
                rope[gt * 2] = cosf(ang); rope[gt * 2 + 1] = sinf(ang); }
        }
    }
    SEAM(0);
    if (IN(1)) {
        const float* x_prompt = INP(0); const float* x_sample = INP(1);
        for (int row = gw; row < MTOK; row += NGW) {
            const float* xr = row < NCTX ? x_prompt + (size_t)row * DM : x_sample + (size_t)(row - NCTX) * DM;
            const int cond = row < NCTX ? 0 : 1 + ((row - NCTX) >> 11);
            const float* sc = mod + (size_t)cond * MODW + 1024;
            f32x4 v[4]; float s = 0.f;
#pragma unroll
            for (int j = 0; j < 4; ++j) { v[j] = *(const f32x4*)(xr + 256 * j + 4 * lane); s += (v[j][0] * v[j][0] + v[j][1] * v[j][1]) + (v[j][2] * v[j][2] + v[j][3] * v[j][3]); }
            s = wave_sum(s);
            if (lane == 0) ss0[row] = s;
#pragma unroll
            for (int j = 0; j < 4; ++j) { const f32x4 s4 = *(const f32x4*)(sc + 256 * j + 4 * lane); const f32x4 h = v[j] * (s4 + 1.0f);
                *(u32x2*)(Abuf + (size_t)row * DM + 256 * j + 4 * lane) = (u32x2){cvt_pk_bf16(h[0], h[1]), cvt_pk_bf16(h[2], h[3])}; }
        }
        constexpr int NB0 = 1792 / 64, NB1 = 5632 / 64, NB2 = 1536 / 64, NBT = NB0 + 2 * NB1 + NB2;
        for (int it = gw; it < NCOND * NBT; it += NGW) {
            const int cond = it / NBT; int r = it % NBT;
            const bf16_t* Wt; const float* sh; float* dst; int N;
            if (r < NB0) { Wt = W_INE; sh = mod + (size_t)cond * MODW; dst = biasw + BIAS_INE; N = 1792; }
            else if ((r -= NB0) < NB1) { Wt = W_UP; sh = mod + (size_t)cond * MODW + 3072; dst = biasw + BIAS_UP0; N = 5632; }
            else if ((r -= NB1) < NB2) { Wt = W_INO; sh = mod + (size_t)(NCOND + cond) * MODW; dst = biasw + BIAS_INO; N = 1536; }
            else { r -= NB2; Wt = W_UP + (size_t)FF2 * DM; sh = mod + (size_t)(NCOND + cond) * MODW + 3072; dst = biasw + BIAS_UP1; N = 5632; }
            float sv[16];
#pragma unroll
            for (int j = 0; j < 4; ++j) { const f32x4 t4 = *(const f32x4*)(sh + 16 * lane + 4 * j); sv[4 * j] = t4[0]; sv[4 * j + 1] = t4[1]; sv[4 * j + 2] = t4[2]; sv[4 * j + 3] = t4[3]; }
            for (int n = 0; n < 64; ++n) {
                const bf16_t* wr_ = Wt + (size_t)(r * 64 + n) * DM + 16 * lane;
                const u32x4 w0 = *(const u32x4*)wr_, w1 = *(const u32x4*)(wr_ + 8);
                float d = 0.f;
#pragma unroll
                for (int j = 0; j < 4; ++j) { d += sv[2 * j] * __uint_as_float(w0[j] << 16) + sv[2 * j + 1] * __uint_as_float(w0[j] & 0xffff0000u); d += sv[8 + 2 * j] * __uint_as_float(w1[j] << 16) + sv[8 + 2 * j + 1] * __uint_as_float(w1[j] & 0xffff0000u); }
                d = wave_sum(d);
                if (lane == 0) dst[(size_t)cond * N + r * 64 + n] = d;
            }
        }
    }
    SEAM(1);
    pg8::StaticOrder S;
    if (IN(2)) {
        pg8::Gemm g{Abuf, W_INE, MTOK, EVEN_IN, DM}; S.init(MTOK, EVEN_IN, G, bx);
        EpiIn<true> E{ss0, biasw + BIAS_INE, INP(11), INP(12), rope, Qb, KE, VTE, MIX, VBT, ssv, out_ka, out_va};
        pg8::gemm_phase<EpiIn<true>, true>(lds, g, S, E);
    }
    SEAM(2);
    if (IN(3)) {
        const float* w_spatial = INP(14); const float* b_spatial = INP(15); const float* v_norm_b = INP(13);
        for (int it = bx; it < 512 + 256 + 768; it += G) {
            if (it < 512) {
                const int b = it >> 6, h = (it >> 3) & 7, qb = it & 7, kvh = h >> 2;
                const size_t row0 = NCTX + (size_t)b * 2048 + qb * 256;
                attn_unit(lds, Qb + row0 * 512 + h * 64, 512, MIX + row0 * DM + h * 64, DM,
                          KE + ((size_t)NCTX + (size_t)b * 2048) * 128 + kvh * 64, 128, VTE + (size_t)NCTX * 128 + (size_t)(b * 2 + kvh) * 64 * 2048, 2048, 0, 32,
                          CK_A + (size_t)b * 512 * 128 + kvh * 64, 128, CVT_A + (size_t)(b * 2 + kvh) * 64 * 512, 512, 8, -1e30f, 0.f, -1);
            } else if (it < 768) {
                const int e = it - 512, b = e >> 3, h = e & 7, kvh = h >> 2;
                const size_t row0 = (size_t)b * 256;
                attn_unit(lds, Qb + row0 * 512 + h * 64, 512, MIX + row0 * DM + h * 64, DM,
                          KE + row0 * 128 + kvh * 64, 128, VTE + (size_t)(b * 2 + kvh) * 64 * 256, 256, 0, 4,
                          nullptr, 0, nullptr, 0, 0, -1e30f, 0.f, -1);
            } else {
                const int e = it - 768;
                spatial_unit(e >> 2, e & 3, w_spatial, b_spatial, v_norm_b, ssv, VBT, MIX);
            }
        }
    }
    SEAM(3);
    if (IN(4)) {
        pg8::Gemm g{MIX, W_OUTE, MTOK, DM, DM}; S.init(MTOK, DM, G, bx);
        EpiRes E{INP(0), INP(1), out, mod + 2048, mod + 4096, Abuf, ss1};
        pg8::gemm_phase<EpiRes, true>(lds, g, S, E);
    }
    SEAM(4);
#define FFN_PHASES(P5, P6, P7, L, SSIN, BIASOFF, NSCALE, SSOUT, LASTL) \
    if (IN(P5)) { \
        pg8::Gemm g{Abuf, W_UP + (size_t)(L) * FF2 * DM, MTOK, FF2, DM}; S.init(MTOK, FF2, G, bx); \
        EpiUp E{SSIN, biasw + (BIASOFF), INP(23) + (size_t)(L) * 3 * FF2, INP(24) + (size_t)(L) * FF2, ZB, ACT, spare}; \
        pg8::gemm_phase<EpiUp, true>(lds, g, S, E); \
    } \
    SEAM(P5); \
    if (IN(P6)) { \
        const float* cw = INP(23) + (size_t)(L) * 3 * FF2; const float* cb = INP(24) + (size_t)(L) * FF2; \
        for (int i = bx * 512 + tid; i < 8 * 7 * 2 * FF; i += G * 512) { \
            const int ch = i % FF, rs = i / FF, which = rs & 1, sm = (rs >> 1) % 7, b = rs / 14; \
            const int pmA = 32 + b * 8 + sm;                         \
            const int zc = (ch >> 7) * 256 + (ch & 127); \
            const float* zA = ZB + (size_t)pmA * 4 * FF2; const float* zB = ZB + (size_t)(pmA + 1) * 4 * FF2; \
            float ra, rg; \
            if (which == 0) {   \
                ra = cb[ch] + cw[ch] * zA[2 * FF2 + zc] + cw[FF2 + ch] * zA[3 * FF2 + zc] + cw[2 * FF2 + ch] * zB[zc]; \
                rg = cb[FF + ch] + cw[FF + ch] * zA[2 * FF2 + zc + 128] + cw[FF2 + FF + ch] * zA[3 * FF2 + zc + 128] + cw[2 * FF2 + FF + ch] * zB[zc + 128]; \
            } else {            \
                ra = cb[ch] + cw[ch] * zA[3 * FF2 + zc] + cw[FF2 + ch] * zB[zc] + cw[2 * FF2 + ch] * zB[FF2 + zc]; \
                rg = cb[FF + ch] + cw[FF + ch] * zA[3 * FF2 + zc + 128] + cw[FF2 + FF + ch] * zB[zc + 128] + cw[2 * FF2 + FF + ch] * zB[FF2 + zc + 128]; \
            } \
            const int row = pmA * 256 + 255 + which; \
            ACT[(size_t)row * FF + ch] = (bf16_t)(cvt_pk_bf16(ra * silu_f(rg), 0.f) & 0xffffu); \
        } \
    } \
    SEAM(P6); \
    if (IN(P7)) { \
        pg8::Gemm g{ACT, W_DN + (size_t)(L) * DM * FF, MTOK, DM, FF}; S.init(MTOK, DM, G, bx); \
        EpiRes E{out, out + (size_t)NCTX * DM, out, mod + (size_t)(L) * NCOND * MODW + 5120, NSCALE, (LASTL) ? nullptr : Abuf, SSOUT}; \
        pg8::gemm_phase<EpiRes, true>(lds, g, S, E); \
    } \
    SEAM(P7);
    FFN_PHASES(5, 6, 7, 0, ss1, BIAS_UP0, mod + (size_t)NCOND * MODW + 1024, ss2, false)
    if (IN(8)) {
        pg8::Gemm g{Abuf, W_INO, MTOK, ODD_IN, DM}; S.init(MTOK, ODD_IN, G, bx);
        EpiIn<false> E{ss2, biasw + BIAS_INO, INP(18), INP(19), rope, Qb, KO, VTO, MIX, nullptr, nullptr, out_kc, out_vc};
        pg8::gemm_phase<EpiIn<false>, true>(lds, g, S, E);
    }
    SEAM(8);
    if (IN(9)) {
        const float* sink_c = INP(20);
        for (int it = bx; it < 1024 + 512; it += G) {
            if (it < 1024) {
                const int b = it >> 7, h = (it >> 3) & 15, qb = it & 7, kvh = h >> 2;
                const size_t row0 = NCTX + (size_t)b * 2048 + qb * 256;
                const int q0 = qb * 256; int klo = q0 - 128; if (klo < 0) klo = 0; int khi = q0 + 384; if (khi > 2048) khi = 2048;
                attn_unit(lds, Qb + row0 * 1024 + h * 64, 1024, MIX + row0 * DM + h * 64, DM,
                          KO + ((size_t)NCTX + (size_t)b * 2048) * 256 + kvh * 64, 256, VTO + (size_t)NCTX * 256 + (size_t)(b * 4 + kvh) * 64 * 2048, 2048, klo >> 6, (khi - klo) >> 6,
                          CK_C + (size_t)b * 512 * 256 + kvh * 64, 256, CVT_C + (size_t)(b * 4 + kvh) * 64 * 512, 512, 8, sink_c[h] * LOG2E, 1.0f, q0);
            } else {
                const int e = it - 1024, b = e >> 4, h = e & 15, kvh = h >> 2;
                const size_t row0 = (size_t)b * 256;
                attn_unit(lds, Qb + row0 * 1024 + h * 64, 1024, MIX + row0 * DM + h * 64, DM,
                          KO + row0 * 256 + kvh * 64, 256, VTO + (size_t)(b * 4 + kvh) * 64 * 256, 256, 0, 4,
                          nullptr, 0, nullptr, 0, 0, sink_c[h] * LOG2E, 1.0f, -1);
            }
        }
    }
    SEAM(9);
    if (IN(10)) {
        pg8::Gemm g{MIX, W_OUTO, MTOK, DM, DM}; S.init(MTOK, DM, G, bx);
        EpiRes E{out, out + (size_t)NCTX * DM, out, mod + (size_t)NCOND * MODW + 2048, mod + (size_t)NCOND * MODW + 4096, Abuf, ss3};
        pg8::gemm_phase<EpiRes, true>(lds, g, S, E);
    }
    SEAM(10);
    FFN_PHASES(11, 12, 13, 1, ss3, BIAS_UP1, nullptr, nullptr, true)
#undef IN
#undef SEAM
}

constexpr int N_PHASES = 14;

extern "C" void kernel_launch(void* const* d_in, const int* in_sizes, int n_in, void* d_out, int out_size, void* d_ws, size_t ws_size, hipStream_t stream) {
    static int grid = 0;
    if (grid == 0) {
        int dev = 0, cus = 0;
        hipGetDevice(&dev);
        hipDeviceGetAttribute(&cus, hipDeviceAttributeMultiprocessorCount, dev);
        hipFuncSetAttribute((const void*)mk_fwd<true>, hipFuncAttributeMaxDynamicSharedMemorySize, LDS_BYTES);
        hipFuncSetAttribute((const void*)mk_fwd<false>, hipFuncAttributeMaxDynamicSharedMemorySize, LDS_BYTES);
        int per_cu = 0;
        hipOccupancyMaxActiveBlocksPerMultiprocessor(&per_cu, (const void*)mk_fwd<true>, 512, LDS_BYTES);
        (void)hipGetLastError();
        if (per_cu < 1) fprintf(stderr, "kernel_launch: occupancy query says %d blocks/CU\n", per_cu);
        grid = cus > 0 ? cus : 256;
        if (n_in != 26 || ws_size < WS_END) { fprintf(stderr, "kernel_launch: unexpected n_in %d / ws %zu\n", n_in, ws_size); }
    }
    hipMemsetAsync((char*)d_ws, 0, WS_ZERO_BYTES, stream);
    Params p{};
    for (int i = 0; i < 26; ++i) p.in[i] = (const float*)d_in[i];
    p.out = (float*)d_out; p.ws = (unsigned char*)d_ws;
#if MK_COOP
    p.ph_lo = 0; p.ph_hi = N_PHASES;
    void* args[] = {&p};
    hipError_t e = hipLaunchCooperativeKernel((const void*)mk_fwd<true>, dim3(grid), dim3(512), args, LDS_BYTES, stream);
    if (e != hipSuccess) fprintf(stderr, "cooperative launch failed: %s (grid %d)\n", hipGetErrorString(e), grid);
#else
    for (int ph = 0; ph < N_PHASES; ++ph) {
        p.ph_lo = ph; p.ph_hi = ph + 1;
        hipLaunchKernelGGL(mk_fwd<false>, dim3(grid), dim3(512), LDS_BYTES, stream, p);
    }
#endif
}
```

```cpp
#include <hip/hip_runtime.h>
#include <hip/hip_cooperative_groups.h>
#include <cstdio>
#include <cstdint>
namespace cg = cooperative_groups;

#ifndef MK_COOP
#define MK_COOP 1
#endif

#ifndef MK_DUP
#define MK_DUP -1
#endif
#define LAS __attribute__((address_space(3)))
typedef unsigned short bf16_t;
typedef short bf16x8 __attribute__((ext_vector_type(8)));
typedef short s16x4 __attribute__((ext_vector_type(4)));
typedef float f32x4 __attribute__((ext_vector_type(4)));
typedef float f32x2 __attribute__((ext_vector_type(2)));
typedef float f32x16 __attribute__((ext_vector_type(16)));
typedef unsigned u32x4 __attribute__((ext_vector_type(4)));
typedef unsigned u32x2 __attribute__((ext_vector_type(2)));

constexpr int DM = 1024, NCTX = 8192, NLAT = 16384, MTOK = 24576;
constexpr int EVEN_IN = 1792, ODD_IN = 1536, FF = 2816, FF2 = 5632;
constexpr int NCOND = 9, MODW = 6144;
constexpr float EPS = 1e-6f;
constexpr float LOG2E = 1.4426950408889634f;

constexpr size_t MiB = 1u << 20;
constexpr size_t WS_MOD = 0;
constexpr size_t WS_SS1 = 442368, WS_SS2 = WS_SS1 + 98304, WS_SS3 = WS_SS2 + 98304, WS_SSV = WS_SS3 + 98304;
constexpr size_t WS_BAR = 900 * 1024;
constexpr size_t WS_ZERO_BYTES = 1 * MiB;
constexpr size_t WS_SS0 = 1 * MiB;
constexpr size_t WS_ROPE = 1 * MiB + 128 * 1024;
constexpr size_t WS_BIAS = 1 * MiB + 256 * 1024;
constexpr size_t WS_ZB = 2 * MiB;
constexpr size_t WS_CK_A = 11 * MiB, WS_CVT_A = 12 * MiB, WS_CK_C = 13 * MiB, WS_CVT_C = 15 * MiB;
constexpr size_t WS_W_INE = 18 * MiB, WS_W_OUTE = 22 * MiB, WS_W_INO = 24 * MiB, WS_W_OUTO = 27 * MiB, WS_W_UP = 29 * MiB, WS_W_DN = 51 * MiB;
constexpr size_t WS_A = 62 * MiB;
constexpr size_t WS_BIG = 110 * MiB;
constexpr size_t WS_ACT = WS_BIG;
constexpr size_t WS_MIX = WS_BIG;
constexpr size_t WS_Q = WS_BIG + 48 * MiB;
constexpr size_t WS_KE = WS_Q + 24 * MiB, WS_VTE = WS_KE + 6 * MiB, WS_VBT = WS_VTE + 6 * MiB;
constexpr size_t WS_KO = WS_Q + 48 * MiB, WS_VTO = WS_KO + 12 * MiB;
constexpr size_t WS_END = 256 * MiB;
static_assert(WS_VBT + 24 * MiB <= WS_END && WS_VTO + 12 * MiB <= WS_END && WS_ACT + 132 * MiB <= WS_END, "ws map");
constexpr size_t BIAS_INE = 0, BIAS_UP0 = 9 * 1792, BIAS_INO = BIAS_UP0 + 9 * 5632, BIAS_UP1 = BIAS_INO + 9 * 1536;

constexpr int LDS_BYTES = 147456;
constexpr int LDS_SPARE = 131072;

struct Params {
    const float* in[26];
    float* out;
    unsigned char* ws;
    int ph_lo, ph_hi;
};

namespace pg8 {
constexpr int BM = 256, BK = 64, HALF = 128, HTB = HALF * BK * 2, STAGE_BYTES = 8 * HTB, NXCD = 8, WGM = 8;
__host__ __device__ __forceinline__ int lds_byte(int r, int c) { const int st = (r >> 4) * 2 + (c >> 5), rr = r & 15, cc = c & 31, ob = rr * 64 + cc * 2; return st * 1024 + (ob ^ (((ob >> 9) & 1) << 5)); }
__host__ __device__ __forceinline__ void stage_rc(int b, int& R, int& C) { const int st = b / 1024, sb = b % 1024, swz = sb ^ (((sb >> 9) & 1) << 5); R = (st >> 1) * 16 + swz / 64; C = (st & 1) * 32 + (swz % 64) / 2; }
__host__ __device__ __forceinline__ int perm32(int rho) { const int n = rho >> 4, i = rho & 15; return 8 * (i >> 2) + 4 * n + (i & 3); }
struct Unit { int pm, pn; };
struct Gemm { const bf16_t* A; const bf16_t* Bt; int M, N, K; };
struct StaticOrder {
    int nM, nN, nwg, G, c;
    __device__ void init(int M, int N, int G_, int c_) { nM = M / BM; nN = N / BM; nwg = nM * nN; G = G_; c = c_; }
    __device__ bool next(int i, Unit& u) const {
        const long L = (long)i * G + c; if (L >= nwg) return false;
        int wgid = (int)L; { const int q = nwg / NXCD, r = nwg % NXCD, xcd = wgid % NXCD, off = wgid / NXCD; wgid = (xcd < r ? xcd * (q + 1) : r * (q + 1) + (xcd - r) * q) + off; }
        const int nig = WGM * nN, gid = wgid / nig, fm = gid * WGM, gsz = (nM - fm) < WGM ? (nM - fm) : WGM;
        u.pm = fm + ((wgid % nig) % gsz); u.pn = (wgid % nig) / gsz; return true;
    }
};
__device__ __forceinline__ unsigned cvt_pk_bf16(float lo, float hi) { unsigned r; asm volatile("v_cvt_pk_bf16_f32 %0, %1, %2" : "=v"(r) : "v"(lo), "v"(hi)); return r; }

template <class Epi, bool ALIGN_EPI>
__device__ __forceinline__ void gemm_phase(LAS unsigned char* lds, const Gemm g, const StaticOrder& S, const Epi& E) {
    const int tid = threadIdx.x, wid = __builtin_amdgcn_readfirstlane(tid >> 6), lane = tid & 63, wr = wid >> 2, wc = wid & 3, fr = lane & 15, fq = lane >> 4;
    const int K = g.K, nt = K / BK;
    unsigned voffA[2], voffB[2];
#pragma unroll
    for (int i = 0; i < 2; ++i) { int R, C; stage_rc(tid * 16 + i * 8192, R, C); const int Rb = (R & ~31) + perm32(R & 31);
        voffA[i] = (unsigned)(R * K + C) * 2u; voffB[i] = (unsigned)(Rb * K + C) * 2u; }
    const size_t kstep = (size_t)(BK * 2);
    const size_t hstep = (size_t)HALF * K * 2;
    const size_t tstep = 2 * hstep;
    const unsigned ldsw = (unsigned)wid * 1024u;
    const int aoff = lds_byte(wr * 64 + fr, fq * 8), boff = lds_byte(wc * 32 + fr, fq * 8);
#define PG8_SA(b, h) (((b) * 2 + (h)) * HTB)
#define PG8_SB(b, h) ((4 + (b) * 2 + (h)) * HTB)
#define PG8_STAGE(bufoff, gbase, voff) do { _Pragma("unroll") for (int _i = 0; _i < 2; ++_i) \
        __builtin_amdgcn_global_load_lds((const unsigned*)((const char*)(gbase) + (voff)[_i]), (LAS unsigned*)(lds + (bufoff) + ldsw + _i * 8192), 16, 0, 0); } while (0)
#define PG8_LDA(dst, b, h) do { _Pragma("unroll") for (int m = 0; m < 4; ++m) _Pragma("unroll") for (int k = 0; k < 2; ++k) dst[m][k] = *(const LAS bf16x8*)(lds + PG8_SA(b, h) + aoff + m * 2048 + k * 1024); } while (0)
#define PG8_LDB(dst, b, h) do { _Pragma("unroll") for (int n = 0; n < 2; ++n) _Pragma("unroll") for (int k = 0; k < 2; ++k) dst[n][k] = *(const LAS bf16x8*)(lds + PG8_SB(b, h) + boff + n * 2048 + k * 1024); } while (0)
#define PG8_MMA(ai, bj, At, Bt) do { __builtin_amdgcn_s_setprio(1); _Pragma("unroll") for (int m = 0; m < 4; ++m) _Pragma("unroll") for (int n = 0; n < 2; ++n) _Pragma("unroll") for (int k = 0; k < 2; ++k) \
        acc[ai][bj][m][n] = __builtin_amdgcn_mfma_f32_16x16x32_bf16(Bt[n][k], At[m][k], acc[ai][bj][m][n], 0, 0, 0); __builtin_amdgcn_s_setprio(0); } while (0)
#define PG8_WAIT_V(n) asm volatile("s_waitcnt vmcnt(" #n ")" ::: "memory")
#define PG8_WAIT_L(n) asm volatile("s_waitcnt lgkmcnt(" #n ")" ::: "memory")
#define PG8_BAR __builtin_amdgcn_s_barrier()
#define PG8_SCHED __builtin_amdgcn_sched_barrier(0)
    Unit cur, nxt; int ui = 0;
    if (!S.next(0, cur)) return;
    f32x4 acc[2][2][4][2];
#pragma unroll
    for (int a = 0; a < 2; ++a)
#pragma unroll
        for (int b = 0; b < 2; ++b)
#pragma unroll
            for (int m = 0; m < 4; ++m)
#pragma unroll
                for (int n = 0; n < 2; ++n) acc[a][b][m][n] = (f32x4){0.f, 0.f, 0.f, 0.f};
    bf16x8 At[4][2], B0[2][2], B1[2][2];
    const char* cA = (const char*)g.A + (size_t)cur.pm * tstep; const char* cB = (const char*)g.Bt + (size_t)cur.pn * tstep;
    PG8_STAGE(PG8_SB(0, 0), cB, voffB); PG8_STAGE(PG8_SB(0, 1), cB + hstep, voffB); PG8_STAGE(PG8_SA(0, 0), cA, voffA); PG8_STAGE(PG8_SA(0, 1), cA + hstep, voffA);
    if (wr == 1) PG8_BAR;
    PG8_WAIT_V(2); PG8_BAR;
    PG8_STAGE(PG8_SB(1, 0), cB + kstep, voffB); PG8_STAGE(PG8_SA(1, 0), cA + kstep, voffA); PG8_STAGE(PG8_SB(1, 1), cB + hstep + kstep, voffB);
    PG8_WAIT_V(6); PG8_BAR;
    for (;;) {
        const bool has_next = S.next(ui + 1, nxt);
        const char* nA = has_next ? (const char*)g.A + (size_t)nxt.pm * tstep : cA; const char* nB = has_next ? (const char*)g.Bt + (size_t)nxt.pn * tstep : cB;
        for (int t = 0; t < nt; t += 2) {
            const bool last = (t == nt - 2);
            const char* a1 = cA + (size_t)(t + 1) * kstep;
            const char* a2 = last ? nA : cA + (size_t)(t + 2) * kstep; const char* b2 = last ? nB : cB + (size_t)(t + 2) * kstep;
            const char* a3 = a2 + kstep; const char* b3 = b2 + kstep;
            PG8_LDB(B0, 0, 0); PG8_LDB(B1, 0, 1); PG8_SCHED; PG8_LDA(At, 0, 0); PG8_STAGE(PG8_SA(1, 1), a1 + hstep, voffA);
            PG8_WAIT_V(8); PG8_WAIT_L(0); PG8_BAR; PG8_MMA(0, 0, At, B0); PG8_MMA(0, 1, At, B1); PG8_BAR; PG8_SCHED;
            PG8_LDA(At, 0, 1); PG8_STAGE(PG8_SB(0, 0), b2, voffB); PG8_STAGE(PG8_SB(0, 1), b2 + hstep, voffB); PG8_STAGE(PG8_SA(0, 0), a2, voffA);
            PG8_WAIT_V(8); PG8_WAIT_L(0); PG8_BAR; PG8_MMA(1, 0, At, B0); PG8_MMA(1, 1, At, B1); PG8_BAR; PG8_SCHED;
            PG8_LDB(B0, 1, 0); PG8_LDB(B1, 1, 1); PG8_SCHED; PG8_LDA(At, 1, 0); PG8_STAGE(PG8_SA(0, 1), a2 + hstep, voffA);
            PG8_WAIT_V(8); PG8_WAIT_L(0); PG8_BAR; PG8_MMA(0, 0, At, B0); PG8_MMA(0, 1, At, B1); PG8_BAR; PG8_SCHED;
            PG8_LDA(At, 1, 1); PG8_STAGE(PG8_SB(1, 0), b3, voffB); PG8_STAGE(PG8_SB(1, 1), b3 + hstep, voffB); PG8_STAGE(PG8_SA(1, 0), a3, voffA);
            PG8_WAIT_V(8); PG8_WAIT_L(0); PG8_BAR; PG8_MMA(1, 0, At, B0); PG8_MMA(1, 1, At, B1); PG8_BAR; PG8_SCHED;
        }
        if constexpr (ALIGN_EPI) { if (wr == 0) PG8_BAR; }
        E(acc, cur, wr, wc, fr, fq);
        if (!has_next) break;
#pragma unroll
        for (int a = 0; a < 2; ++a)
#pragma unroll
            for (int b = 0; b < 2; ++b)
#pragma unroll
                for (int m = 0; m < 4; ++m)
#pragma unroll
                    for (int n = 0; n < 2; ++n) acc[a][b][m][n] = (f32x4){0.f, 0.f, 0.f, 0.f};
        cur = nxt; cA = nA; cB = nB; ++ui;
        if constexpr (ALIGN_EPI) { if (wr == 1) PG8_BAR; }
    }
    PG8_WAIT_V(0);
    if constexpr (!ALIGN_EPI) { if (wr == 0) PG8_BAR; }
    PG8_BAR;
#undef PG8_SA
#undef PG8_SB
#undef PG8_STAGE
#undef PG8_LDA
#undef PG8_LDB
#undef PG8_MMA
#undef PG8_WAIT_V
#undef PG8_WAIT_L
#undef PG8_BAR
#undef PG8_SCHED
}
}

using pg8::cvt_pk_bf16;
typedef f32x4 (&AccRef)[2][2][4][2];

__device__ __forceinline__ int cond_of_tile(int pm) { return pm < 32 ? 0 : 1 + ((pm - 32) >> 3); }
__device__ __forceinline__ float red_fq(float v) { v += __shfl_xor(v, 16); v += __shfl_xor(v, 32); return v; }
__device__ __forceinline__ float gelu_tanh(float x) { const float u = x + 0.044715f * x * x * x; return x * __builtin_amdgcn_rcpf(1.0f + __builtin_amdgcn_exp2f(-2.302208198f * u)); }
__device__ __forceinline__ float silu_f(float x) { return x * __builtin_amdgcn_rcpf(1.0f + __builtin_amdgcn_exp2f(-LOG2E * x)); }
__device__ __forceinline__ u32x4 pack8(const f32x4 a, const f32x4 b) { u32x4 w; w.x = cvt_pk_bf16(a[0], a[1]); w.y = cvt_pk_bf16(a[2], a[3]); w.z = cvt_pk_bf16(b[0], b[1]); w.w = cvt_pk_bf16(b[2], b[3]); return w; }
__device__ __forceinline__ float bf2f(unsigned short h) { return __uint_as_float((unsigned)h << 16); }

template <class T> __device__ __forceinline__ T ldg(const void* base, unsigned off) { return *(const T*)((const char*)base + off); }
template <class T> __device__ __forceinline__ void stg(void* base, unsigned off, T v) { *(T*)((char*)base + off) = v; }
__device__ __forceinline__ float ss4(const f32x4 v) { return (v[0] * v[0] + v[1] * v[1]) + (v[2] * v[2] + v[3] * v[3]); }

struct EpiRes {
    const float* xp; const float* xs; float* out; const float* gate; const float* nscale; bf16_t* An; float* ssn;
    __device__ __forceinline__ void operator()(AccRef acc, const pg8::Unit& u, int wr, int wc, int fr, int fq) const {
        const int cond = cond_of_tile(u.pm);
        const unsigned colbase = u.pn * 256 + wc * 32 + 8 * fq;
        const bool ctx = u.pm < 32;
        const float* xb = ctx ? xp : xs;
        const unsigned rsub = ctx ? 0u : (unsigned)NCTX;
        const unsigned moff = (cond * MODW + colbase) * 4u;
#pragma unroll
        for (int ai = 0; ai < 2; ++ai)
#pragma unroll
            for (int m = 0; m < 4; ++m) {
                const unsigned row = u.pm * 256 + ai * 128 + wr * 64 + m * 16 + fr;
                const unsigned xoff = ((row - rsub) * DM + colbase) * 4u, ooff = (row * DM + colbase) * 4u;
                float ssum = 0.f;
#pragma unroll
                for (int bj = 0; bj < 2; ++bj) {
                    f32x4 xn[2];
#pragma unroll
                    for (int n = 0; n < 2; ++n) {
                        const f32x4 xo = ldg<f32x4>(xb, xoff + bj * 512 + n * 16);
                        const f32x4 gt = ldg<f32x4>(gate, moff + bj * 512 + n * 16);
                        xn[n] = xo + gt * acc[ai][bj][m][n];
                        stg<f32x4>(out, ooff + bj * 512 + n * 16, xn[n]);
                        ssum += ss4(xn[n]);
                    }
                    if (An) {
                        const f32x4 s0 = ldg<f32x4>(nscale, moff + bj * 512) + 1.0f, s1 = ldg<f32x4>(nscale, moff + bj * 512 + 16) + 1.0f;
                        stg<u32x4>(An, (row * DM + colbase) * 2u + bj * 256, pack8(xn[0] * s0, xn[1] * s1));
                    }
                }
                if (ssn) { ssum = red_fq(ssum); if (fq == 0) atomicAdd((float*)((char*)ssn + row * 4u), ssum); }
                asm volatile("" ::: "memory");
            }
    }
};

template <bool EVEN>
struct EpiIn {
    const float* ss; const float* bias;
    const float* qg; const float* kg;
    const float* rope;
    bf16_t* Q; bf16_t* K; bf16_t* Vt; bf16_t* MIX; bf16_t* VbT; float* ssv;
    float* outk; float* outv;
    __device__ __forceinline__ void operator()(AccRef acc, const pg8::Unit& u, int wr, int wc, int fr, int fq) const {
        constexpr unsigned N = EVEN ? EVEN_IN : ODD_IN, QW = EVEN ? 512 : 1024, KVH = EVEN ? 2 : 4, KW = KVH * 64;
        const int cond = cond_of_tile(u.pm);
        int role; unsigned hidx;
        if (EVEN) { if (u.pn < 2) { role = 0; hidx = 4 * u.pn + wc; } else if (u.pn == 2) { role = wc < 2 ? 1 : 2; hidx = wc & 1; } else if (u.pn < 5) { role = 3; hidx = (u.pn - 3) * 4 + wc; } else { role = 4; hidx = (u.pn - 5) * 4 + wc; } }
        else { if (u.pn < 4) { role = 0; hidx = 4 * u.pn + wc; } else if (u.pn == 4) { role = 1; hidx = wc; } else { role = 2; hidx = wc; } }
        const unsigned boff = (cond * N + u.pn * 256 + wc * 32 + 8 * fq) * 4u;
        const bool lat = u.pm >= 32;
        const unsigned c8 = hidx * 64 + 8 * fq;
        const float* gp = role == 0 ? qg : kg;
#pragma unroll
        for (int ai = 0; ai < 2; ++ai)
#pragma unroll
            for (int m = 0; m < 4; ++m) {
                const unsigned row = u.pm * 256 + ai * 128 + wr * 64 + m * 16 + fr;
                const float rr = 1.0f / sqrtf(ldg<float>(ss, row * 4u) * (1.0f / DM) + EPS);
                f32x4 z[2][2];
#pragma unroll
                for (int bj = 0; bj < 2; ++bj)
#pragma unroll
                    for (int n = 0; n < 2; ++n) z[bj][n] = acc[ai][bj][m][n] * rr + ldg<f32x4>(bias, boff + bj * 512 + n * 16);
                if (role <= 1) {
                    float s2 = (ss4(z[0][0]) + ss4(z[0][1])) + (ss4(z[1][0]) + ss4(z[1][1]));
                    s2 = red_fq(s2);
                    const float rn = 1.0f / sqrtf(s2 * (1.0f / 64.0f) + EPS);
#pragma unroll
                    for (int bj = 0; bj < 2; ++bj)
#pragma unroll
                        for (int n = 0; n < 2; ++n) z[bj][n] = z[bj][n] * rn * ldg<f32x4>(gp, (8 * fq) * 4u + bj * 128 + n * 16);
                    if (role == 1 && !lat) {
#pragma unroll
                        for (int bj = 0; bj < 2; ++bj)
#pragma unroll
                            for (int n = 0; n < 2; ++n) stg<f32x4>(outk, (row * KW + c8) * 4u + bj * 128 + n * 16, z[bj][n]);
                    }
                    if (lat) {
                        const unsigned t = (row - NCTX) & 2047u;
#pragma unroll
                        for (int bj = 0; bj < 2; ++bj) {
                            const unsigned pos = bj == 0 ? (t >> 6) : (t & 63u);
#pragma unroll
                            for (int n = 0; n < 2; ++n) {
                                const f32x4 cs = ldg<f32x4>(rope, (pos * 16 + 4 * fq) * 8u + n * 16);
                                const f32x4 v = z[bj][n];
                                z[bj][n] = (f32x4){v[0] * cs[0] - v[1] * cs[1], v[0] * cs[1] + v[1] * cs[0], v[2] * cs[2] - v[3] * cs[3], v[2] * cs[3] + v[3] * cs[2]};
                            }
                        }
                    }
                    if (role == 0) {
#pragma unroll
                        for (int bj = 0; bj < 2; ++bj) stg<u32x4>(Q, (row * QW + c8) * 2u + bj * 64, pack8(z[bj][0] * (0.125f * LOG2E), z[bj][1] * (0.125f * LOG2E)));
                    } else {
#pragma unroll
                        for (int bj = 0; bj < 2; ++bj) stg<u32x4>(K, (row * KW + c8) * 2u + bj * 64, pack8(z[bj][0], z[bj][1]));
                    }
                } else if (role == 2) {
                    if (!lat) {
#pragma unroll
                        for (int bj = 0; bj < 2; ++bj)
#pragma unroll
                            for (int n = 0; n < 2; ++n) stg<f32x4>(outv, (row * KW + c8) * 4u + bj * 128 + n * 16, z[bj][n]);
                    }
                    unsigned vb, T;
                    if (!lat) { T = 256; vb = ((row >> 8) * KVH + hidx) * 64 * 256 + (row & 255u); }
                    else { T = 2048; vb = NCTX * KW + (((row - NCTX) >> 11) * KVH + hidx) * 64 * 2048 + ((row - NCTX) & 2047u); }
                    vb += 8 * fq * T;
#pragma unroll
                    for (int bj = 0; bj < 2; ++bj)
#pragma unroll
                        for (int n = 0; n < 2; ++n)
#pragma unroll
                            for (int i = 0; i < 4; ++i) stg<bf16_t>(Vt, (vb + (32 * bj + 4 * n + i) * T) * 2u, (bf16_t)(cvt_pk_bf16(z[bj][n][i], 0.f) & 0xffffu));
                } else if (EVEN && role == 3) {
#pragma unroll
                    for (int bj = 0; bj < 2; ++bj) {
                        f32x4 a = z[bj][0], b = z[bj][1];
#pragma unroll
                        for (int i = 0; i < 4; ++i) { a[i] = gelu_tanh(a[i]); b[i] = gelu_tanh(b[i]); }
                        stg<u32x4>(MIX, (row * DM + 512 + c8) * 2u + bj * 64, pack8(a, b));
                    }
                } else if (EVEN) {
                    float s2 = 0.f;
                    const unsigned cb = (row >> 7) * 512 * 128 + (row & 127u) + c8 * 128;
#pragma unroll
                    for (int bj = 0; bj < 2; ++bj)
#pragma unroll
                        for (int n = 0; n < 2; ++n)
#pragma unroll
                            for (int i = 0; i < 4; ++i) {
                                const float gv = gelu_tanh(z[bj][n][i]); s2 += gv * gv;
                                stg<bf16_t>(VbT, (cb + (32 * bj + 4 * n + i) * 128) * 2u, (bf16_t)(cvt_pk_bf16(gv, 0.f) & 0xffffu));
                            }
                    s2 = red_fq(s2);
                    if (fq == 0) atomicAdd((float*)((char*)ssv + row * 4u), s2);
                }
                asm volatile("" ::: "memory");
            }
    }
};

template <int CTRL> __device__ __forceinline__ float dpp_rot(float v) { return __builtin_bit_cast(float, __builtin_amdgcn_update_dpp(0, __builtin_bit_cast(int, v), CTRL, 0xf, 0xf, false)); }
struct EpiUp {
    const float* ss; const float* bias; const float* cw; const float* cbias;
    float* ZB; bf16_t* ACT; LAS float* xch;
    __device__ __forceinline__ void operator()(AccRef acc, const pg8::Unit& u, int wr, int wc, int fr, int fq) const {
        const int cond = cond_of_tile(u.pm);
        const unsigned nb = u.pn * 256 + wc * 32 + 8 * fq;
        const unsigned boff = (cond * FF2 + nb) * 4u;
#pragma unroll
        for (int ai = 0; ai < 2; ++ai)
#pragma unroll
            for (int m = 0; m < 4; ++m) {
                const unsigned row = u.pm * 256 + ai * 128 + wr * 64 + m * 16 + fr;
                const float rr = 1.0f / sqrtf(ldg<float>(ss, row * 4u) * (1.0f / DM) + EPS);
#pragma unroll
                for (int bj = 0; bj < 2; ++bj)
#pragma unroll
                    for (int n = 0; n < 2; ++n) acc[ai][bj][m][n] = acc[ai][bj][m][n] * rr + ldg<f32x4>(bias, boff + bj * 512 + n * 16);
            }
        if (wr == 0 && fr < 2) {
            const unsigned zo = ((u.pm * 4 + fr) * FF2 + nb) * 4u;
#pragma unroll
            for (int bj = 0; bj < 2; ++bj)
#pragma unroll
                for (int n = 0; n < 2; ++n) stg<f32x4>(ZB, zo + bj * 512 + n * 16, acc[0][bj][0][n]);
        }
        if (wr == 1 && fr >= 14) {
            const unsigned zo = ((u.pm * 4 + 2 + (fr - 14)) * FF2 + nb) * 4u;
#pragma unroll
            for (int bj = 0; bj < 2; ++bj)
#pragma unroll
                for (int n = 0; n < 2; ++n) stg<f32x4>(ZB, zo + bj * 512 + n * 16, acc[1][bj][3][n]);
        }
        LAS float* my = xch + (wr * 4 + wc) * 256 + 8 * fq;
        if (fr == 0) {
#pragma unroll
            for (int ai = 0; ai < 2; ++ai)
#pragma unroll
                for (int bj = 0; bj < 2; ++bj)
#pragma unroll
                    for (int n = 0; n < 2; ++n) *(LAS f32x4*)(my + ai * 128 + bj * 32 + 4 * n) = acc[ai][bj][0][n];
        }
        if (fr == 15) {
#pragma unroll
            for (int ai = 0; ai < 2; ++ai)
#pragma unroll
                for (int bj = 0; bj < 2; ++bj)
#pragma unroll
                    for (int n = 0; n < 2; ++n) *(LAS f32x4*)(my + ai * 128 + 64 + bj * 32 + 4 * n) = acc[ai][bj][3][n];
        }
        asm volatile("s_waitcnt lgkmcnt(0)" ::: "memory"); __builtin_amdgcn_s_barrier(); asm volatile("" ::: "memory");
        const unsigned chb = u.pn * 128 + wc * 32 + 8 * fq;
        const float* cw1 = cw + FF2; const float* cw2 = cw + 2 * FF2;
#pragma unroll
        for (int ai = 0; ai < 2; ++ai) {
            const bool hasp = !(ai == 0 && wr == 0), hasn = !(ai == 1 && wr == 1);
            const LAS float* pp = xch + ((wr == 1 ? 0 : 4) + wc) * 256 + (wr == 1 ? ai : 0) * 128 + 64 + 8 * fq;
            const LAS float* pn = xch + ((wr == 0 ? 4 : 0) + wc) * 256 + (wr == 0 ? ai : 1) * 128 + 8 * fq;
            const unsigned arow = ((u.pm * 256 + ai * 128 + wr * 64 + fr) * FF + chb) * 2u;
#pragma unroll
            for (int n = 0; n < 2; ++n) {
                f32x4 sg[4];
#pragma unroll
                for (int pass = 0; pass < 2; ++pass) {
                    const int bj = 1 - pass;
                    const unsigned ci = (bj * FF + chb + 4 * n) * 4u;
                    const f32x4 w0 = ldg<f32x4>(cw, ci), w1 = ldg<f32x4>(cw1, ci), w2 = ldg<f32x4>(cw2, ci), cb = ldg<f32x4>(cbias, ci);
                    f32x4 hp = (f32x4){0.f, 0.f, 0.f, 0.f}, hn = (f32x4){0.f, 0.f, 0.f, 0.f};
                    if (hasp) hp = *(const LAS f32x4*)(pp + bj * 32 + 4 * n);
                    if (hasn) hn = *(const LAS f32x4*)(pn + bj * 32 + 4 * n);
                    f32x4 prevsrc = hp;
#pragma unroll
                    for (int m = 0; m < 4; ++m) {
                        const f32x4 zc = acc[ai][bj][m][n];
                        const f32x4 nsrc = m < 3 ? acc[ai][bj][m < 3 ? m + 1 : 3][n] : hn;
                        f32x4 pv, nv;
#pragma unroll
                        for (int i = 0; i < 4; ++i) {
                            pv[i] = dpp_rot<0x121>(fr == 15 ? prevsrc[i] : zc[i]);
                            nv[i] = dpp_rot<0x12F>(fr == 0 ? nsrc[i] : zc[i]);
                        }
                        f32x4 res = cb + w0 * pv + w1 * zc + w2 * nv;
                        prevsrc = zc;
                        if (pass == 0) {
#pragma unroll
                            for (int i = 0; i < 4; ++i) res[i] = silu_f(res[i]);
                            sg[m] = res;
                        } else {
                            res = res * sg[m];
                            stg<u32x2>(ACT, arow + m * (16 * FF * 2) + n * 8, (u32x2){cvt_pk_bf16(res[0], res[1]), cvt_pk_bf16(res[2], res[3])});
                        }
                    }
                    asm volatile("" ::: "memory");
                }
                asm volatile("" ::: "memory");
            }
        }
    }
};

__device__ __forceinline__ int crow(int r, int hi) { return (r & 3) + 8 * (r >> 2) + 4 * hi; }
__device__ __forceinline__ void attn_unit(LAS unsigned char* lds, const bf16_t* Q, int qstride, bf16_t* O, int ostride,
                                          const bf16_t* K0, int ks0, const bf16_t* V0, int vs0, int t0lo, int nt0,
                                          const bf16_t* K1, int ks1, const bf16_t* V1, int vs1, int nt1,
                                          float m_init, float l_init, int win_q0) {
    const int tid = threadIdx.x, lane = tid & 63, r32 = lane & 31, hi = lane >> 5, wid = __builtin_amdgcn_readfirstlane(tid >> 6);
    const int qrow = wid * 32 + r32;
    bf16x8 qf[4];
#pragma unroll
    for (int d0 = 0; d0 < 4; ++d0) qf[d0] = *(const bf16x8*)(Q + (size_t)qrow * qstride + d0 * 16 + hi * 8);
    float mrun = m_init, lrun = hi == 0 ? l_init : 0.f;
    f32x16 o0 = {}, o1 = {};
    const int NT = nt0 + nt1;
    const int lrow = 8 * wid + (lane >> 3), lch = (lane & 7) ^ ((lrow >> 1) & 7);
    auto dma = [&](int t) {
        const bf16_t* kp; const bf16_t* vp;
        if (t < nt0) { kp = K0 + (size_t)((t0lo + t) * 64 + lrow) * ks0 + lch * 8; vp = V0 + (size_t)lrow * vs0 + (t0lo + t) * 64 + lch * 8; }
        else { kp = K1 + (size_t)((t - nt0) * 64 + lrow) * ks1 + lch * 8; vp = V1 + (size_t)lrow * vs1 + (t - nt0) * 64 + lch * 8; }
        LAS unsigned char* dst = lds + (t & 3) * 16384 + wid * 1024;
        __builtin_amdgcn_global_load_lds((const unsigned*)kp, (LAS unsigned*)dst, 16, 0, 0);
        __builtin_amdgcn_global_load_lds((const unsigned*)vp, (LAS unsigned*)(dst + 8192), 16, 0, 0);
    };
    const int krow = (r32 & 0x13) | ((r32 & 4) << 1) | ((r32 & 8) >> 1);
    const int koff = krow * 128 + ((hi ^ ((krow >> 1) & 7)) << 4);
    const int voff = 8192 + r32 * 128 + ((hi ^ ((r32 >> 1) & 7)) << 4);
    dma(0); if (NT > 1) dma(1); if (NT > 2) dma(2);
    for (int t = 0; t < NT; ++t) {
        if (t + 2 < NT) asm volatile("s_waitcnt vmcnt(4)" ::: "memory");
        else if (t + 1 < NT) asm volatile("s_waitcnt vmcnt(2)" ::: "memory");
        else asm volatile("s_waitcnt vmcnt(0)" ::: "memory");
        __builtin_amdgcn_s_barrier(); asm volatile("" ::: "memory");
        if (t + 3 < NT) dma(t + 3);
        bool active = true;
        int key0 = 0;
        if (win_q0 >= 0 && t < nt0) {
            key0 = (t0lo + t) * 64;
            const int qw0 = win_q0 + wid * 32;
            active = !(key0 + 63 < qw0 - 128 || key0 > qw0 + 31 + 128);
        }
        if (active) {
            const LAS unsigned char* sb = lds + (t & 3) * 16384;
            f32x16 p0 = {}, p1 = {};
#pragma unroll
            for (int d0 = 0; d0 < 4; ++d0) {
                const bf16x8 k0 = *(const LAS bf16x8*)(sb + (koff ^ (d0 << 5)));
                const bf16x8 k1 = *(const LAS bf16x8*)(sb + (koff ^ (d0 << 5)) + 32 * 128);
                p0 = __builtin_amdgcn_mfma_f32_32x32x16_bf16(k0, qf[d0], p0, 0, 0, 0);
                p1 = __builtin_amdgcn_mfma_f32_32x32x16_bf16(k1, qf[d0], p1, 0, 0, 0);
            }
            if (win_q0 >= 0 && t < nt0) {
                const int qw0 = win_q0 + wid * 32;
                const int bb = key0 + 8 * hi - (win_q0 + qrow);
                if (key0 < qw0 + 31 - 128) {
#pragma unroll
                    for (int r = 0; r < 16; ++r) { const int c = 16 * (r >> 3) + (r & 7); if (bb < -128 - c) p0[r] = -INFINITY; if (bb < -160 - c) p1[r] = -INFINITY; }
                }
                if (key0 + 63 > qw0 + 128) {
#pragma unroll
                    for (int r = 0; r < 16; ++r) { const int c = 16 * (r >> 3) + (r & 7); if (bb > 128 - c) p0[r] = -INFINITY; if (bb > 96 - c) p1[r] = -INFINITY; }
                }
            }
            p0 = p0 - mrun; p1 = p1 - mrun;
            float mx = __builtin_fmaxf(__builtin_fmaxf(p0[0], p1[0]), __builtin_fmaxf(p0[1], p1[1]));
#pragma unroll
            for (int r = 2; r < 16; r += 2) mx = __builtin_fmaxf(__builtin_fmaxf(mx, p0[r]), __builtin_fmaxf(p1[r], __builtin_fmaxf(p0[r + 1], p1[r + 1])));
            mx = __builtin_fmaxf(mx, __shfl_xor(mx, 32));
            if (__any(mx > 8.0f)) {
                const float dl = mx > 8.0f ? mx : 0.f;
                const float f = __builtin_amdgcn_exp2f(-dl);
                mrun += dl; lrun *= f;
                p0 = p0 - dl; p1 = p1 - dl;
#pragma unroll
                for (int r = 0; r < 16; ++r) { o0[r] *= f; o1[r] *= f; }
            }
            f32x2 ls2 = {0.f, 0.f};
#pragma unroll
            for (int r = 0; r < 16; r += 2) {
                p0[r] = __builtin_amdgcn_exp2f(p0[r]); p0[r + 1] = __builtin_amdgcn_exp2f(p0[r + 1]); p1[r] = __builtin_amdgcn_exp2f(p1[r]); p1[r + 1] = __builtin_amdgcn_exp2f(p1[r + 1]);
                ls2 += (f32x2){p0[r], p0[r + 1]}; ls2 += (f32x2){p1[r], p1[r + 1]};
            }
            lrun += ls2[0] + ls2[1];
            bf16x8 pw[4];
#pragma unroll
            for (int ks = 0; ks < 4; ++ks) {
                u32x4 w;
                if (ks < 2) { w.x = cvt_pk_bf16(p0[8 * ks + 0], p0[8 * ks + 1]); w.y = cvt_pk_bf16(p0[8 * ks + 2], p0[8 * ks + 3]); w.z = cvt_pk_bf16(p0[8 * ks + 4], p0[8 * ks + 5]); w.w = cvt_pk_bf16(p0[8 * ks + 6], p0[8 * ks + 7]); }
                else { const int k2 = ks - 2; w.x = cvt_pk_bf16(p1[8 * k2 + 0], p1[8 * k2 + 1]); w.y = cvt_pk_bf16(p1[8 * k2 + 2], p1[8 * k2 + 3]); w.z = cvt_pk_bf16(p1[8 * k2 + 4], p1[8 * k2 + 5]); w.w = cvt_pk_bf16(p1[8 * k2 + 6], p1[8 * k2 + 7]); }
                pw[ks] = __builtin_bit_cast(bf16x8, w);
            }
#pragma unroll
            for (int ks = 0; ks < 4; ++ks) {
                const bf16x8 va = *(const LAS bf16x8*)(sb + (voff ^ (ks << 5)));
                const bf16x8 vbb = *(const LAS bf16x8*)(sb + (voff ^ (ks << 5)) + 32 * 128);
                o0 = __builtin_amdgcn_mfma_f32_32x32x16_bf16(va, pw[ks], o0, 0, 0, 0);
                o1 = __builtin_amdgcn_mfma_f32_32x32x16_bf16(vbb, pw[ks], o1, 0, 0, 0);
            }
        }
    }
    float lt = lrun + __shfl_xor(lrun, 32);
    const float inv = 1.0f / lt;
    bf16_t* orow = O + (size_t)qrow * ostride;
#pragma unroll
    for (int r4 = 0; r4 < 4; ++r4) {
        u32x2 w0, w1;
        w0.x = cvt_pk_bf16(o0[4 * r4 + 0] * inv, o0[4 * r4 + 1] * inv); w0.y = cvt_pk_bf16(o0[4 * r4 + 2] * inv, o0[4 * r4 + 3] * inv);
        w1.x = cvt_pk_bf16(o1[4 * r4 + 0] * inv, o1[4 * r4 + 1] * inv); w1.y = cvt_pk_bf16(o1[4 * r4 + 2] * inv, o1[4 * r4 + 3] * inv);
        *(u32x2*)(orow + 8 * r4 + 4 * hi) = w0;
        *(u32x2*)(orow + 32 + 8 * r4 + 4 * hi) = w1;
    }
    asm volatile("s_waitcnt vmcnt(0) lgkmcnt(0)" ::: "memory"); __builtin_amdgcn_s_barrier(); asm volatile("" ::: "memory");
}

__device__ __forceinline__ void spatial_unit(int chunk, int g, const float* w_s, const float* b_s, const float* v_gain, const float* ssv, const bf16_t* VbT, bf16_t* MIX) {
    const int tid = threadIdx.x, lane = tid & 63, r32 = lane & 31, hi = lane >> 5, wid = __builtin_amdgcn_readfirstlane(tid >> 6);
    const int pblk = wid & 3, chalf = wid >> 2;
    const int p = 32 * pblk + r32;
    bf16x8 yf[8];
#pragma unroll
    for (int ks = 0; ks < 8; ++ks) {
        const int q = 16 * ks + 8 * hi;
        const f32x4 w0 = *(const f32x4*)(w_s + ((size_t)g * 128 + p) * 128 + q), w1 = *(const f32x4*)(w_s + ((size_t)g * 128 + p) * 128 + q + 4);
        const f32x4 s0 = *(const f32x4*)(ssv + chunk * 128 + q), s1 = *(const f32x4*)(ssv + chunk * 128 + q + 4);
        f32x4 a, b;
#pragma unroll
        for (int i = 0; i < 4; ++i) { a[i] = w0[i] / sqrtf(s0[i] * (1.0f / 512.0f) + EPS); b[i] = w1[i] / sqrtf(s1[i] * (1.0f / 512.0f) + EPS); }
        yf[ks] = __builtin_bit_cast(bf16x8, pack8(a, b));
    }
    const float bs = b_s[g * 128 + p];
    const int row = chunk * 128 + p;
#pragma unroll
    for (int cbk = 0; cbk < 2; ++cbk) {
        const int cblk = 2 * chalf + cbk;
        const bf16_t* xr = VbT + ((size_t)chunk * 512 + 128 * g + 32 * cblk + r32) * 128 + 8 * hi;
        f32x16 acc = {};
#pragma unroll
        for (int ks = 0; ks < 8; ++ks) { const bf16x8 xf = *(const bf16x8*)(xr + 16 * ks); acc = __builtin_amdgcn_mfma_f32_32x32x16_bf16(xf, yf[ks], acc, 0, 0, 0); }
#pragma unroll
        for (int r4 = 0; r4 < 4; ++r4) {
            const int ch = 128 * g + 32 * cblk + 8 * r4 + 4 * hi;
            const f32x4 gn = *(const f32x4*)(v_gain + ch);
            bf16_t* up = MIX + (size_t)row * DM + 512 + ch;
            const u32x2 uu = *(const u32x2*)up;
            const float u0 = __uint_as_float(uu.x << 16), u1 = __uint_as_float(uu.x & 0xffff0000u), u2 = __uint_as_float(uu.y << 16), u3 = __uint_as_float(uu.y & 0xffff0000u);
            u32x2 w;
            w.x = cvt_pk_bf16(u0 * (gn[0] * acc[4 * r4 + 0] + bs), u1 * (gn[1] * acc[4 * r4 + 1] + bs));
            w.y = cvt_pk_bf16(u2 * (gn[2] * acc[4 * r4 + 2] + bs), u3 * (gn[3] * acc[4 * r4 + 3] + bs));
            *(u32x2*)up = w;
        }
    }
}

__device__ __forceinline__ unsigned f2bf(float f) { unsigned u = __builtin_bit_cast(unsigned, f); return (u + 0x7fffu + ((u >> 16) & 1u)) >> 16; }
__device__ __forceinline__ unsigned pk2(float lo, float hi) { return f2bf(lo) | (f2bf(hi) << 16); }
__device__ __forceinline__ float wave_sum(float v) {
#pragma unroll
    for (int o = 1; o < 64; o <<= 1) v += __shfl_xor(v, o);
    return v;
}
__device__ __forceinline__ void transpose_item(const float* W, int K, int N, bf16_t* WT, int k0, int n0, int drow, LAS float* scr, int lane) {
#pragma unroll 8
    for (int i = 0; i < 32; ++i) { const int kk = 2 * i + (lane >> 5); scr[kk * 33 + (lane & 31)] = W[(size_t)(k0 + kk) * N + n0 + (lane & 31)]; }
    asm volatile("s_waitcnt lgkmcnt(0)" ::: "memory");
    const int c = lane & 7;
#pragma unroll
    for (int j = 0; j < 4; ++j) { const int n = (lane >> 3) + 8 * j; const LAS float* s = scr + (8 * c) * 33 + n;
        u32x4 o; o.x = pk2(s[0 * 33], s[1 * 33]); o.y = pk2(s[2 * 33], s[3 * 33]); o.z = pk2(s[4 * 33], s[5 * 33]); o.w = pk2(s[6 * 33], s[7 * 33]);
        *(u32x4*)(WT + (size_t)(drow + n) * K + k0 + 8 * c) = o; }
    asm volatile("s_waitcnt lgkmcnt(0)" ::: "memory");
}
__device__ __forceinline__ int perm_in(int n0) { const int pn = n0 >> 8, rem = n0 & 255; return pn * 256 + ((rem & 63) >> 5) * 128 + (rem >> 6) * 32; }
__device__ __forceinline__ int perm_up(int n0) { const int half = n0 / FF, ch = n0 % FF; return (ch >> 7) * 256 + half * 128 + (ch & 127); }


#define XB_TMO      128
#define XB_XCNT(j)  (256  + 64 * (j))
#define XB_XSUB(j)  (1280 + 64 * (j))
#define XB_XGEN(j)  (2304 + 64 * (j))
#define XB_TOP      3328
#define XB_TOPGEN   3392
#define XCD_BAR_WORDS 3456
#define XB_SPIN_CAP (1u << 18)
__device__ __forceinline__ unsigned xb_ld(unsigned* p)              { return __hip_atomic_load(p, __ATOMIC_RELAXED, __HIP_MEMORY_SCOPE_AGENT); }
__device__ __forceinline__ unsigned xb_add(unsigned* p, unsigned v) { return __hip_atomic_fetch_add(p, v, __ATOMIC_RELAXED, __HIP_MEMORY_SCOPE_AGENT); }
__device__ __forceinline__ unsigned xb_xcc_id() { return (unsigned)__builtin_amdgcn_s_getreg((3 << 11) | 20) & 0xFu; }
#define XB_SPIN(cond, bar) do { unsigned _sp = 0; while (cond) { __builtin_amdgcn_s_sleep(1); \
    if ((++_sp & 255u) == 0u) { if (xb_ld(&(bar)[XB_TMO])) break; if (_sp > XB_SPIN_CAP) { atomicAdd(&(bar)[XB_TMO], 1u); break; } } } } while (0)
struct XcdBarrier { unsigned* bar; unsigned x; volatile LAS unsigned* st; };
__device__ __forceinline__ XcdBarrier xcd_barrier_post(unsigned* bar, volatile LAS unsigned* st) {
    XcdBarrier b; b.bar = bar; b.x = xb_xcc_id(); b.st = st;
    if (threadIdx.x == 0) (void)xb_add(&bar[XB_XCNT(b.x)], 1u);
    return b;
}
__device__ __forceinline__ void xcd_barrier_complete(unsigned* bar, unsigned x, unsigned& nloc, unsigned& nx) {
    const unsigned G = gridDim.x * gridDim.y * gridDim.z;
    unsigned sum, cnt, mine, sp = 0u;
    for (;;) {
        sum = 0u; cnt = 0u; mine = 0u;
#pragma unroll
        for (unsigned j = 0; j < 16; ++j) { const unsigned c = xb_ld(&bar[XB_XCNT(j)]); sum += c; cnt += (c > 0u) ? 1u : 0u; mine = (j == x) ? c : mine; }
        if (sum == G) break;
        __builtin_amdgcn_s_sleep(1);
        if ((++sp & 255u) == 0u) { if (xb_ld(&bar[XB_TMO])) break; if (sp > XB_SPIN_CAP) { atomicAdd(&bar[XB_TMO], 1u); break; } }
    }
    nloc = mine > 0u ? mine : 1u; nx = cnt > 0u ? cnt : 1u;
}
__device__ __forceinline__ void xcd_barrier(const XcdBarrier& b) {
    asm volatile("s_waitcnt vmcnt(0)" ::: "memory");
    __syncthreads();
    if (threadIdx.x == 0) {
        unsigned* bar = b.bar;
        __builtin_amdgcn_s_waitcnt(0);
        unsigned nloc = b.st[0], nx = b.st[1];
        if (nloc == 0u) { xcd_barrier_complete(bar, b.x, nloc, nx); b.st[0] = nloc; b.st[1] = nx; }
        const unsigned old = xb_add(&bar[XB_XSUB(b.x)], 1u);
        const unsigned gen = old / nloc;
        if (old + 1u == (gen + 1u) * nloc) {
            __builtin_amdgcn_fence(__ATOMIC_RELEASE, "agent");
            asm volatile("s_waitcnt vmcnt(0)" ::: "memory");
            const unsigned og = xb_add(&bar[XB_TOP], 1u);
            const unsigned tg = og / nx;
            if (og + 1u == (tg + 1u) * nx) xb_add(&bar[XB_TOPGEN], 1u);
            else XB_SPIN(xb_ld(&bar[XB_TOPGEN]) == tg, bar);
            __builtin_amdgcn_fence(__ATOMIC_ACQUIRE, "agent");
            xb_add(&bar[XB_XGEN(b.x)], 1u);
            asm volatile("s_waitcnt vmcnt(0)" ::: "memory");
        } else {
            XB_SPIN(xb_ld(&bar[XB_XGEN(b.x)]) == gen, bar);
            __builtin_amdgcn_fence(__ATOMIC_ACQUIRE, "agent");
            asm volatile("s_waitcnt vmcnt(0)" ::: "memory");
        }
    }
    __syncthreads();
}

template <bool COOP>
__global__ void __launch_bounds__(512, 2) mk_fwd(Params P) {
    extern __shared__ __attribute__((aligned(16))) unsigned char lds_raw[];
    LAS unsigned char* lds = (LAS unsigned char*)lds_raw;
    const int tid = threadIdx.x, lane = tid & 63, wave = __builtin_amdgcn_readfirstlane(tid >> 6);
    const int G = gridDim.x, bx = blockIdx.x;
    const int gw = bx * 8 + wave, NGW = G * 8;
    unsigned char* ws = P.ws;
    float* out = P.out;
    typedef const float* cfp_t; typedef __attribute__((address_space(4))) const cfp_t* kargp_t;
#define INP(i) ({ kargp_t kp_ = (kargp_t)__builtin_amdgcn_kernarg_segment_ptr(); asm volatile("" : "+s"(kp_)); kp_[i]; })
#define out_ka (out + (size_t)MTOK * DM)
#define out_va (out + (size_t)MTOK * DM + NCTX * 128)
#define out_kc (out + (size_t)MTOK * DM + NCTX * 256)
#define out_vc (out + (size_t)MTOK * DM + NCTX * 512)
#define mod ((float*)(ws + WS_MOD))
#define ss0 ((float*)(ws + WS_SS0))
#define ss1 ((float*)(ws + WS_SS1))
#define ss2 ((float*)(ws + WS_SS2))
#define ss3 ((float*)(ws + WS_SS3))
#define ssv ((float*)(ws + WS_SSV))
#define rope ((float*)(ws + WS_ROPE))
#define biasw ((float*)(ws + WS_BIAS))
#define ZB ((float*)(ws + WS_ZB))
#define CK_A ((bf16_t*)(ws + WS_CK_A))
#define CVT_A ((bf16_t*)(ws + WS_CVT_A))
#define CK_C ((bf16_t*)(ws + WS_CK_C))
#define CVT_C ((bf16_t*)(ws + WS_CVT_C))
#define W_INE ((bf16_t*)(ws + WS_W_INE))
#define W_OUTE ((bf16_t*)(ws + WS_W_OUTE))
#define W_INO ((bf16_t*)(ws + WS_W_INO))
#define W_OUTO ((bf16_t*)(ws + WS_W_OUTO))
#define W_UP ((bf16_t*)(ws + WS_W_UP))
#define W_DN ((bf16_t*)(ws + WS_W_DN))
#define Abuf ((bf16_t*)(ws + WS_A))
#define ACT ((bf16_t*)(ws + WS_ACT))
#define MIX ((bf16_t*)(ws + WS_MIX))
#define Qb ((bf16_t*)(ws + WS_Q))
#define KE ((bf16_t*)(ws + WS_KE))
#define VTE ((bf16_t*)(ws + WS_VTE))
#define VBT ((bf16_t*)(ws + WS_VBT))
#define KO ((bf16_t*)(ws + WS_KO))
#define VTO ((bf16_t*)(ws + WS_VTO))
    LAS float* spare = (LAS float*)(lds + LDS_SPARE);

    const int lo = P.ph_lo, hi = P.ph_hi;
    XcdBarrier xbar; xbar.bar = (unsigned*)(ws + WS_BAR); xbar.x = 0; xbar.st = (volatile LAS unsigned*)(lds + LDS_SPARE + 12288);
    if constexpr (COOP) {
        if (tid < 2) ((LAS unsigned*)(lds + LDS_SPARE + 12288))[tid] = 0u;
        __syncthreads();
        xbar = xcd_barrier_post((unsigned*)(ws + WS_BAR), (volatile LAS unsigned*)(lds + LDS_SPARE + 12288));
    }
#ifndef MK_PHMASK
#define MK_PHMASK 0x3fff
#endif
#define IN(k) ((((MK_PHMASK) >> (k)) & 1) && lo <= (k) && (k) < hi)
#define SEAM(k) do { if constexpr (COOP) { if (IN(k) && IN((k) + 1)) { if ((k) == 0) cg::this_grid().sync(); else xcd_barrier(xbar); } } } while (0)

    if (IN(0)) {
        const float* c_in = INP(6); const float* c_ctx = INP(7); const float* w_mod = INP(8); const float* b_mod = INP(9);
        for (int it = bx; it < 2 * 24 * 16; it += G) {
            const int l = it / 384, cbk = (it % 384) / 16, ksp = it % 16;
            __syncthreads();
            for (int i = tid; i < NCOND * 64; i += 512) { const int cd = i >> 6, k = ksp * 64 + (i & 63); const float v = cd == 0 ? c_ctx[k] : c_in[(cd - 1) * DM + k]; spare[i] = v / (1.0f + __expf(-v)); }
            __syncthreads();
            const int col = cbk * 256 + (tid & 255), kh = tid >> 8;
            float a[NCOND];
#pragma unroll
            for (int cd = 0; cd < NCOND; ++cd) a[cd] = 0.f;
            const float* wp = w_mod + ((size_t)l * DM + ksp * 64 + kh * 32) * MODW + col;
#pragma unroll 4
            for (int k = 0; k < 32; ++k) { const float w = wp[(size_t)k * MODW];
#pragma unroll
                for (int cd = 0; cd < NCOND; ++cd) a[cd] += spare[cd * 64 + kh * 32 + k] * w; }
            const float bm = (ksp == 0 && kh == 0) ? b_mod[l * MODW + col] : 0.f;
#pragma unroll
            for (int cd = 0; cd < NCOND; ++cd) atomicAdd(mod + ((size_t)l * NCOND + cd) * MODW + col, a[cd] + bm);
        }
        __syncthreads();
        {
            const float* w_in_even = INP(10); const float* w_out_even = INP(16); const float* w_in_odd = INP(17); const float* w_out_odd = INP(21); const float* w_up = INP(22); const float* w_down = INP(25);
            LAS float* scr = (LAS float*)(lds + wave * 16384);
            constexpr int I_INE = 16 * 56, I_OUT = 16 * 32, I_INO = 16 * 48, I_UP = 16 * 176, I_DN = 44 * 32;
            constexpr int NIT = I_INE + 2 * I_OUT + I_INO + 2 * I_UP + 2 * I_DN;
            for (int it = gw; it < NIT; it += NGW) {
                int r = it;
                if (r < I_INE) { const int kb = r / 56, nb = r % 56; transpose_item(w_in_even, DM, EVEN_IN, W_INE, 64 * kb, 32 * nb, perm_in(32 * nb), scr, lane); continue; } r -= I_INE;
                if (r < I_OUT) { const int kb = r / 32, nb = r % 32; transpose_item(w_out_even, DM, DM, W_OUTE, 64 * kb, 32 * nb, 32 * nb, scr, lane); continue; } r -= I_OUT;
                if (r < I_INO) { const int kb = r / 48, nb = r % 48; transpose_item(w_in_odd, DM, ODD_IN, W_INO, 64 * kb, 32 * nb, perm_in(32 * nb), scr, lane); continue; } r -= I_INO;
                if (r < I_OUT) { const int kb = r / 32, nb = r % 32; transpose_item(w_out_odd, DM, DM, W_OUTO, 64 * kb, 32 * nb, 32 * nb, scr, lane); continue; } r -= I_OUT;
                if (r < 2 * I_UP) { const int l = r / I_UP, q = r % I_UP, kb = q / 176, nb = q % 176; transpose_item(w_up + (size_t)l * DM * FF2, DM, FF2, W_UP + (size_t)l * FF2 * DM, 64 * kb, 32 * nb, perm_up(32 * nb), scr, lane); continue; } r -= 2 * I_UP;
                { const int l = r / I_DN, q = r % I_DN, kb = q / 32, nb = q % 32; transpose_item(w_down + (size_t)l * FF * DM, FF, DM, W_DN + (size_t)l * DM * FF, 64 * kb, 32 * nb, 32 * nb, scr, lane); }
            }
        }
        {
            const float* cache_k_attn = INP(2); const float* cache_v_attn = INP(3); const float* cache_k_swa = INP(4); const float* cache_v_swa = INP(5);
            const int gt = bx * 512 + tid, NT_ = G * 512;
            for (int i = gt; i < 8 * 512 * 128 / 4; i += NT_) { const f32x4 v = *(const f32x4*)(cache_k_attn + (size_t)i * 4); *(u32x2*)(CK_A + (size_t)i * 4) = (u32x2){pk2(v[0], v[1]), pk2(v[2], v[3])}; }
            for (int i = gt; i < 8 * 512 * 256 / 4; i += NT_) { const f32x4 v = *(const f32x4*)(cache_k_swa + (size_t)i * 4); *(u32x2*)(CK_C + (size_t)i * 4) = (u32x2){pk2(v[0], v[1]), pk2(v[2], v[3])}; }
            for (int i = gt; i < 8 * 64 * 128; i += NT_) { const int cd = i & 127, pc = (i >> 7) & 63, b = i >> 13; const float* s = cache_v_attn + ((size_t)b * 512 + pc * 8) * 128 + cd;
                u32x4 o; o.x = pk2(s[0], s[128]); o.y = pk2(s[256], s[384]); o.z = pk2(s[512], s[640]); o.w = pk2(s[768], s[896]);
                *(u32x4*)(CVT_A + ((size_t)b * 128 + cd) * 512 + pc * 8) = o; }
            for (int i = gt; i < 8 * 64 * 256; i += NT_) { const int cd = i & 255, pc = (i >> 8) & 63, b = i >> 14; const float* s = cache_v_swa + ((size_t)b * 512 + pc * 8) * 256 + cd;
                u32x4 o; o.x = pk2(s[0], s[256]); o.y = pk2(s[512], s[768]); o.z = pk2(s[1024], s[1280]); o.w = pk2(s[1536], s[1792]);
                *(u32x4*)(CVT_C + ((size_t)b * 256 + cd) * 512 + pc * 8) = o; }
            if (gt < 1024) { const int pos = gt >> 4, f = gt & 15; const float inv = exp2f(-(float)f * (13.287712379549449f / 16.0f)); const float ang = (float)pos * inv;
                rope[gt * 2] = cosf(ang); rope[gt * 2 + 1] = sinf(ang); }
        }
    }
    SEAM(0);
    if (IN(1)) {
        const float* x_prompt = INP(0); const float* x_sample = INP(1);
        for (int row = gw; row < MTOK; row += NGW) {
            const float* xr = row < NCTX ? x_prompt + (size_t)row * DM : x_sample + (size_t)(row - NCTX) * DM;
            const int cond = row < NCTX ? 0 : 1 + ((row - NCTX) >> 11);
            const float* sc = mod + (size_t)cond * MODW + 1024;
            f32x4 v[4]; float s = 0.f;
#pragma unroll
            for (int j = 0; j < 4; ++j) { v[j] = *(const f32x4*)(xr + 256 * j + 4 * lane); s += (v[j][0] * v[j][0] + v[j][1] * v[j][1]) + (v[j][2] * v[j][2] + v[j][3] * v[j][3]); }
            s = wave_sum(s);
            if (lane == 0) ss0[row] = s;
#pragma unroll
            for (int j = 0; j < 4; ++j) { const f32x4 s4 = *(const f32x4*)(sc + 256 * j + 4 * lane); const f32x4 h = v[j] * (s4 + 1.0f);
                *(u32x2*)(Abuf + (size_t)row * DM + 256 * j + 4 * lane) = (u32x2){cvt_pk_bf16(h[0], h[1]), cvt_pk_bf16(h[2], h[3])}; }
        }
        constexpr int NB0 = 1792 / 64, NB1 = 5632 / 64, NB2 = 1536 / 64, NBT = NB0 + 2 * NB1 + NB2;
        for (int it = gw; it < NCOND * NBT; it += NGW) {
            const int cond = it / NBT; int r = it % NBT;
            const bf16_t* Wt; const float* sh; float* dst; int N;
            if (r < NB0) { Wt = W_INE; sh = mod + (size_t)cond * MODW; dst = biasw + BIAS_INE; N = 1792; }
            else if ((r -= NB0) < NB1) { Wt = W_UP; sh = mod + (size_t)cond * MODW + 3072; dst = biasw + BIAS_UP0; N = 5632; }
            else if ((r -= NB1) < NB2) { Wt = W_INO; sh = mod + (size_t)(NCOND + cond) * MODW; dst = biasw + BIAS_INO; N = 1536; }
            else { r -= NB2; Wt = W_UP + (size_t)FF2 * DM; sh = mod + (size_t)(NCOND + cond) * MODW + 3072; dst = biasw + BIAS_UP1; N = 5632; }
            float sv[16];
#pragma unroll
            for (int j = 0; j < 4; ++j) { const f32x4 t4 = *(const f32x4*)(sh + 16 * lane + 4 * j); sv[4 * j] = t4[0]; sv[4 * j + 1] = t4[1]; sv[4 * j + 2] = t4[2]; sv[4 * j + 3] = t4[3]; }
            for (int n = 0; n < 64; ++n) {
                const bf16_t* wr_ = Wt + (size_t)(r * 64 + n) * DM + 16 * lane;
                const u32x4 w0 = *(const u32x4*)wr_, w1 = *(const u32x4*)(wr_ + 8);
                float d = 0.f;
#pragma unroll
                for (int j = 0; j < 4; ++j) { d += sv[2 * j] * __uint_as_float(w0[j] << 16) + sv[2 * j + 1] * __uint_as_float(w0[j] & 0xffff0000u); d += sv[8 + 2 * j] * __uint_as_float(w1[j] << 16) + sv[8 + 2 * j + 1] * __uint_as_float(w1[j] & 0xffff0000u); }
                d = wave_sum(d);
                if (lane == 0) dst[(size_t)cond * N + r * 64 + n] = d;
            }
        }
    }
    SEAM(1);
    pg8::StaticOrder S;
    if (IN(2)) {
        pg8::Gemm g{Abuf, W_INE, MTOK, EVEN_IN, DM}; S.init(MTOK, EVEN_IN, G, bx);
        EpiIn<true> E{ss0, biasw + BIAS_INE, INP(11), INP(12), rope, Qb, KE, VTE, MIX, VBT, ssv, out_ka, out_va};
        pg8::gemm_phase<EpiIn<true>, true>(lds, g, S, E);
    }
    SEAM(2);
    if (IN(3)) {
        const float* w_spatial = INP(14); const float* b_spatial = INP(15); const float* v_norm_b = INP(13);
        for (int it = bx; it < 512 + 256 + 768; it += G) {
            if (it < 512) {
                const int b = it >> 6, h = (it >> 3) & 7, qb = it & 7, kvh = h >> 2;
                const size_t row0 = NCTX + (size_t)b * 2048 + qb * 256;
                attn_unit(lds, Qb + row0 * 512 + h * 64, 512, MIX + row0 * DM + h * 64, DM,
                          KE + ((size_t)NCTX + (size_t)b * 2048) * 128 + kvh * 64, 128, VTE + (size_t)NCTX * 128 + (size_t)(b * 2 + kvh) * 64 * 2048, 2048, 0, 32,
                          CK_A + (size_t)b * 512 * 128 + kvh * 64, 128, CVT_A + (size_t)(b * 2 + kvh) * 64 * 512, 512, 8, 0.f, 0.f, -1);
            } else if (it < 768) {
                const int e = it - 512, b = e >> 3, h = e & 7, kvh = h >> 2;
                const size_t row0 = (size_t)b * 256;
                attn_unit(lds, Qb + row0 * 512 + h * 64, 512, MIX + row0 * DM + h * 64, DM,
                          KE + row0 * 128 + kvh * 64, 128, VTE + (size_t)(b * 2 + kvh) * 64 * 256, 256, 0, 4,
                          nullptr, 0, nullptr, 0, 0, 0.f, 0.f, -1);
            } else {
                const int e = it - 768;
                spatial_unit(e >> 2, e & 3, w_spatial, b_spatial, v_norm_b, ssv, VBT, MIX);
            }
        }
    }
    SEAM(3);
    if (IN(4)) {
        pg8::Gemm g{MIX, W_OUTE, MTOK, DM, DM}; S.init(MTOK, DM, G, bx);
        EpiRes E{INP(0), INP(1), out, mod + 2048, mod + 4096, Abuf, ss1};
        pg8::gemm_phase<EpiRes, true>(lds, g, S, E);
    }
    SEAM(4);
#define FFN_PHASES(P5, P6, P7, L, SSIN, BIASOFF, NSCALE, SSOUT, LASTL) \
    if (IN(P5)) { \
        pg8::Gemm g{Abuf, W_UP + (size_t)(L) * FF2 * DM, MTOK, FF2, DM}; S.init(MTOK, FF2, G, bx); \
        EpiUp E{SSIN, biasw + (BIASOFF), INP(23) + (size_t)(L) * 3 * FF2, INP(24) + (size_t)(L) * FF2, ZB, ACT, spare}; \
        pg8::gemm_phase<EpiUp, true>(lds, g, S, E); \
    } \
    SEAM(P5); \
    if (IN(P6)) { \
        const float* cw = INP(23) + (size_t)(L) * 3 * FF2; const float* cb = INP(24) + (size_t)(L) * FF2; \
        for (int i = bx * 512 + tid; i < 8 * 7 * 2 * FF; i += G * 512) { \
            const int ch = i % FF, rs = i / FF, which = rs & 1, sm = (rs >> 1) % 7, b = rs / 14; \
            const int pmA = 32 + b * 8 + sm;                         \
            const int zc = (ch >> 7) * 256 + (ch & 127); \
            const float* zA = ZB + (size_t)pmA * 4 * FF2; const float* zB = ZB + (size_t)(pmA + 1) * 4 * FF2; \
            float ra, rg; \
            if (which == 0) {   \
                ra = cb[ch] + cw[ch] * zA[2 * FF2 + zc] + cw[FF2 + ch] * zA[3 * FF2 + zc] + cw[2 * FF2 + ch] * zB[zc]; \
                rg = cb[FF + ch] + cw[FF + ch] * zA[2 * FF2 + zc + 128] + cw[FF2 + FF + ch] * zA[3 * FF2 + zc + 128] + cw[2 * FF2 + FF + ch] * zB[zc + 128]; \
            } else {            \
                ra = cb[ch] + cw[ch] * zA[3 * FF2 + zc] + cw[FF2 + ch] * zB[zc] + cw[2 * FF2 + ch] * zB[FF2 + zc]; \
                rg = cb[FF + ch] + cw[FF + ch] * zA[3 * FF2 + zc + 128] + cw[FF2 + FF + ch] * zB[zc + 128] + cw[2 * FF2 + FF + ch] * zB[FF2 + zc + 128]; \
            } \
            const int row = pmA * 256 + 255 + which; \
            ACT[(size_t)row * FF + ch] = (bf16_t)(cvt_pk_bf16(ra * silu_f(rg), 0.f) & 0xffffu); \
        } \
    } \
    SEAM(P6); \
    if (IN(P7)) { \
        pg8::Gemm g{ACT, W_DN + (size_t)(L) * DM * FF, MTOK, DM, FF}; S.init(MTOK, DM, G, bx); \
        EpiRes E{out, out + (size_t)NCTX * DM, out, mod + (size_t)(L) * NCOND * MODW + 5120, NSCALE, (LASTL) ? nullptr : Abuf, SSOUT}; \
        pg8::gemm_phase<EpiRes, true>(lds, g, S, E); \
    } \
    SEAM(P7);
    FFN_PHASES(5, 6, 7, 0, ss1, BIAS_UP0, mod + (size_t)NCOND * MODW + 1024, ss2, false)
    if (IN(8)) {
        pg8::Gemm g{Abuf, W_INO, MTOK, ODD_IN, DM}; S.init(MTOK, ODD_IN, G, bx);
        EpiIn<false> E{ss2, biasw + BIAS_INO, INP(18), INP(19), rope, Qb, KO, VTO, MIX, nullptr, nullptr, out_kc, out_vc};
        pg8::gemm_phase<EpiIn<false>, true>(lds, g, S, E);
    }
    SEAM(8);
    if (IN(9)) {
        const float* sink_c = INP(20);
        for (int it = bx; it < 1024 + 512; it += G) {
            if (it < 1024) {
                const int b = it >> 7, h = (it >> 3) & 15, qb = it & 7, kvh = h >> 2;
                const size_t row0 = NCTX + (size_t)b * 2048 + qb * 256;
                const int q0 = qb * 256; int klo = q0 - 128; if (klo < 0) klo = 0; int khi = q0 + 384; if (khi > 2048) khi = 2048;
                attn_unit(lds, Qb + row0 * 1024 + h * 64, 1024, MIX + row0 * DM + h * 64, DM,
                          KO + ((size_t)NCTX + (size_t)b * 2048) * 256 + kvh * 64, 256, VTO + (size_t)NCTX * 256 + (size_t)(b * 4 + kvh) * 64 * 2048, 2048, klo >> 6, (khi - klo) >> 6,
                          CK_C + (size_t)b * 512 * 256 + kvh * 64, 256, CVT_C + (size_t)(b * 4 + kvh) * 64 * 512, 512, 8, sink_c[h] * LOG2E, 1.0f, q0);
            } else {
                const int e = it - 1024, b = e >> 4, h = e & 15, kvh = h >> 2;
                const size_t row0 = (size_t)b * 256;
                attn_unit(lds, Qb + row0 * 1024 + h * 64, 1024, MIX + row0 * DM + h * 64, DM,
                          KO + row0 * 256 + kvh * 64, 256, VTO + (size_t)(b * 4 + kvh) * 64 * 256, 256, 0, 4,
                          nullptr, 0, nullptr, 0, 0, sink_c[h] * LOG2E, 1.0f, -1);
            }
        }
    }
    SEAM(9);
    if (IN(10)) {
        pg8::Gemm g{MIX, W_OUTO, MTOK, DM, DM}; S.init(MTOK, DM, G, bx);
        EpiRes E{out, out + (size_t)NCTX * DM, out, mod + (size_t)NCOND * MODW + 2048, mod + (size_t)NCOND * MODW + 4096, Abuf, ss3};
        pg8::gemm_phase<EpiRes, true>(lds, g, S, E);
    }
    SEAM(10);
    FFN_PHASES(11, 12, 13, 1, ss3, BIAS_UP1, nullptr, nullptr, true)
#undef IN
#undef SEAM
}

constexpr int N_PHASES = 14;

extern "C" void kernel_launch(void* const* d_in, const int* in_sizes, int n_in, void* d_out, int out_size, void* d_ws, size_t ws_size, hipStream_t stream) {
    static int grid = 0;
    if (grid == 0) {
        int dev = 0, cus = 0;
        hipGetDevice(&dev);
        hipDeviceGetAttribute(&cus, hipDeviceAttributeMultiprocessorCount, dev);
        hipFuncSetAttribute((const void*)mk_fwd<true>, hipFuncAttributeMaxDynamicSharedMemorySize, LDS_BYTES);
        hipFuncSetAttribute((const void*)mk_fwd<false>, hipFuncAttributeMaxDynamicSharedMemorySize, LDS_BYTES);
        int per_cu = 0;
        hipOccupancyMaxActiveBlocksPerMultiprocessor(&per_cu, (const void*)mk_fwd<true>, 512, LDS_BYTES);
        (void)hipGetLastError();
        if (per_cu < 1) fprintf(stderr, "kernel_launch: occupancy query says %d blocks/CU\n", per_cu);
        grid = cus > 0 ? cus : 256;
        if (n_in != 26 || ws_size < WS_END) { fprintf(stderr, "kernel_launch: unexpected n_in %d / ws %zu\n", n_in, ws_size); }
    }
    hipMemsetAsync((char*)d_ws, 0, WS_ZERO_BYTES, stream);
    Params p{};
    for (int i = 0; i < 26; ++i) p.in[i] = (const float*)d_in[i];
    p.out = (float*)d_out; p.ws = (unsigned char*)d_ws;
#if MK_COOP
    p.ph_lo = 0; p.ph_hi = N_PHASES;
    void* args[] = {&p};
    hipError_t e = hipLaunchCooperativeKernel((const void*)mk_fwd<true>, dim3(grid), dim3(512), args, LDS_BYTES, stream);
    if (e != hipSuccess) fprintf(stderr, "cooperative launch failed: %s (grid %d)\n", hipGetErrorString(e), grid);
#else
    for (int ph = 0; ph < N_PHASES; ++ph) {
        p.ph_lo = ph; p.ph_hi = ph + 1;
        hipLaunchKernelGGL(mk_fwd<false>, dim3(grid), dim3(512), LDS_BYTES, stream, p);
        if (ph == MK_DUP) hipLaunchKernelGGL(mk_fwd<false>, dim3(grid), dim3(512), LDS_BYTES, stream, p);
    }
#endif
}
```

```cpp
#include <hip/hip_runtime.h>
#include <hip/hip_cooperative_groups.h>
#include <cstdio>
#include <cstdint>
namespace cg = cooperative_groups;

#ifndef MK_COOP
#define MK_COOP 1
#endif

#ifndef MK_DUP
#define MK_DUP -1
#endif
#define LAS __attribute__((address_space(3)))
typedef unsigned short bf16_t;
typedef short bf16x8 __attribute__((ext_vector_type(8)));
typedef short s16x4 __attribute__((ext_vector_type(4)));
typedef float f32x4 __attribute__((ext_vector_type(4)));
typedef float f32x2 __attribute__((ext_vector_type(2)));
typedef float f32x16 __attribute__((ext_vector_type(16)));
typedef unsigned u32x4 __attribute__((ext_vector_type(4)));
typedef unsigned u32x2 __attribute__((ext_vector_type(2)));

constexpr int DM = 1024, NCTX = 8192, NLAT = 16384, MTOK = 24576;
constexpr int EVEN_IN = 1792, ODD_IN = 1536, FF = 2816, FF2 = 5632;
constexpr int NCOND = 9, MODW = 6144;
constexpr float EPS = 1e-6f;
constexpr float LOG2E = 1.4426950408889634f;

constexpr size_t MiB = 1u << 20;
constexpr size_t WS_MOD = 0;
constexpr size_t WS_SS1 = 442368, WS_SS2 = WS_SS1 + 98304, WS_SS3 = WS_SS2 + 98304, WS_SSV = WS_SS3 + 98304;
constexpr size_t WS_BAR = 900 * 1024;
constexpr size_t WS_ZERO_BYTES = 1 * MiB;
constexpr size_t WS_SS0 = 1 * MiB;
constexpr size_t WS_ROPE = 1 * MiB + 128 * 1024;
constexpr size_t WS_BIAS = 1 * MiB + 256 * 1024;
constexpr size_t WS_ZB = 2 * MiB;
constexpr size_t WS_CK_A = 11 * MiB, WS_CVT_A = 12 * MiB, WS_CK_C = 13 * MiB, WS_CVT_C = 15 * MiB;
constexpr size_t WS_W_INE = 18 * MiB, WS_W_OUTE = 22 * MiB, WS_W_INO = 24 * MiB, WS_W_OUTO = 27 * MiB, WS_W_UP = 29 * MiB, WS_W_DN = 51 * MiB;
constexpr size_t WS_A = 62 * MiB;
constexpr size_t WS_BIG = 110 * MiB;
constexpr size_t WS_ACT = WS_BIG;
constexpr size_t WS_MIX = WS_BIG;
constexpr size_t WS_Q = WS_BIG + 48 * MiB;
constexpr size_t WS_KE = WS_Q + 24 * MiB, WS_VTE = WS_KE + 6 * MiB, WS_VBT = WS_VTE + 6 * MiB;
constexpr size_t WS_KO = WS_Q + 48 * MiB, WS_VTO = WS_KO + 12 * MiB;
constexpr size_t WS_END = 256 * MiB;
static_assert(WS_VBT + 24 * MiB <= WS_END && WS_VTO + 12 * MiB <= WS_END && WS_ACT + 132 * MiB <= WS_END, "ws map");
constexpr size_t BIAS_INE = 0, BIAS_UP0 = 9 * 1792, BIAS_INO = BIAS_UP0 + 9 * 5632, BIAS_UP1 = BIAS_INO + 9 * 1536;

constexpr int LDS_BYTES = 147456;
constexpr int LDS_SPARE = 131072;

struct Params {
    const float* in[26];
    float* out;
    unsigned char* ws;
    int ph_lo, ph_hi;
};

namespace pg8 {
constexpr int BM = 256, BK = 64, HALF = 128, HTB = HALF * BK * 2, STAGE_BYTES = 8 * HTB, NXCD = 8, WGM = 8;
__host__ __device__ __forceinline__ int lds_byte(int r, int c) { const int st = (r >> 4) * 2 + (c >> 5), rr = r & 15, cc = c & 31, ob = rr * 64 + cc * 2; return st * 1024 + (ob ^ (((ob >> 9) & 1) << 5)); }
__host__ __device__ __forceinline__ void stage_rc(int b, int& R, int& C) { const int st = b / 1024, sb = b % 1024, swz = sb ^ (((sb >> 9) & 1) << 5); R = (st >> 1) * 16 + swz / 64; C = (st & 1) * 32 + (swz % 64) / 2; }
__host__ __device__ __forceinline__ int perm32(int rho) { const int n = rho >> 4, i = rho & 15; return 8 * (i >> 2) + 4 * n + (i & 3); }
struct Unit { int pm, pn; };
struct Gemm { const bf16_t* A; const bf16_t* Bt; int M, N, K; };
struct StaticOrder {
    int nM, nN, nwg, G, c;
    __device__ __forceinline__ void init(int M, int N, int G_, int c_) { nM = M / BM; nN = N / BM; nwg = nM * nN; G = G_; c = c_; }
    __device__ __forceinline__ bool next(int i, Unit& u) const {
        const long L = (long)i * G + c; if (L >= nwg) return false;
        int wgid = (int)L; { const int q = nwg / NXCD, r = nwg % NXCD, xcd = wgid % NXCD, off = wgid / NXCD; wgid = (xcd < r ? xcd * (q + 1) : r * (q + 1) + (xcd - r) * q) + off; }
        const int nig = WGM * nN, gid = wgid / nig, fm = gid * WGM, gsz = (nM - fm) < WGM ? (nM - fm) : WGM;
        u.pm = fm + ((wgid % nig) % gsz); u.pn = (wgid % nig) / gsz; return true;
    }
};
__device__ __forceinline__ unsigned cvt_pk_bf16(float lo, float hi) { unsigned r; asm volatile("v_cvt_pk_bf16_f32 %0, %1, %2" : "=v"(r) : "v"(lo), "v"(hi)); return r; }

template <class Epi, bool ALIGN_EPI>
__device__ __forceinline__ void gemm_phase(LAS unsigned char* lds, const Gemm g, const StaticOrder& S, const Epi& E) {
    const int tid = threadIdx.x, wid = __builtin_amdgcn_readfirstlane(tid >> 6), lane = tid & 63, wr = wid >> 2, wc = wid & 3, fr = lane & 15, fq = lane >> 4;
    const int K = g.K, nt = K / BK;
    unsigned voffA[2], voffB[2];
#pragma unroll
    for (int i = 0; i < 2; ++i) { int R, C; stage_rc(tid * 16 + i * 8192, R, C); const int Rb = (R & ~31) + perm32(R & 31);
        voffA[i] = (unsigned)(R * K + C) * 2u; voffB[i] = (unsigned)(Rb * K + C) * 2u; }
    const size_t kstep = (size_t)(BK * 2);
    const size_t hstep = (size_t)HALF * K * 2;
    const size_t tstep = 2 * hstep;
    const unsigned ldsw = (unsigned)wid * 1024u;
    const int aoff = lds_byte(wr * 64 + fr, fq * 8), boff = lds_byte(wc * 32 + fr, fq * 8);
#define PG8_SA(b, h) (((b) * 2 + (h)) * HTB)
#define PG8_SB(b, h) ((4 + (b) * 2 + (h)) * HTB)
#define PG8_STAGE(bufoff, gbase, voff) do { _Pragma("unroll") for (int _i = 0; _i < 2; ++_i) \
        __builtin_amdgcn_global_load_lds((const unsigned*)((const char*)(gbase) + (voff)[_i]), (LAS unsigned*)(lds + (bufoff) + ldsw + _i * 8192), 16, 0, 0); } while (0)
#define PG8_LDA(dst, b, h) do { _Pragma("unroll") for (int m = 0; m < 4; ++m) _Pragma("unroll") for (int k = 0; k < 2; ++k) dst[m][k] = *(const LAS bf16x8*)(lds + PG8_SA(b, h) + aoff + m * 2048 + k * 1024); } while (0)
#define PG8_LDB(dst, b, h) do { _Pragma("unroll") for (int n = 0; n < 2; ++n) _Pragma("unroll") for (int k = 0; k < 2; ++k) dst[n][k] = *(const LAS bf16x8*)(lds + PG8_SB(b, h) + boff + n * 2048 + k * 1024); } while (0)
#define PG8_MMA(ai, bj, At, Bt) do { __builtin_amdgcn_s_setprio(1); _Pragma("unroll") for (int m = 0; m < 4; ++m) _Pragma("unroll") for (int n = 0; n < 2; ++n) _Pragma("unroll") for (int k = 0; k < 2; ++k) \
        acc[ai][bj][m][n] = __builtin_amdgcn_mfma_f32_16x16x32_bf16(Bt[n][k], At[m][k], acc[ai][bj][m][n], 0, 0, 0); __builtin_amdgcn_s_setprio(0); } while (0)
#define PG8_WAIT_V(n) asm volatile("s_waitcnt vmcnt(" #n ")" ::: "memory")
#define PG8_WAIT_L(n) asm volatile("s_waitcnt lgkmcnt(" #n ")" ::: "memory")
#define PG8_BAR __builtin_amdgcn_s_barrier()
#define PG8_SCHED __builtin_amdgcn_sched_barrier(0)
    Unit cur, nxt; int ui = 0;
    if (!S.next(0, cur)) return;
    f32x4 acc[2][2][4][2];
#pragma unroll
    for (int a = 0; a < 2; ++a)
#pragma unroll
        for (int b = 0; b < 2; ++b)
#pragma unroll
            for (int m = 0; m < 4; ++m)
#pragma unroll
                for (int n = 0; n < 2; ++n) acc[a][b][m][n] = (f32x4){0.f, 0.f, 0.f, 0.f};
    bf16x8 At[4][2], B0[2][2], B1[2][2];
    const char* cA = (const char*)g.A + (size_t)cur.pm * tstep; const char* cB = (const char*)g.Bt + (size_t)cur.pn * tstep;
    PG8_STAGE(PG8_SB(0, 0), cB, voffB); PG8_STAGE(PG8_SB(0, 1), cB + hstep, voffB); PG8_STAGE(PG8_SA(0, 0), cA, voffA); PG8_STAGE(PG8_SA(0, 1), cA + hstep, voffA);
    if (wr == 1) PG8_BAR;
    PG8_WAIT_V(2); PG8_BAR;
    PG8_STAGE(PG8_SB(1, 0), cB + kstep, voffB); PG8_STAGE(PG8_SA(1, 0), cA + kstep, voffA); PG8_STAGE(PG8_SB(1, 1), cB + hstep + kstep, voffB);
    PG8_WAIT_V(6); PG8_BAR;
    for (;;) {
        const bool has_next = S.next(ui + 1, nxt);
        const char* nA = has_next ? (const char*)g.A + (size_t)nxt.pm * tstep : cA; const char* nB = has_next ? (const char*)g.Bt + (size_t)nxt.pn * tstep : cB;
        for (int t = 0; t < nt; t += 2) {
            const bool last = (t == nt - 2);
            const char* a1 = cA + (size_t)(t + 1) * kstep;
            const char* a2 = last ? nA : cA + (size_t)(t + 2) * kstep; const char* b2 = last ? nB : cB + (size_t)(t + 2) * kstep;
            const char* a3 = a2 + kstep; const char* b3 = b2 + kstep;
            PG8_LDB(B0, 0, 0); PG8_LDB(B1, 0, 1); PG8_SCHED; PG8_LDA(At, 0, 0); PG8_STAGE(PG8_SA(1, 1), a1 + hstep, voffA);
            PG8_WAIT_V(8); PG8_WAIT_L(0); PG8_BAR; PG8_MMA(0, 0, At, B0); PG8_MMA(0, 1, At, B1); PG8_BAR; PG8_SCHED;
            PG8_LDA(At, 0, 1); PG8_STAGE(PG8_SB(0, 0), b2, voffB); PG8_STAGE(PG8_SB(0, 1), b2 + hstep, voffB); PG8_STAGE(PG8_SA(0, 0), a2, voffA);
            PG8_WAIT_V(8); PG8_WAIT_L(0); PG8_BAR; PG8_MMA(1, 0, At, B0); PG8_MMA(1, 1, At, B1); PG8_BAR; PG8_SCHED;
            PG8_LDB(B0, 1, 0); PG8_LDB(B1, 1, 1); PG8_SCHED; PG8_LDA(At, 1, 0); PG8_STAGE(PG8_SA(0, 1), a2 + hstep, voffA);
            PG8_WAIT_V(8); PG8_WAIT_L(0); PG8_BAR; PG8_MMA(0, 0, At, B0); PG8_MMA(0, 1, At, B1); PG8_BAR; PG8_SCHED;
            PG8_LDA(At, 1, 1); PG8_STAGE(PG8_SB(1, 0), b3, voffB); PG8_STAGE(PG8_SB(1, 1), b3 + hstep, voffB); PG8_STAGE(PG8_SA(1, 0), a3, voffA);
            PG8_WAIT_V(8); PG8_WAIT_L(0); PG8_BAR; PG8_MMA(1, 0, At, B0); PG8_MMA(1, 1, At, B1); PG8_BAR; PG8_SCHED;
        }
        if constexpr (ALIGN_EPI) { if (wr == 0) PG8_BAR; }
        E(acc, cur, wr, wc, fr, fq);
        if (!has_next) break;
#pragma unroll
        for (int a = 0; a < 2; ++a)
#pragma unroll
            for (int b = 0; b < 2; ++b)
#pragma unroll
                for (int m = 0; m < 4; ++m)
#pragma unroll
                    for (int n = 0; n < 2; ++n) acc[a][b][m][n] = (f32x4){0.f, 0.f, 0.f, 0.f};
        cur = nxt; cA = nA; cB = nB; ++ui;
        if constexpr (ALIGN_EPI) { if (wr == 1) PG8_BAR; }
    }
    PG8_WAIT_V(0);
    if constexpr (!ALIGN_EPI) { if (wr == 0) PG8_BAR; }
    PG8_BAR;
#undef PG8_SA
#undef PG8_SB
#undef PG8_STAGE
#undef PG8_LDA
#undef PG8_LDB
#undef PG8_MMA
#undef PG8_WAIT_V
#undef PG8_WAIT_L
#undef PG8_BAR
#undef PG8_SCHED
}
}

using pg8::cvt_pk_bf16;
typedef f32x4 (&AccRef)[2][2][4][2];

__device__ __forceinline__ int cond_of_tile(int pm) { return pm < 32 ? 0 : 1 + ((pm - 32) >> 3); }
__device__ __forceinline__ float red_fq(float v) { v += __shfl_xor(v, 16); v += __shfl_xor(v, 32); return v; }
__device__ __forceinline__ float gelu_tanh(float x) { const float u = x + 0.044715f * x * x * x; return x * __builtin_amdgcn_rcpf(1.0f + __builtin_amdgcn_exp2f(-2.302208198f * u)); }
__device__ __forceinline__ float silu_f(float x) { return x * __builtin_amdgcn_rcpf(1.0f + __builtin_amdgcn_exp2f(-LOG2E * x)); }
__device__ __forceinline__ u32x4 pack8(const f32x4 a, const f32x4 b) { u32x4 w; w.x = cvt_pk_bf16(a[0], a[1]); w.y = cvt_pk_bf16(a[2], a[3]); w.z = cvt_pk_bf16(b[0], b[1]); w.w = cvt_pk_bf16(b[2], b[3]); return w; }
__device__ __forceinline__ float bf2f(unsigned short h) { return __uint_as_float((unsigned)h << 16); }

template <class T> __device__ __forceinline__ T ldg(const void* base, unsigned off) { return *(const T*)((const char*)base + off); }
template <class T> __device__ __forceinline__ void stg(void* base, unsigned off, T v) { *(T*)((char*)base + off) = v; }
__device__ __forceinline__ float ss4(const f32x4 v) { return (v[0] * v[0] + v[1] * v[1]) + (v[2] * v[2] + v[3] * v[3]); }

struct EpiRes {
    const float* xp; const float* xs; float* out; const float* gate; const float* nscale; bf16_t* An; float* ssn;
    __device__ __forceinline__ void operator()(AccRef acc, const pg8::Unit& u, int wr, int wc, int fr, int fq) const {
        const int cond = cond_of_tile(u.pm);
        const unsigned colbase = u.pn * 256 + wc * 32 + 8 * fq;
        const bool ctx = u.pm < 32;
        const float* xb = ctx ? xp : xs;
        const unsigned rsub = ctx ? 0u : (unsigned)NCTX;
        const unsigned moff = (cond * MODW + colbase) * 4u;
#pragma unroll
        for (int ai = 0; ai < 2; ++ai)
#pragma unroll
            for (int m = 0; m < 4; ++m) {
                const unsigned row = u.pm * 256 + ai * 128 + wr * 64 + m * 16 + fr;
                const unsigned xoff = ((row - rsub) * DM + colbase) * 4u, ooff = (row * DM + colbase) * 4u;
                float ssum = 0.f;
#pragma unroll
                for (int bj = 0; bj < 2; ++bj) {
                    f32x4 xn[2];
#pragma unroll
                    for (int n = 0; n < 2; ++n) {
                        const f32x4 xo = ldg<f32x4>(xb, xoff + bj * 512 + n * 16);
                        const f32x4 gt = ldg<f32x4>(gate, moff + bj * 512 + n * 16);
                        xn[n] = xo + gt * acc[ai][bj][m][n];
                        stg<f32x4>(out, ooff + bj * 512 + n * 16, xn[n]);
                        ssum += ss4(xn[n]);
                    }
                    if (An) {
                        const f32x4 s0 = ldg<f32x4>(nscale, moff + bj * 512) + 1.0f, s1 = ldg<f32x4>(nscale, moff + bj * 512 + 16) + 1.0f;
                        stg<u32x4>(An, (row * DM + colbase) * 2u + bj * 256, pack8(xn[0] * s0, xn[1] * s1));
                    }
                }
                if (ssn) { ssum = red_fq(ssum); if (fq == 0) atomicAdd((float*)((char*)ssn + row * 4u), ssum); }
                asm volatile("" ::: "memory");
            }
    }
};

template <bool EVEN>
struct EpiIn {
    const float* ss; const float* bias;
    const float* qg; const float* kg;
    const float* rope;
    bf16_t* Q; bf16_t* K; bf16_t* Vt; bf16_t* MIX; bf16_t* VbT; float* ssv;
    float* outk; float* outv;
    __device__ __forceinline__ void operator()(AccRef acc, const pg8::Unit& u, int wr, int wc, int fr, int fq) const {
        constexpr unsigned N = EVEN ? EVEN_IN : ODD_IN, QW = EVEN ? 512 : 1024, KVH = EVEN ? 2 : 4, KW = KVH * 64;
        const int cond = cond_of_tile(u.pm);
        int role; unsigned hidx;
        if (EVEN) { if (u.pn < 2) { role = 0; hidx = 4 * u.pn + wc; } else if (u.pn == 2) { role = wc < 2 ? 1 : 2; hidx = wc & 1; } else if (u.pn < 5) { role = 3; hidx = (u.pn - 3) * 4 + wc; } else { role = 4; hidx = (u.pn - 5) * 4 + wc; } }
        else { if (u.pn < 4) { role = 0; hidx = 4 * u.pn + wc; } else if (u.pn == 4) { role = 1; hidx = wc; } else { role = 2; hidx = wc; } }
        const unsigned boff = (cond * N + u.pn * 256 + wc * 32 + 8 * fq) * 4u;
        const bool lat = u.pm >= 32;
        const unsigned c8 = hidx * 64 + 8 * fq;
        const float* gp = role == 0 ? qg : kg;
#pragma unroll
        for (int ai = 0; ai < 2; ++ai)
#pragma unroll
            for (int m = 0; m < 4; ++m) {
                const unsigned row = u.pm * 256 + ai * 128 + wr * 64 + m * 16 + fr;
                const float rr = 1.0f / sqrtf(ldg<float>(ss, row * 4u) * (1.0f / DM) + EPS);
                f32x4 z[2][2];
#pragma unroll
                for (int bj = 0; bj < 2; ++bj)
#pragma unroll
                    for (int n = 0; n < 2; ++n) z[bj][n] = acc[ai][bj][m][n] * rr + ldg<f32x4>(bias, boff + bj * 512 + n * 16);
                if (role <= 1) {
                    float s2 = (ss4(z[0][0]) + ss4(z[0][1])) + (ss4(z[1][0]) + ss4(z[1][1]));
                    s2 = red_fq(s2);
                    const float rn = 1.0f / sqrtf(s2 * (1.0f / 64.0f) + EPS);
#pragma unroll
                    for (int bj = 0; bj < 2; ++bj)
#pragma unroll
                        for (int n = 0; n < 2; ++n) z[bj][n] = z[bj][n] * rn * ldg<f32x4>(gp, (8 * fq) * 4u + bj * 128 + n * 16);
                    if (role == 1 && !lat) {
#pragma unroll
                        for (int bj = 0; bj < 2; ++bj)
#pragma unroll
                            for (int n = 0; n < 2; ++n) stg<f32x4>(outk, (row * KW + c8) * 4u + bj * 128 + n * 16, z[bj][n]);
                    }
                    if (lat) {
                        const unsigned t = (row - NCTX) & 2047u;
#pragma unroll
                        for (int bj = 0; bj < 2; ++bj) {
                            const unsigned pos = bj == 0 ? (t >> 6) : (t & 63u);
#pragma unroll
                            for (int n = 0; n < 2; ++n) {
                                const f32x4 cs = ldg<f32x4>(rope, (pos * 16 + 4 * fq) * 8u + n * 16);
                                const f32x4 v = z[bj][n];
                                z[bj][n] = (f32x4){v[0] * cs[0] - v[1] * cs[1], v[0] * cs[1] + v[1] * cs[0], v[2] * cs[2] - v[3] * cs[3], v[2] * cs[3] + v[3] * cs[2]};
                            }
                        }
                    }
                    if (role == 0) {
#pragma unroll
                        for (int bj = 0; bj < 2; ++bj) stg<u32x4>(Q, (row * QW + c8) * 2u + bj * 64, pack8(z[bj][0] * (0.125f * LOG2E), z[bj][1] * (0.125f * LOG2E)));
                    } else {
#pragma unroll
                        for (int bj = 0; bj < 2; ++bj) stg<u32x4>(K, (row * KW + c8) * 2u + bj * 64, pack8(z[bj][0], z[bj][1]));
                    }
                } else if (role == 2) {
                    if (!lat) {
#pragma unroll
                        for (int bj = 0; bj < 2; ++bj)
#pragma unroll
                            for (int n = 0; n < 2; ++n) stg<f32x4>(outv, (row * KW + c8) * 4u + bj * 128 + n * 16, z[bj][n]);
                    }
                    unsigned vb, T;
                    if (!lat) { T = 256; vb = ((row >> 8) * KVH + hidx) * 64 * 256 + (row & 255u); }
                    else { T = 2048; vb = NCTX * KW + (((row - NCTX) >> 11) * KVH + hidx) * 64 * 2048 + ((row - NCTX) & 2047u); }
                    vb += 8 * fq * T;
#pragma unroll
                    for (int bj = 0; bj < 2; ++bj)
#pragma unroll
                        for (int n = 0; n < 2; ++n)
#pragma unroll
                            for (int i = 0; i < 4; ++i) stg<bf16_t>(Vt, (vb + (32 * bj + 4 * n + i) * T) * 2u, (bf16_t)(cvt_pk_bf16(z[bj][n][i], 0.f) & 0xffffu));
                } else if (EVEN && role == 3) {
#pragma unroll
                    for (int bj = 0; bj < 2; ++bj) {
                        f32x4 a = z[bj][0], b = z[bj][1];
#pragma unroll
                        for (int i = 0; i < 4; ++i) { a[i] = gelu_tanh(a[i]); b[i] = gelu_tanh(b[i]); }
                        stg<u32x4>(MIX, (row * DM + 512 + c8) * 2u + bj * 64, pack8(a, b));
                    }
                } else if (EVEN) {
                    float s2 = 0.f;
                    const unsigned cb = (row >> 7) * 512 * 128 + (row & 127u) + c8 * 128;
#pragma unroll
                    for (int bj = 0; bj < 2; ++bj)
#pragma unroll
                        for (int n = 0; n < 2; ++n)
#pragma unroll
                            for (int i = 0; i < 4; ++i) {
                                const float gv = gelu_tanh(z[bj][n][i]); s2 += gv * gv;
                                stg<bf16_t>(VbT, (cb + (32 * bj + 4 * n + i) * 128) * 2u, (bf16_t)(cvt_pk_bf16(gv, 0.f) & 0xffffu));
                            }
                    s2 = red_fq(s2);
                    if (fq == 0) atomicAdd((float*)((char*)ssv + row * 4u), s2);
                }
                asm volatile("" ::: "memory");
            }
    }
};

template <int CTRL> __device__ __forceinline__ float dpp_rot(float v) { return __builtin_bit_cast(float, __builtin_amdgcn_update_dpp(0, __builtin_bit_cast(int, v), CTRL, 0xf, 0xf, false)); }
struct EpiUp {
    const float* ss; const float* bias; const float* cw; const float* cbias;
    float* ZB; bf16_t* ACT; LAS float* xch;
    __device__ __forceinline__ void operator()(AccRef acc, const pg8::Unit& u, int wr, int wc, int fr, int fq) const {
        const int cond = cond_of_tile(u.pm);
        const unsigned nb = u.pn * 256 + wc * 32 + 8 * fq;
        const unsigned boff = (cond * FF2 + nb) * 4u;
#pragma unroll
        for (int ai = 0; ai < 2; ++ai)
#pragma unroll
            for (int m = 0; m < 4; ++m) {
                const unsigned row = u.pm * 256 + ai * 128 + wr * 64 + m * 16 + fr;
                const float rr = 1.0f / sqrtf(ldg<float>(ss, row * 4u) * (1.0f / DM) + EPS);
#pragma unroll
                for (int bj = 0; bj < 2; ++bj)
#pragma unroll
                    for (int n = 0; n < 2; ++n) acc[ai][bj][m][n] = acc[ai][bj][m][n] * rr + ldg<f32x4>(bias, boff + bj * 512 + n * 16);
            }
        if (wr == 0 && fr < 2) {
            const unsigned zo = ((u.pm * 4 + fr) * FF2 + nb) * 4u;
#pragma unroll
            for (int bj = 0; bj < 2; ++bj)
#pragma unroll
                for (int n = 0; n < 2; ++n) stg<f32x4>(ZB, zo + bj * 512 + n * 16, acc[0][bj][0][n]);
        }
        if (wr == 1 && fr >= 14) {
            const unsigned zo = ((u.pm * 4 + 2 + (fr - 14)) * FF2 + nb) * 4u;
#pragma unroll
            for (int bj = 0; bj < 2; ++bj)
#pragma unroll
                for (int n = 0; n < 2; ++n) stg<f32x4>(ZB, zo + bj * 512 + n * 16, acc[1][bj][3][n]);
        }
        LAS float* my = xch + (wr * 4 + wc) * 256 + 8 * fq;
        if (fr == 0) {
#pragma unroll
            for (int ai = 0; ai < 2; ++ai)
#pragma unroll
                for (int bj = 0; bj < 2; ++bj)
#pragma unroll
                    for (int n = 0; n < 2; ++n) *(LAS f32x4*)(my + ai * 128 + bj * 32 + 4 * n) = acc[ai][bj][0][n];
        }
        if (fr == 15) {
#pragma unroll
            for (int ai = 0; ai < 2; ++ai)
#pragma unroll
                for (int bj = 0; bj < 2; ++bj)
#pragma unroll
                    for (int n = 0; n < 2; ++n) *(LAS f32x4*)(my + ai * 128 + 64 + bj * 32 + 4 * n) = acc[ai][bj][3][n];
        }
        asm volatile("s_waitcnt lgkmcnt(0)" ::: "memory"); __builtin_amdgcn_s_barrier(); asm volatile("" ::: "memory");
        const unsigned chb = u.pn * 128 + wc * 32 + 8 * fq;
        const float* cw1 = cw + FF2; const float* cw2 = cw + 2 * FF2;
#pragma unroll
        for (int ai = 0; ai < 2; ++ai) {
            const bool hasp = !(ai == 0 && wr == 0), hasn = !(ai == 1 && wr == 1);
            const LAS float* pp = xch + ((wr == 1 ? 0 : 4) + wc) * 256 + (wr == 1 ? ai : 0) * 128 + 64 + 8 * fq;
            const LAS float* pn = xch + ((wr == 0 ? 4 : 0) + wc) * 256 + (wr == 0 ? ai : 1) * 128 + 8 * fq;
            const unsigned arow = ((u.pm * 256 + ai * 128 + wr * 64 + fr) * FF + chb) * 2u;
#pragma unroll
            for (int n = 0; n < 2; ++n) {
                f32x4 sg[4];
#pragma unroll
                for (int pass = 0; pass < 2; ++pass) {
                    const int bj = 1 - pass;
                    const unsigned ci = (bj * FF + chb + 4 * n) * 4u;
                    const f32x4 w0 = ldg<f32x4>(cw, ci), w1 = ldg<f32x4>(cw1, ci), w2 = ldg<f32x4>(cw2, ci), cb = ldg<f32x4>(cbias, ci);
                    f32x4 hp = (f32x4){0.f, 0.f, 0.f, 0.f}, hn = (f32x4){0.f, 0.f, 0.f, 0.f};
                    if (hasp) hp = *(const LAS f32x4*)(pp + bj * 32 + 4 * n);
                    if (hasn) hn = *(const LAS f32x4*)(pn + bj * 32 + 4 * n);
                    f32x4 prevsrc = hp;
#pragma unroll
                    for (int m = 0; m < 4; ++m) {
                        const f32x4 zc = acc[ai][bj][m][n];
                        const f32x4 nsrc = m < 3 ? acc[ai][bj][m < 3 ? m + 1 : 3][n] : hn;
                        f32x4 pv, nv;
#pragma unroll
                        for (int i = 0; i < 4; ++i) {
                            pv[i] = dpp_rot<0x121>(fr == 15 ? prevsrc[i] : zc[i]);
                            nv[i] = dpp_rot<0x12F>(fr == 0 ? nsrc[i] : zc[i]);
                        }
                        f32x4 res = cb + w0 * pv + w1 * zc + w2 * nv;
                        prevsrc = zc;
                        if (pass == 0) {
#pragma unroll
                            for (int i = 0; i < 4; ++i) res[i] = silu_f(res[i]);
                            sg[m] = res;
                        } else {
                            res = res * sg[m];
                            stg<u32x2>(ACT, arow + m * (16 * FF * 2) + n * 8, (u32x2){cvt_pk_bf16(res[0], res[1]), cvt_pk_bf16(res[2], res[3])});
                        }
                    }
                    asm volatile("" ::: "memory");
                }
                asm volatile("" ::: "memory");
            }
        }
    }
};

__device__ __forceinline__ int crow(int r, int hi) { return (r & 3) + 8 * (r >> 2) + 4 * hi; }
__device__ __forceinline__ void attn_unit(LAS unsigned char* lds, const bf16_t* Q, int qstride, bf16_t* O, int ostride,
                                          const bf16_t* K0, int ks0, const bf16_t* V0, int vs0, int t0lo, int nt0,
                                          const bf16_t* K1, int ks1, const bf16_t* V1, int vs1, int nt1,
                                          float m_init, float l_init, int win_q0) {
    const int tid = threadIdx.x, lane = tid & 63, r32 = lane & 31, hi = lane >> 5, wid = __builtin_amdgcn_readfirstlane(tid >> 6);
    const int qrow = wid * 32 + r32;
    bf16x8 qf[4];
#pragma unroll
    for (int d0 = 0; d0 < 4; ++d0) qf[d0] = *(const bf16x8*)(Q + (size_t)qrow * qstride + d0 * 16 + hi * 8);
    float mrun = m_init, lrun = hi == 0 ? l_init : 0.f;
    f32x16 o0 = {}, o1 = {};
    const int NT = nt0 + nt1;
    const int lrow = 8 * wid + (lane >> 3), lch = (lane & 7) ^ ((lrow >> 1) & 7);
    auto dma = [&](int t) {
        const bf16_t* kp; const bf16_t* vp;
        if (t < nt0) { kp = K0 + (size_t)((t0lo + t) * 64 + lrow) * ks0 + lch * 8; vp = V0 + (size_t)lrow * vs0 + (t0lo + t) * 64 + lch * 8; }
        else { kp = K1 + (size_t)((t - nt0) * 64 + lrow) * ks1 + lch * 8; vp = V1 + (size_t)lrow * vs1 + (t - nt0) * 64 + lch * 8; }
        LAS unsigned char* dst = lds + (t & 3) * 16384 + wid * 1024;
        __builtin_amdgcn_global_load_lds((const unsigned*)kp, (LAS unsigned*)dst, 16, 0, 0);
        __builtin_amdgcn_global_load_lds((const unsigned*)vp, (LAS unsigned*)(dst + 8192), 16, 0, 0);
    };
    const int krow = (r32 & 0x13) | ((r32 & 4) << 1) | ((r32 & 8) >> 1);
    const int koff = krow * 128 + ((hi ^ ((krow >> 1) & 7)) << 4);
    const int voff = 8192 + r32 * 128 + ((hi ^ ((r32 >> 1) & 7)) << 4);
    dma(0); if (NT > 1) dma(1); if (NT > 2) dma(2);
    for (int t = 0; t < NT; ++t) {
        if (t + 2 < NT) asm volatile("s_waitcnt vmcnt(4)" ::: "memory");
        else if (t + 1 < NT) asm volatile("s_waitcnt vmcnt(2)" ::: "memory");
        else asm volatile("s_waitcnt vmcnt(0)" ::: "memory");
        __builtin_amdgcn_s_barrier(); asm volatile("" ::: "memory");
        if (t + 3 < NT) dma(t + 3);
        bool active = true;
        int key0 = 0;
        if (win_q0 >= 0 && t < nt0) {
            key0 = (t0lo + t) * 64;
            const int qw0 = win_q0 + wid * 32;
            active = !(key0 + 63 < qw0 - 128 || key0 > qw0 + 31 + 128);
        }
        if (active) {
            const LAS unsigned char* sb = lds + (t & 3) * 16384;
            f32x16 p0 = {}, p1 = {};
#pragma unroll
            for (int d0 = 0; d0 < 4; ++d0) {
                const bf16x8 k0 = *(const LAS bf16x8*)(sb + (koff ^ (d0 << 5)));
                const bf16x8 k1 = *(const LAS bf16x8*)(sb + (koff ^ (d0 << 5)) + 32 * 128);
                p0 = __builtin_amdgcn_mfma_f32_32x32x16_bf16(k0, qf[d0], p0, 0, 0, 0);
                p1 = __builtin_amdgcn_mfma_f32_32x32x16_bf16(k1, qf[d0], p1, 0, 0, 0);
            }
            if (win_q0 >= 0 && t < nt0) {
                const int qw0 = win_q0 + wid * 32;
                const int bb = key0 + 8 * hi - (win_q0 + qrow);
                if (key0 < qw0 + 31 - 128) {
#pragma unroll
                    for (int r = 0; r < 16; ++r) { const int c = 16 * (r >> 3) + (r & 7); if (bb < -128 - c) p0[r] = -INFINITY; if (bb < -160 - c) p1[r] = -INFINITY; }
                }
                if (key0 + 63 > qw0 + 128) {
#pragma unroll
                    for (int r = 0; r < 16; ++r) { const int c = 16 * (r >> 3) + (r & 7); if (bb > 128 - c) p0[r] = -INFINITY; if (bb > 96 - c) p1[r] = -INFINITY; }
                }
            }
            p0 = p0 - mrun; p1 = p1 - mrun;
            float mx = __builtin_fmaxf(__builtin_fmaxf(p0[0], p1[0]), __builtin_fmaxf(p0[1], p1[1]));
#pragma unroll
            for (int r = 2; r < 16; r += 2) mx = __builtin_fmaxf(__builtin_fmaxf(mx, p0[r]), __builtin_fmaxf(p1[r], __builtin_fmaxf(p0[r + 1], p1[r + 1])));
            mx = __builtin_fmaxf(mx, __shfl_xor(mx, 32));
            if (__any(mx > 8.0f)) {
                const float dl = mx > 8.0f ? mx : 0.f;
                const float f = __builtin_amdgcn_exp2f(-dl);
                mrun += dl; lrun *= f;
                p0 = p0 - dl; p1 = p1 - dl;
#pragma unroll
                for (int r = 0; r < 16; ++r) { o0[r] *= f; o1[r] *= f; }
            }
            f32x2 ls2 = {0.f, 0.f};
#pragma unroll
            for (int r = 0; r < 16; r += 2) {
                p0[r] = __builtin_amdgcn_exp2f(p0[r]); p0[r + 1] = __builtin_amdgcn_exp2f(p0[r + 1]); p1[r] = __builtin_amdgcn_exp2f(p1[r]); p1[r + 1] = __builtin_amdgcn_exp2f(p1[r + 1]);
                ls2 += (f32x2){p0[r], p0[r + 1]}; ls2 += (f32x2){p1[r], p1[r + 1]};
            }
            lrun += ls2[0] + ls2[1];
            bf16x8 pw[4];
#pragma unroll
            for (int ks = 0; ks < 4; ++ks) {
                u32x4 w;
                if (ks < 2) { w.x = cvt_pk_bf16(p0[8 * ks + 0], p0[8 * ks + 1]); w.y = cvt_pk_bf16(p0[8 * ks + 2], p0[8 * ks + 3]); w.z = cvt_pk_bf16(p0[8 * ks + 4], p0[8 * ks + 5]); w.w = cvt_pk_bf16(p0[8 * ks + 6], p0[8 * ks + 7]); }
                else { const int k2 = ks - 2; w.x = cvt_pk_bf16(p1[8 * k2 + 0], p1[8 * k2 + 1]); w.y = cvt_pk_bf16(p1[8 * k2 + 2], p1[8 * k2 + 3]); w.z = cvt_pk_bf16(p1[8 * k2 + 4], p1[8 * k2 + 5]); w.w = cvt_pk_bf16(p1[8 * k2 + 6], p1[8 * k2 + 7]); }
                pw[ks] = __builtin_bit_cast(bf16x8, w);
            }
#pragma unroll
            for (int ks = 0; ks < 4; ++ks) {
                const bf16x8 va = *(const LAS bf16x8*)(sb + (voff ^ (ks << 5)));
                const bf16x8 vbb = *(const LAS bf16x8*)(sb + (voff ^ (ks << 5)) + 32 * 128);
                o0 = __builtin_amdgcn_mfma_f32_32x32x16_bf16(va, pw[ks], o0, 0, 0, 0);
                o1 = __builtin_amdgcn_mfma_f32_32x32x16_bf16(vbb, pw[ks], o1, 0, 0, 0);
            }
        }
    }
    float lt = lrun + __shfl_xor(lrun, 32);
    const float inv = 1.0f / lt;
    bf16_t* orow = O + (size_t)qrow * ostride;
#pragma unroll
    for (int r4 = 0; r4 < 4; ++r4) {
        u32x2 w0, w1;
        w0.x = cvt_pk_bf16(o0[4 * r4 + 0] * inv, o0[4 * r4 + 1] * inv); w0.y = cvt_pk_bf16(o0[4 * r4 + 2] * inv, o0[4 * r4 + 3] * inv);
        w1.x = cvt_pk_bf16(o1[4 * r4 + 0] * inv, o1[4 * r4 + 1] * inv); w1.y = cvt_pk_bf16(o1[4 * r4 + 2] * inv, o1[4 * r4 + 3] * inv);
        *(u32x2*)(orow + 8 * r4 + 4 * hi) = w0;
        *(u32x2*)(orow + 32 + 8 * r4 + 4 * hi) = w1;
    }
    asm volatile("s_waitcnt vmcnt(0) lgkmcnt(0)" ::: "memory"); __builtin_amdgcn_s_barrier(); asm volatile("" ::: "memory");
}

__device__ __forceinline__ void spatial_unit(int chunk, int g, const float* w_s, const float* b_s, const float* v_gain, const float* ssv, const bf16_t* VbT, bf16_t* MIX) {
    const int tid = threadIdx.x, lane = tid & 63, r32 = lane & 31, hi = lane >> 5, wid = __builtin_amdgcn_readfirstlane(tid >> 6);
    const int pblk = wid & 3, chalf = wid >> 2;
    const int p = 32 * pblk + r32;
    bf16x8 yf[8];
#pragma unroll
    for (int ks = 0; ks < 8; ++ks) {
        const int q = 16 * ks + 8 * hi;
        const f32x4 w0 = *(const f32x4*)(w_s + ((size_t)g * 128 + p) * 128 + q), w1 = *(const f32x4*)(w_s + ((size_t)g * 128 + p) * 128 + q + 4);
        const f32x4 s0 = *(const f32x4*)(ssv + chunk * 128 + q), s1 = *(const f32x4*)(ssv + chunk * 128 + q + 4);
        f32x4 a, b;
#pragma unroll
        for (int i = 0; i < 4; ++i) { a[i] = w0[i] / sqrtf(s0[i] * (1.0f / 512.0f) + EPS); b[i] = w1[i] / sqrtf(s1[i] * (1.0f / 512.0f) + EPS); }
        yf[ks] = __builtin_bit_cast(bf16x8, pack8(a, b));
    }
    const float bs = b_s[g * 128 + p];
    const int row = chunk * 128 + p;
#pragma unroll
    for (int cbk = 0; cbk < 2; ++cbk) {
        const int cblk = 2 * chalf + cbk;
        const bf16_t* xr = VbT + ((size_t)chunk * 512 + 128 * g + 32 * cblk + r32) * 128 + 8 * hi;
        f32x16 acc = {};
#pragma unroll
        for (int ks = 0; ks < 8; ++ks) { const bf16x8 xf = *(const bf16x8*)(xr + 16 * ks); acc = __builtin_amdgcn_mfma_f32_32x32x16_bf16(xf, yf[ks], acc, 0, 0, 0); }
#pragma unroll
        for (int r4 = 0; r4 < 4; ++r4) {
            const int ch = 128 * g + 32 * cblk + 8 * r4 + 4 * hi;
            const f32x4 gn = *(const f32x4*)(v_gain + ch);
            bf16_t* up = MIX + (size_t)row * DM + 512 + ch;
            const u32x2 uu = *(const u32x2*)up;
            const float u0 = __uint_as_float(uu.x << 16), u1 = __uint_as_float(uu.x & 0xffff0000u), u2 = __uint_as_float(uu.y << 16), u3 = __uint_as_float(uu.y & 0xffff0000u);
            u32x2 w;
            w.x = cvt_pk_bf16(u0 * (gn[0] * acc[4 * r4 + 0] + bs), u1 * (gn[1] * acc[4 * r4 + 1] + bs));
            w.y = cvt_pk_bf16(u2 * (gn[2] * acc[4 * r4 + 2] + bs), u3 * (gn[3] * acc[4 * r4 + 3] + bs));
            *(u32x2*)up = w;
        }
    }
}

__device__ __forceinline__ unsigned f2bf(float f) { unsigned u = __builtin_bit_cast(unsigned, f); return (u + 0x7fffu + ((u >> 16) & 1u)) >> 16; }
__device__ __forceinline__ unsigned pk2(float lo, float hi) { return f2bf(lo) | (f2bf(hi) << 16); }
__device__ __forceinline__ float wave_sum(float v) {
#pragma unroll
    for (int o = 1; o < 64; o <<= 1) v += __shfl_xor(v, o);
    return v;
}
__device__ __forceinline__ void transpose_item(const float* W, int K, int N, bf16_t* WT, int k0, int n0, int drow, LAS float* scr, int lane) {
#pragma unroll 8
    for (int i = 0; i < 32; ++i) { const int kk = 2 * i + (lane >> 5); scr[kk * 33 + (lane & 31)] = W[(size_t)(k0 + kk) * N + n0 + (lane & 31)]; }
    asm volatile("s_waitcnt lgkmcnt(0)" ::: "memory");
    const int c = lane & 7;
#pragma unroll
    for (int j = 0; j < 4; ++j) { const int n = (lane >> 3) + 8 * j; const LAS float* s = scr + (8 * c) * 33 + n;
        u32x4 o; o.x = pk2(s[0 * 33], s[1 * 33]); o.y = pk2(s[2 * 33], s[3 * 33]); o.z = pk2(s[4 * 33], s[5 * 33]); o.w = pk2(s[6 * 33], s[7 * 33]);
        *(u32x4*)(WT + (size_t)(drow + n) * K + k0 + 8 * c) = o; }
    asm volatile("s_waitcnt lgkmcnt(0)" ::: "memory");
}
__device__ __forceinline__ int perm_in(int n0) { const int pn = n0 >> 8, rem = n0 & 255; return pn * 256 + ((rem & 63) >> 5) * 128 + (rem >> 6) * 32; }
__device__ __forceinline__ int perm_up(int n0) { const int half = n0 / FF, ch = n0 % FF; return (ch >> 7) * 256 + half * 128 + (ch & 127); }


#define XB_TMO      128
#define XB_XCNT(j)  (256  + 64 * (j))
#define XB_XSUB(j)  (1280 + 64 * (j))
#define XB_XGEN(j)  (2304 + 64 * (j))
#define XB_TOP      3328
#define XB_TOPGEN   3392
#define XCD_BAR_WORDS 3456
#define XB_SPIN_CAP (1u << 18)
__device__ __forceinline__ unsigned xb_ld(unsigned* p)              { return __hip_atomic_load(p, __ATOMIC_RELAXED, __HIP_MEMORY_SCOPE_AGENT); }
__device__ __forceinline__ unsigned xb_add(unsigned* p, unsigned v) { return __hip_atomic_fetch_add(p, v, __ATOMIC_RELAXED, __HIP_MEMORY_SCOPE_AGENT); }
__device__ __forceinline__ unsigned xb_xcc_id() { return (unsigned)__builtin_amdgcn_s_getreg((3 << 11) | 20) & 0xFu; }
#define XB_SPIN(cond, bar) do { unsigned _sp = 0; while (cond) { __builtin_amdgcn_s_sleep(1); \
    if ((++_sp & 255u) == 0u) { if (xb_ld(&(bar)[XB_TMO])) break; if (_sp > XB_SPIN_CAP) { atomicAdd(&(bar)[XB_TMO], 1u); break; } } } } while (0)
struct XcdBarrier { unsigned* bar; unsigned x; volatile LAS unsigned* st; };
__device__ __forceinline__ XcdBarrier xcd_barrier_post(unsigned* bar, volatile LAS unsigned* st) {
    XcdBarrier b; b.bar = bar; b.x = xb_xcc_id(); b.st = st;
    if (threadIdx.x == 0) (void)xb_add(&bar[XB_XCNT(b.x)], 1u);
    return b;
}
__device__ __forceinline__ void xcd_barrier_complete(unsigned* bar, unsigned x, unsigned& nloc, unsigned& nx) {
    const unsigned G = gridDim.x * gridDim.y * gridDim.z;
    unsigned sum, cnt, mine, sp = 0u;
    for (;;) {
        sum = 0u; cnt = 0u; mine = 0u;
#pragma unroll
        for (unsigned j = 0; j < 16; ++j) { const unsigned c = xb_ld(&bar[XB_XCNT(j)]); sum += c; cnt += (c > 0u) ? 1u : 0u; mine = (j == x) ? c : mine; }
        if (sum == G) break;
        __builtin_amdgcn_s_sleep(1);
        if ((++sp & 255u) == 0u) { if (xb_ld(&bar[XB_TMO])) break; if (sp > XB_SPIN_CAP) { atomicAdd(&bar[XB_TMO], 1u); break; } }
    }
    nloc = mine > 0u ? mine : 1u; nx = cnt > 0u ? cnt : 1u;
}
__device__ __forceinline__ void xcd_barrier(const XcdBarrier& b) {
    asm volatile("s_waitcnt vmcnt(0)" ::: "memory");
    __syncthreads();
    if (threadIdx.x == 0) {
        unsigned* bar = b.bar;
        __builtin_amdgcn_s_waitcnt(0);
        unsigned nloc = b.st[0], nx = b.st[1];
        if (nloc == 0u) { xcd_barrier_complete(bar, b.x, nloc, nx); b.st[0] = nloc; b.st[1] = nx; }
        const unsigned old = xb_add(&bar[XB_XSUB(b.x)], 1u);
        const unsigned gen = old / nloc;
        if (old + 1u == (gen + 1u) * nloc) {
            __builtin_amdgcn_fence(__ATOMIC_RELEASE, "agent");
            asm volatile("s_waitcnt vmcnt(0)" ::: "memory");
            const unsigned og = xb_add(&bar[XB_TOP], 1u);
            const unsigned tg = og / nx;
            if (og + 1u == (tg + 1u) * nx) xb_add(&bar[XB_TOPGEN], 1u);
            else XB_SPIN(xb_ld(&bar[XB_TOPGEN]) == tg, bar);
            __builtin_amdgcn_fence(__ATOMIC_ACQUIRE, "agent");
            xb_add(&bar[XB_XGEN(b.x)], 1u);
            asm volatile("s_waitcnt vmcnt(0)" ::: "memory");
        } else {
            XB_SPIN(xb_ld(&bar[XB_XGEN(b.x)]) == gen, bar);
            __builtin_amdgcn_fence(__ATOMIC_ACQUIRE, "agent");
            asm volatile("s_waitcnt vmcnt(0)" ::: "memory");
        }
    }
    __syncthreads();
}

template <bool COOP>
__global__ void __launch_bounds__(512, 2) mk_fwd(Params P) {
    extern __shared__ __attribute__((aligned(16))) unsigned char lds_raw[];
    LAS unsigned char* lds = (LAS unsigned char*)lds_raw;
    const int tid = threadIdx.x, lane = tid & 63, wave = __builtin_amdgcn_readfirstlane(tid >> 6);
    const int G = gridDim.x, bx = blockIdx.x;
    const int gw = bx * 8 + wave, NGW = G * 8;
    unsigned char* ws = P.ws;
    float* out = P.out;
    typedef const float* cfp_t; typedef __attribute__((address_space(4))) const cfp_t* kargp_t;
#define INP(i) ({ kargp_t kp_ = (kargp_t)__builtin_amdgcn_kernarg_segment_ptr(); asm volatile("" : "+s"(kp_)); kp_[i]; })
#define out_ka (out + (size_t)MTOK * DM)
#define out_va (out + (size_t)MTOK * DM + NCTX * 128)
#define out_kc (out + (size_t)MTOK * DM + NCTX * 256)
#define out_vc (out + (size_t)MTOK * DM + NCTX * 512)
#define mod ((float*)(ws + WS_MOD))
#define ss0 ((float*)(ws + WS_SS0))
#define ss1 ((float*)(ws + WS_SS1))
#define ss2 ((float*)(ws + WS_SS2))
#define ss3 ((float*)(ws + WS_SS3))
#define ssv ((float*)(ws + WS_SSV))
#define rope ((float*)(ws + WS_ROPE))
#define biasw ((float*)(ws + WS_BIAS))
#define ZB ((float*)(ws + WS_ZB))
#define CK_A ((bf16_t*)(ws + WS_CK_A))
#define CVT_A ((bf16_t*)(ws + WS_CVT_A))
#define CK_C ((bf16_t*)(ws + WS_CK_C))
#define CVT_C ((bf16_t*)(ws + WS_CVT_C))
#define W_INE ((bf16_t*)(ws + WS_W_INE))
#define W_OUTE ((bf16_t*)(ws + WS_W_OUTE))
#define W_INO ((bf16_t*)(ws + WS_W_INO))
#define W_OUTO ((bf16_t*)(ws + WS_W_OUTO))
#define W_UP ((bf16_t*)(ws + WS_W_UP))
#define W_DN ((bf16_t*)(ws + WS_W_DN))
#define Abuf ((bf16_t*)(ws + WS_A))
#define ACT ((bf16_t*)(ws + WS_ACT))
#define MIX ((bf16_t*)(ws + WS_MIX))
#define Qb ((bf16_t*)(ws + WS_Q))
#define KE ((bf16_t*)(ws + WS_KE))
#define VTE ((bf16_t*)(ws + WS_VTE))
#define VBT ((bf16_t*)(ws + WS_VBT))
#define KO ((bf16_t*)(ws + WS_KO))
#define VTO ((bf16_t*)(ws + WS_VTO))
    LAS float* spare = (LAS float*)(lds + LDS_SPARE);

    const int lo = P.ph_lo, hi = P.ph_hi;
    XcdBarrier xbar; xbar.bar = (unsigned*)(ws + WS_BAR); xbar.x = 0; xbar.st = (volatile LAS unsigned*)(lds + LDS_SPARE + 12288);
    if constexpr (COOP) {
        if (tid < 2) ((LAS unsigned*)(lds + LDS_SPARE + 12288))[tid] = 0u;
        __syncthreads();
        xbar = xcd_barrier_post((unsigned*)(ws + WS_BAR), (volatile LAS unsigned*)(lds + LDS_SPARE + 12288));
        if (P.ph_lo < 0) cg::this_grid().sync();
    }
#ifndef MK_PHMASK
#define MK_PHMASK 0x3fff
#endif
#define IN(k) ((((MK_PHMASK) >> (k)) & 1) && lo <= (k) && (k) < hi)
#define SEAM(k) do { if constexpr (COOP) { if (IN(k) && IN((k) + 1)) { xcd_barrier(xbar); } } } while (0)

    if (IN(0)) {
        const float* c_in = INP(6); const float* c_ctx = INP(7); const float* w_mod = INP(8); const float* b_mod = INP(9);
        for (int it = bx; it < 2 * 24 * 16; it += G) {
            const int l = it / 384, cbk = (it % 384) / 16, ksp = it % 16;
            __syncthreads();
            for (int i = tid; i < NCOND * 64; i += 512) { const int cd = i >> 6, k = ksp * 64 + (i & 63); const float v = cd == 0 ? c_ctx[k] : c_in[(cd - 1) * DM + k]; spare[i] = v / (1.0f + __expf(-v)); }
            __syncthreads();
            const int col = cbk * 256 + (tid & 255), kh = tid >> 8;
            float a[NCOND];
#pragma unroll
            for (int cd = 0; cd < NCOND; ++cd) a[cd] = 0.f;
            const float* wp = w_mod + ((size_t)l * DM + ksp * 64 + kh * 32) * MODW + col;
#pragma unroll 4
            for (int k = 0; k < 32; ++k) { const float w = wp[(size_t)k * MODW];
#pragma unroll
                for (int cd = 0; cd < NCOND; ++cd) a[cd] += spare[cd * 64 + kh * 32 + k] * w; }
            const float bm = (ksp == 0 && kh == 0) ? b_mod[l * MODW + col] : 0.f;
#pragma unroll
            for (int cd = 0; cd < NCOND; ++cd) atomicAdd(mod + ((size_t)l * NCOND + cd) * MODW + col, a[cd] + bm);
        }
        __syncthreads();
        {
            const float* w_in_even = INP(10); const float* w_out_even = INP(16); const float* w_in_odd = INP(17); const float* w_out_odd = INP(21); const float* w_up = INP(22); const float* w_down = INP(25);
            LAS float* scr = (LAS float*)(lds + wave * 16384);
            constexpr int I_INE = 16 * 56, I_OUT = 16 * 32, I_INO = 16 * 48, I_UP = 16 * 176, I_DN = 44 * 32;
            constexpr int NIT = I_INE + 2 * I_OUT + I_INO + 2 * I_UP + 2 * I_DN;
            for (int it = gw; it < NIT; it += NGW) {
                int r = it;
                if (r < I_INE) { const int kb = r / 56, nb = r % 56; transpose_item(w_in_even, DM, EVEN_IN, W_INE, 64 * kb, 32 * nb, perm_in(32 * nb), scr, lane); continue; } r -= I_INE;
                if (r < I_OUT) { const int kb = r / 32, nb = r % 32; transpose_item(w_out_even, DM, DM, W_OUTE, 64 * kb, 32 * nb, 32 * nb, scr, lane); continue; } r -= I_OUT;
                if (r < I_INO) { const int kb = r / 48, nb = r % 48; transpose_item(w_in_odd, DM, ODD_IN, W_INO, 64 * kb, 32 * nb, perm_in(32 * nb), scr, lane); continue; } r -= I_INO;
                if (r < I_OUT) { const int kb = r / 32, nb = r % 32; transpose_item(w_out_odd, DM, DM, W_OUTO, 64 * kb, 32 * nb, 32 * nb, scr, lane); continue; } r -= I_OUT;
                if (r < 2 * I_UP) { const int l = r / I_UP, q = r % I_UP, kb = q / 176, nb = q % 176; transpose_item(w_up + (size_t)l * DM * FF2, DM, FF2, W_UP + (size_t)l * FF2 * DM, 64 * kb, 32 * nb, perm_up(32 * nb), scr, lane); continue; } r -= 2 * I_UP;
                { const int l = r / I_DN, q = r % I_DN, kb = q / 32, nb = q % 32; transpose_item(w_down + (size_t)l * FF * DM, FF, DM, W_DN + (size_t)l * DM * FF, 64 * kb, 32 * nb, 32 * nb, scr, lane); }
            }
        }
        {
            const float* cache_k_attn = INP(2); const float* cache_v_attn = INP(3); const float* cache_k_swa = INP(4); const float* cache_v_swa = INP(5);
            const int gt = bx * 512 + tid, NT_ = G * 512;
            for (int i = gt; i < 8 * 512 * 128 / 4; i += NT_) { const f32x4 v = *(const f32x4*)(cache_k_attn + (size_t)i * 4); *(u32x2*)(CK_A + (size_t)i * 4) = (u32x2){pk2(v[0], v[1]), pk2(v[2], v[3])}; }
            for (int i = gt; i < 8 * 512 * 256 / 4; i += NT_) { const f32x4 v = *(const f32x4*)(cache_k_swa + (size_t)i * 4); *(u32x2*)(CK_C + (size_t)i * 4) = (u32x2){pk2(v[0], v[1]), pk2(v[2], v[3])}; }
            for (int i = gt; i < 8 * 64 * 128; i += NT_) { const int cd = i & 127, pc = (i >> 7) & 63, b = i >> 13; const float* s = cache_v_attn + ((size_t)b * 512 + pc * 8) * 128 + cd;
                u32x4 o; o.x = pk2(s[0], s[128]); o.y = pk2(s[256], s[384]); o.z = pk2(s[512], s[640]); o.w = pk2(s[768], s[896]);
                *(u32x4*)(CVT_A + ((size_t)b * 128 + cd) * 512 + pc * 8) = o; }
            for (int i = gt; i < 8 * 64 * 256; i += NT_) { const int cd = i & 255, pc = (i >> 8) & 63, b = i >> 14; const float* s = cache_v_swa + ((size_t)b * 512 + pc * 8) * 256 + cd;
                u32x4 o; o.x = pk2(s[0], s[256]); o.y = pk2(s[512], s[768]); o.z = pk2(s[1024], s[1280]); o.w = pk2(s[1536], s[1792]);
                *(u32x4*)(CVT_C + ((size_t)b * 256 + cd) * 512 + pc * 8) = o; }
            if (gt < 1024) { const int pos = gt >> 4, f = gt & 15; const float inv = exp2f(-(float)f * (13.287712379549449f / 16.0f)); const float ang = (float)pos * inv;
                rope[gt * 2] = cosf(ang); rope[gt * 2 + 1] = sinf(ang); }
        }
    }
    SEAM(0);
    if (IN(1)) {
        const float* x_prompt = INP(0); const float* x_sample = INP(1);
        for (int row = gw; row < MTOK; row += NGW) {
            const float* xr = row < NCTX ? x_prompt + (size_t)row * DM : x_sample + (size_t)(row - NCTX) * DM;
            const int cond = row < NCTX ? 0 : 1 + ((row - NCTX) >> 11);
            const float* sc = mod + (size_t)cond * MODW + 1024;
            f32x4 v[4]; float s = 0.f;
#pragma unroll
            for (int j = 0; j < 4; ++j) { v[j] = *(const f32x4*)(xr + 256 * j + 4 * lane); s += (v[j][0] * v[j][0] + v[j][1] * v[j][1]) + (v[j][2] * v[j][2] + v[j][3] * v[j][3]); }
            s = wave_sum(s);
            if (lane == 0) ss0[row] = s;
#pragma unroll
            for (int j = 0; j < 4; ++j) { const f32x4 s4 = *(const f32x4*)(sc + 256 * j + 4 * lane); const f32x4 h = v[j] * (s4 + 1.0f);
                *(u32x2*)(Abuf + (size_t)row * DM + 256 * j + 4 * lane) = (u32x2){cvt_pk_bf16(h[0], h[1]), cvt_pk_bf16(h[2], h[3])}; }
        }
        constexpr int NB0 = 1792 / 64, NB1 = 5632 / 64, NB2 = 1536 / 64, NBT = NB0 + 2 * NB1 + NB2;
        for (int it = gw; it < NCOND * NBT; it += NGW) {
            const int cond = it / NBT; int r = it % NBT;
            const bf16_t* Wt; const float* sh; float* dst; int N;
            if (r < NB0) { Wt = W_INE; sh = mod + (size_t)cond * MODW; dst = biasw + BIAS_INE; N = 1792; }
            else if ((r -= NB0) < NB1) { Wt = W_UP; sh = mod + (size_t)cond * MODW + 3072; dst = biasw + BIAS_UP0; N = 5632; }
            else if ((r -= NB1) < NB2) { Wt = W_INO; sh = mod + (size_t)(NCOND + cond) * MODW; dst = biasw + BIAS_INO; N = 1536; }
            else { r -= NB2; Wt = W_UP + (size_t)FF2 * DM; sh = mod + (size_t)(NCOND + cond) * MODW + 3072; dst = biasw + BIAS_UP1; N = 5632; }
            float sv[16];
#pragma unroll
            for (int j = 0; j < 4; ++j) { const f32x4 t4 = *(const f32x4*)(sh + 16 * lane + 4 * j); sv[4 * j] = t4[0]; sv[4 * j + 1] = t4[1]; sv[4 * j + 2] = t4[2]; sv[4 * j + 3] = t4[3]; }
            for (int n = 0; n < 64; ++n) {
                const bf16_t* wr_ = Wt + (size_t)(r * 64 + n) * DM + 16 * lane;
                const u32x4 w0 = *(const u32x4*)wr_, w1 = *(const u32x4*)(wr_ + 8);
                float d = 0.f;
#pragma unroll
                for (int j = 0; j < 4; ++j) { d += sv[2 * j] * __uint_as_float(w0[j] << 16) + sv[2 * j + 1] * __uint_as_float(w0[j] & 0xffff0000u); d += sv[8 + 2 * j] * __uint_as_float(w1[j] << 16) + sv[8 + 2 * j + 1] * __uint_as_float(w1[j] & 0xffff0000u); }
                d = wave_sum(d);
                if (lane == 0) dst[(size_t)cond * N + r * 64 + n] = d;
            }
        }
    }
    SEAM(1);
    pg8::StaticOrder S;
    if (IN(2)) {
        pg8::Gemm g{Abuf, W_INE, MTOK, EVEN_IN, DM}; S.init(MTOK, EVEN_IN, G, bx);
        EpiIn<true> E{ss0, biasw + BIAS_INE, INP(11), INP(12), rope, Qb, KE, VTE, MIX, VBT, ssv, out_ka, out_va};
        pg8::gemm_phase<EpiIn<true>, true>(lds, g, S, E);
    }
    SEAM(2);
    if (IN(3)) {
        const float* w_spatial = INP(14); const float* b_spatial = INP(15); const float* v_norm_b = INP(13);
        for (int it = bx; it < 512 + 256 + 768; it += G) {
            if (it < 512) {
                const int b = it >> 6, h = (it >> 3) & 7, qb = it & 7, kvh = h >> 2;
                const size_t row0 = NCTX + (size_t)b * 2048 + qb * 256;
                attn_unit(lds, Qb + row0 * 512 + h * 64, 512, MIX + row0 * DM + h * 64, DM,
                          KE + ((size_t)NCTX + (size_t)b * 2048) * 128 + kvh * 64, 128, VTE + (size_t)NCTX * 128 + (size_t)(b * 2 + kvh) * 64 * 2048, 2048, 0, 32,
                          CK_A + (size_t)b * 512 * 128 + kvh * 64, 128, CVT_A + (size_t)(b * 2 + kvh) * 64 * 512, 512, 8, 0.f, 0.f, -1);
            } else if (it < 768) {
                const int e = it - 512, b = e >> 3, h = e & 7, kvh = h >> 2;
                const size_t row0 = (size_t)b * 256;
                attn_unit(lds, Qb + row0 * 512 + h * 64, 512, MIX + row0 * DM + h * 64, DM,
                          KE + row0 * 128 + kvh * 64, 128, VTE + (size_t)(b * 2 + kvh) * 64 * 256, 256, 0, 4,
                          nullptr, 0, nullptr, 0, 0, 0.f, 0.f, -1);
            } else {
                const int e = it - 768;
                spatial_unit(e >> 2, e & 3, w_spatial, b_spatial, v_norm_b, ssv, VBT, MIX);
            }
        }
    }
    SEAM(3);
    if (IN(4)) {
        pg8::Gemm g{MIX, W_OUTE, MTOK, DM, DM}; S.init(MTOK, DM, G, bx);
        EpiRes E{INP(0), INP(1), out, mod + 2048, mod + 4096, Abuf, ss1};
        pg8::gemm_phase<EpiRes, true>(lds, g, S, E);
    }
    SEAM(4);
#define FFN_PHASES(P5, P6, P7, L, SSIN, BIASOFF, NSCALE, SSOUT, LASTL) \
    if (IN(P5)) { \
        pg8::Gemm g{Abuf, W_UP + (size_t)(L) * FF2 * DM, MTOK, FF2, DM}; S.init(MTOK, FF2, G, bx); \
        EpiUp E{SSIN, biasw + (BIASOFF), INP(23) + (size_t)(L) * 3 * FF2, INP(24) + (size_t)(L) * FF2, ZB, ACT, spare}; \
        pg8::gemm_phase<EpiUp, true>(lds, g, S, E); \
    } \
    SEAM(P5); \
    if (IN(P6)) { \
        const float* cw = INP(23) + (size_t)(L) * 3 * FF2; const float* cb = INP(24) + (size_t)(L) * FF2; \
        for (int i = bx * 512 + tid; i < 8 * 7 * 2 * FF; i += G * 512) { \
            const int ch = i % FF, rs = i / FF, which = rs & 1, sm = (rs >> 1) % 7, b = rs / 14; \
            const int pmA = 32 + b * 8 + sm;                         \
            const int zc = (ch >> 7) * 256 + (ch & 127); \
            const float* zA = ZB + (size_t)pmA * 4 * FF2; const float* zB = ZB + (size_t)(pmA + 1) * 4 * FF2; \
            float ra, rg; \
            if (which == 0) {   \
                ra = cb[ch] + cw[ch] * zA[2 * FF2 + zc] + cw[FF2 + ch] * zA[3 * FF2 + zc] + cw[2 * FF2 + ch] * zB[zc]; \
                rg = cb[FF + ch] + cw[FF + ch] * zA[2 * FF2 + zc + 128] + cw[FF2 + FF + ch] * zA[3 * FF2 + zc + 128] + cw[2 * FF2 + FF + ch] * zB[zc + 128]; \
            } else {            \
                ra = cb[ch] + cw[ch] * zA[3 * FF2 + zc] + cw[FF2 + ch] * zB[zc] + cw[2 * FF2 + ch] * zB[FF2 + zc]; \
                rg = cb[FF + ch] + cw[FF + ch] * zA[3 * FF2 + zc + 128] + cw[FF2 + FF + ch] * zB[zc + 128] + cw[2 * FF2 + FF + ch] * zB[FF2 + zc + 128]; \
            } \
            const int row = pmA * 256 + 255 + which; \
            ACT[(size_t)row * FF + ch] = (bf16_t)(cvt_pk_bf16(ra * silu_f(rg), 0.f) & 0xffffu); \
        } \
    } \
    SEAM(P6); \
    if (IN(P7)) { \
        pg8::Gemm g{ACT, W_DN + (size_t)(L) * DM * FF, MTOK, DM, FF}; S.init(MTOK, DM, G, bx); \
        EpiRes E{out, out + (size_t)NCTX * DM, out, mod + (size_t)(L) * NCOND * MODW + 5120, NSCALE, (LASTL) ? nullptr : Abuf, SSOUT}; \
        pg8::gemm_phase<EpiRes, true>(lds, g, S, E); \
    } \
    SEAM(P7);
    FFN_PHASES(5, 6, 7, 0, ss1, BIAS_UP0, mod + (size_t)NCOND * MODW + 1024, ss2, false)
    if (IN(8)) {
        pg8::Gemm g{Abuf, W_INO, MTOK, ODD_IN, DM}; S.init(MTOK, ODD_IN, G, bx);
        EpiIn<false> E{ss2, biasw + BIAS_INO, INP(18), INP(19), rope, Qb, KO, VTO, MIX, nullptr, nullptr, out_kc, out_vc};
        pg8::gemm_phase<EpiIn<false>, true>(lds, g, S, E);
    }
    SEAM(8);
    if (IN(9)) {
        const float* sink_c = INP(20);
        for (int it = bx; it < 1024 + 512; it += G) {
            if (it < 1024) {
                const int b = it >> 7, h = (it >> 3) & 15, qb = it & 7, kvh = h >> 2;
                const size_t row0 = NCTX + (size_t)b * 2048 + qb * 256;
                const int q0 = qb * 256; int klo = q0 - 128; if (klo < 0) klo = 0; int khi = q0 + 384; if (khi > 2048) khi = 2048;
                attn_unit(lds, Qb + row0 * 1024 + h * 64, 1024, MIX + row0 * DM + h * 64, DM,
                          KO + ((size_t)NCTX + (size_t)b * 2048) * 256 + kvh * 64, 256, VTO + (size_t)NCTX * 256 + (size_t)(b * 4 + kvh) * 64 * 2048, 2048, klo >> 6, (khi - klo) >> 6,
                          CK_C + (size_t)b * 512 * 256 + kvh * 64, 256, CVT_C + (size_t)(b * 4 + kvh) * 64 * 512, 512, 8, sink_c[h] * LOG2E, 1.0f, q0);
            } else {
                const int e = it - 1024, b = e >> 4, h = e & 15, kvh = h >> 2;
                const size_t row0 = (size_t)b * 256;
                attn_unit(lds, Qb + row0 * 1024 + h * 64, 1024, MIX + row0 * DM + h * 64, DM,
                          KO + row0 * 256 + kvh * 64, 256, VTO + (size_t)(b * 4 + kvh) * 64 * 256, 256, 0, 4,
                          nullptr, 0, nullptr, 0, 0, sink_c[h] * LOG2E, 1.0f, -1);
            }
        }
    }
    SEAM(9);
    if (IN(10)) {
        pg8::Gemm g{MIX, W_OUTO, MTOK, DM, DM}; S.init(MTOK, DM, G, bx);
        EpiRes E{out, out + (size_t)NCTX * DM, out, mod + (size_t)NCOND * MODW + 2048, mod + (size_t)NCOND * MODW + 4096, Abuf, ss3};
        pg8::gemm_phase<EpiRes, true>(lds, g, S, E);
    }
    SEAM(10);
    FFN_PHASES(11, 12, 13, 1, ss3, BIAS_UP1, nullptr, nullptr, true)
#undef IN
#undef SEAM
}

constexpr int N_PHASES = 14;

extern "C" void kernel_launch(void* const* d_in, const int* in_sizes, int n_in, void* d_out, int out_size, void* d_ws, size_t ws_size, hipStream_t stream) {
    static int grid = 0;
    if (grid == 0) {
        int dev = 0, cus = 0;
        hipGetDevice(&dev);
        hipDeviceGetAttribute(&cus, hipDeviceAttributeMultiprocessorCount, dev);
        hipFuncSetAttribute((const void*)mk_fwd<true>, hipFuncAttributeMaxDynamicSharedMemorySize, LDS_BYTES);
        hipFuncSetAttribute((const void*)mk_fwd<false>, hipFuncAttributeMaxDynamicSharedMemorySize, LDS_BYTES);
        int per_cu = 0;
        hipOccupancyMaxActiveBlocksPerMultiprocessor(&per_cu, (const void*)mk_fwd<true>, 512, LDS_BYTES);
        (void)hipGetLastError();
        if (per_cu < 1) fprintf(stderr, "kernel_launch: occupancy query says %d blocks/CU\n", per_cu);
        grid = cus > 0 ? cus : 256;
        if (n_in != 26 || ws_size < WS_END) { fprintf(stderr, "kernel_launch: unexpected n_in %d / ws %zu\n", n_in, ws_size); }
    }
    hipMemsetAsync((char*)d_ws, 0, WS_ZERO_BYTES, stream);
    Params p{};
    for (int i = 0; i < 26; ++i) p.in[i] = (const float*)d_in[i];
    p.out = (float*)d_out; p.ws = (unsigned char*)d_ws;
#if MK_COOP
    p.ph_lo = 0; p.ph_hi = N_PHASES;
    void* args[] = {&p};
    hipError_t e = hipLaunchCooperativeKernel((const void*)mk_fwd<true>, dim3(grid), dim3(512), args, LDS_BYTES, stream);
    if (e != hipSuccess) fprintf(stderr, "cooperative launch failed: %s (grid %d)\n", hipGetErrorString(e), grid);
#else
    for (int ph = 0; ph < N_PHASES; ++ph) {
        p.ph_lo = ph; p.ph_hi = ph + 1;
        hipLaunchKernelGGL(mk_fwd<false>, dim3(grid), dim3(512), LDS_BYTES, stream, p);
        if (ph == MK_DUP) hipLaunchKernelGGL(mk_fwd<false>, dim3(grid), dim3(512), LDS_BYTES, stream, p);
    }
#endif
}
```

```cpp
#include <hip/hip_runtime.h>
#include <hip/hip_cooperative_groups.h>
#include <cstdio>
#include <cstdint>
namespace cg = cooperative_groups;

#ifndef MK_COOP
#define MK_COOP 1
#endif

#ifndef MK_DUP
#define MK_DUP -1
#endif
#define LAS __attribute__((address_space(3)))
typedef unsigned short bf16_t;
typedef short bf16x8 __attribute__((ext_vector_type(8)));
typedef short s16x4 __attribute__((ext_vector_type(4)));
typedef float f32x4 __attribute__((ext_vector_type(4)));
typedef float f32x2 __attribute__((ext_vector_type(2)));
typedef float f32x16 __attribute__((ext_vector_type(16)));
typedef unsigned u32x4 __attribute__((ext_vector_type(4)));
typedef unsigned u32x2 __attribute__((ext_vector_type(2)));

constexpr int DM = 1024, NCTX = 8192, NLAT = 16384, MTOK = 24576;
constexpr int EVEN_IN = 1792, ODD_IN = 1536, FF = 2816, FF2 = 5632;
constexpr int NCOND = 9, MODW = 6144;
constexpr float EPS = 1e-6f;
constexpr float LOG2E = 1.4426950408889634f;

constexpr size_t MiB = 1u << 20;
constexpr size_t WS_MOD = 0;
constexpr size_t WS_SS1 = 442368, WS_SS2 = WS_SS1 + 98304, WS_SS3 = WS_SS2 + 98304, WS_SSV = WS_SS3 + 98304;
constexpr size_t WS_BAR = 900 * 1024;
constexpr size_t WS_ZERO_BYTES = 1 * MiB;
constexpr size_t WS_SS0 = 1 * MiB;
constexpr size_t WS_ROPE = 1 * MiB + 128 * 1024;
constexpr size_t WS_BIAS = 1 * MiB + 256 * 1024;
constexpr size_t WS_ZB = 2 * MiB;
constexpr size_t WS_CK_A = 11 * MiB, WS_CVT_A = 12 * MiB, WS_CK_C = 13 * MiB, WS_CVT_C = 15 * MiB;
constexpr size_t WS_W_INE = 18 * MiB, WS_W_OUTE = 22 * MiB, WS_W_INO = 24 * MiB, WS_W_OUTO = 27 * MiB, WS_W_UP = 29 * MiB, WS_W_DN = 51 * MiB;
constexpr size_t WS_A = 62 * MiB;
constexpr size_t WS_BIG = 110 * MiB;
constexpr size_t WS_ACT = WS_BIG;
constexpr size_t WS_MIX = WS_BIG;
constexpr size_t WS_Q = WS_BIG + 48 * MiB;
constexpr size_t WS_KE = WS_Q + 24 * MiB, WS_VTE = WS_KE + 6 * MiB, WS_VBT = WS_VTE + 6 * MiB;
constexpr size_t WS_KO = WS_Q + 48 * MiB, WS_VTO = WS_KO + 12 * MiB;
constexpr size_t WS_END = 256 * MiB;
static_assert(WS_VBT + 24 * MiB <= WS_END && WS_VTO + 12 * MiB <= WS_END && WS_ACT + 132 * MiB <= WS_END, "ws map");
constexpr size_t BIAS_INE = 0, BIAS_UP0 = 9 * 1792, BIAS_INO = BIAS_UP0 + 9 * 5632, BIAS_UP1 = BIAS_INO + 9 * 1536;

constexpr int LDS_BYTES = 147456;
constexpr int LDS_SPARE = 131072;

struct Params {
    const float* in[26];
    float* out;
    unsigned char* ws;
    int ph_lo, ph_hi;
};

namespace pg8 {
constexpr int BM = 256, BK = 64, HALF = 128, HTB = HALF * BK * 2, STAGE_BYTES = 8 * HTB, NXCD = 8, WGM = 8;
__host__ __device__ __forceinline__ int lds_byte(int r, int c) { const int st = (r >> 4) * 2 + (c >> 5), rr = r & 15, cc = c & 31, ob = rr * 64 + cc * 2; return st * 1024 + (ob ^ (((ob >> 9) & 1) << 5)); }
__host__ __device__ __forceinline__ void stage_rc(int b, int& R, int& C) { const int st = b / 1024, sb = b % 1024, swz = sb ^ (((sb >> 9) & 1) << 5); R = (st >> 1) * 16 + swz / 64; C = (st & 1) * 32 + (swz % 64) / 2; }
__host__ __device__ __forceinline__ int perm32(int rho) { const int n = rho >> 4, i = rho & 15; return 8 * (i >> 2) + 4 * n + (i & 3); }
struct Unit { int pm, pn; };
struct Gemm { const bf16_t* A; const bf16_t* Bt; int M, N, K; };
struct StaticOrder {
    int nM, nN, nwg, nc, rel, pm0;
    __device__ __forceinline__ void init(int pm0_, int nM_, int N, int G, int c, int c0, int nc_) { pm0 = pm0_; nM = nM_; nN = N / BM; nwg = nM * nN; nc = nc_; rel = (c - c0 + G) % G; }
    __device__ __forceinline__ bool next(int i, Unit& u) const {
        if (rel >= nc) return false;
        const long L = (long)i * nc + rel; if (L >= nwg) return false;
        int wgid = (int)L; { const int q = nwg / NXCD, r = nwg % NXCD, xcd = wgid % NXCD, off = wgid / NXCD; wgid = (xcd < r ? xcd * (q + 1) : r * (q + 1) + (xcd - r) * q) + off; }
        const int nig = WGM * nN, gid = wgid / nig, fm = gid * WGM, gsz = (nM - fm) < WGM ? (nM - fm) : WGM;
        u.pm = pm0 + fm + ((wgid % nig) % gsz); u.pn = (wgid % nig) / gsz; return true;
    }
};
__device__ __forceinline__ unsigned cvt_pk_bf16(float lo, float hi) { unsigned r; asm volatile("v_cvt_pk_bf16_f32 %0, %1, %2" : "=v"(r) : "v"(lo), "v"(hi)); return r; }

template <class Epi, bool ALIGN_EPI>
__device__ __forceinline__ void gemm_phase(LAS unsigned char* lds, const Gemm g, const StaticOrder& S, const Epi& E, const int tid) {
    const int wid = __builtin_amdgcn_readfirstlane(tid >> 6), lane = tid & 63, wr = wid >> 2, wc = wid & 3, fr = lane & 15, fq = lane >> 4;
    const int K = g.K, nt = K / BK;
    unsigned voffA[2], voffB[2];
#pragma unroll
    for (int i = 0; i < 2; ++i) { int R, C; stage_rc(tid * 16 + i * 8192, R, C); const int Rb = (R & ~31) + perm32(R & 31);
        voffA[i] = (unsigned)(R * K + C) * 2u; voffB[i] = (unsigned)(Rb * K + C) * 2u; }
    const size_t kstep = (size_t)(BK * 2);
    const size_t hstep = (size_t)HALF * K * 2;
    const size_t tstep = 2 * hstep;
    const unsigned ldsw = (unsigned)wid * 1024u;
    const int aoff = lds_byte(wr * 64 + fr, fq * 8), boff = lds_byte(wc * 32 + fr, fq * 8);
#define PG8_SA(b, h) (((b) * 2 + (h)) * HTB)
#define PG8_SB(b, h) ((4 + (b) * 2 + (h)) * HTB)
#define PG8_STAGE(bufoff, gbase, voff) do { _Pragma("unroll") for (int _i = 0; _i < 2; ++_i) \
        __builtin_amdgcn_global_load_lds((const unsigned*)((const char*)(gbase) + (voff)[_i]), (LAS unsigned*)(lds + (bufoff) + ldsw + _i * 8192), 16, 0, 0); } while (0)
#define PG8_LDA(dst, b, h) do { _Pragma("unroll") for (int m = 0; m < 4; ++m) _Pragma("unroll") for (int k = 0; k < 2; ++k) dst[m][k] = *(const LAS bf16x8*)(lds + PG8_SA(b, h) + aoff + m * 2048 + k * 1024); } while (0)
#define PG8_LDB(dst, b, h) do { _Pragma("unroll") for (int n = 0; n < 2; ++n) _Pragma("unroll") for (int k = 0; k < 2; ++k) dst[n][k] = *(const LAS bf16x8*)(lds + PG8_SB(b, h) + boff + n * 2048 + k * 1024); } while (0)
#define PG8_MMA(ai, bj, At, Bt) do { __builtin_amdgcn_s_setprio(1); _Pragma("unroll") for (int m = 0; m < 4; ++m) _Pragma("unroll") for (int n = 0; n < 2; ++n) _Pragma("unroll") for (int k = 0; k < 2; ++k) \
        acc[ai][bj][m][n] = __builtin_amdgcn_mfma_f32_16x16x32_bf16(Bt[n][k], At[m][k], acc[ai][bj][m][n], 0, 0, 0); __builtin_amdgcn_s_setprio(0); } while (0)
#define PG8_WAIT_V(n) asm volatile("s_waitcnt vmcnt(" #n ")" ::: "memory")
#define PG8_WAIT_L(n) asm volatile("s_waitcnt lgkmcnt(" #n ")" ::: "memory")
#define PG8_BAR __builtin_amdgcn_s_barrier()
#define PG8_SCHED __builtin_amdgcn_sched_barrier(0)
    Unit cur, nxt; int ui = 0;
    if (!S.next(0, cur)) return;
    f32x4 acc[2][2][4][2];
#pragma unroll
    for (int a = 0; a < 2; ++a)
#pragma unroll
        for (int b = 0; b < 2; ++b)
#pragma unroll
            for (int m = 0; m < 4; ++m)
#pragma unroll
                for (int n = 0; n < 2; ++n) acc[a][b][m][n] = (f32x4){0.f, 0.f, 0.f, 0.f};
    bf16x8 At[4][2], B0[2][2], B1[2][2];
    const char* cA = (const char*)g.A + (size_t)cur.pm * tstep; const char* cB = (const char*)g.Bt + (size_t)cur.pn * tstep;
    PG8_STAGE(PG8_SB(0, 0), cB, voffB); PG8_STAGE(PG8_SB(0, 1), cB + hstep, voffB); PG8_STAGE(PG8_SA(0, 0), cA, voffA); PG8_STAGE(PG8_SA(0, 1), cA + hstep, voffA);
    if (wr == 1) PG8_BAR;
    PG8_WAIT_V(2); PG8_BAR;
    PG8_STAGE(PG8_SB(1, 0), cB + kstep, voffB); PG8_STAGE(PG8_SA(1, 0), cA + kstep, voffA); PG8_STAGE(PG8_SB(1, 1), cB + hstep + kstep, voffB);
    PG8_WAIT_V(6); PG8_BAR;
    for (;;) {
        const bool has_next = S.next(ui + 1, nxt);
        const char* nA = has_next ? (const char*)g.A + (size_t)nxt.pm * tstep : cA; const char* nB = has_next ? (const char*)g.Bt + (size_t)nxt.pn * tstep : cB;
        for (int t = 0; t < nt; t += 2) {
            const bool last = (t == nt - 2);
            const char* a1 = cA + (size_t)(t + 1) * kstep;
            const char* a2 = last ? nA : cA + (size_t)(t + 2) * kstep; const char* b2 = last ? nB : cB + (size_t)(t + 2) * kstep;
            const char* a3 = a2 + kstep; const char* b3 = b2 + kstep;
            PG8_LDB(B0, 0, 0); PG8_LDB(B1, 0, 1); PG8_SCHED; PG8_LDA(At, 0, 0); PG8_STAGE(PG8_SA(1, 1), a1 + hstep, voffA);
            PG8_WAIT_V(8); PG8_WAIT_L(0); PG8_BAR; PG8_MMA(0, 0, At, B0); PG8_MMA(0, 1, At, B1); PG8_BAR; PG8_SCHED;
            PG8_LDA(At, 0, 1); PG8_STAGE(PG8_SB(0, 0), b2, voffB); PG8_STAGE(PG8_SB(0, 1), b2 + hstep, voffB); PG8_STAGE(PG8_SA(0, 0), a2, voffA);
            PG8_WAIT_V(8); PG8_WAIT_L(0); PG8_BAR; PG8_MMA(1, 0, At, B0); PG8_MMA(1, 1, At, B1); PG8_BAR; PG8_SCHED;
            PG8_LDB(B0, 1, 0); PG8_LDB(B1, 1, 1); PG8_SCHED; PG8_LDA(At, 1, 0); PG8_STAGE(PG8_SA(0, 1), a2 + hstep, voffA);
            PG8_WAIT_V(8); PG8_WAIT_L(0); PG8_BAR; PG8_MMA(0, 0, At, B0); PG8_MMA(0, 1, At, B1); PG8_BAR; PG8_SCHED;
            PG8_LDA(At, 1, 1); PG8_STAGE(PG8_SB(1, 0), b3, voffB); PG8_STAGE(PG8_SB(1, 1), b3 + hstep, voffB); PG8_STAGE(PG8_SA(1, 0), a3, voffA);
            PG8_WAIT_V(8); PG8_WAIT_L(0); PG8_BAR; PG8_MMA(1, 0, At, B0); PG8_MMA(1, 1, At, B1); PG8_BAR; PG8_SCHED;
        }
        if constexpr (ALIGN_EPI) { if (wr == 0) PG8_BAR; }
        E(acc, cur, wr, wc, fr, fq);
        if (!has_next) break;
#pragma unroll
        for (int a = 0; a < 2; ++a)
#pragma unroll
            for (int b = 0; b < 2; ++b)
#pragma unroll
                for (int m = 0; m < 4; ++m)
#pragma unroll
                    for (int n = 0; n < 2; ++n) acc[a][b][m][n] = (f32x4){0.f, 0.f, 0.f, 0.f};
        cur = nxt; cA = nA; cB = nB; ++ui;
        if constexpr (ALIGN_EPI) { if (wr == 1) PG8_BAR; }
    }
    PG8_WAIT_V(0);
    if constexpr (!ALIGN_EPI) { if (wr == 0) PG8_BAR; }
    PG8_BAR;
#undef PG8_SA
#undef PG8_SB
#undef PG8_STAGE
#undef PG8_LDA
#undef PG8_LDB
#undef PG8_MMA
#undef PG8_WAIT_V
#undef PG8_WAIT_L
#undef PG8_BAR
#undef PG8_SCHED
}
}

using pg8::cvt_pk_bf16;
typedef f32x4 (&AccRef)[2][2][4][2];

__device__ __forceinline__ int cond_of_tile(int pm) { return pm < 32 ? 0 : 1 + ((pm - 32) >> 3); }
__device__ __forceinline__ float red_fq(float v) { v += __shfl_xor(v, 16); v += __shfl_xor(v, 32); return v; }
__device__ __forceinline__ float gelu_tanh(float x) { const float u = x + 0.044715f * x * x * x; return x * __builtin_amdgcn_rcpf(1.0f + __builtin_amdgcn_exp2f(-2.302208198f * u)); }
__device__ __forceinline__ float silu_f(float x) { return x * __builtin_amdgcn_rcpf(1.0f + __builtin_amdgcn_exp2f(-LOG2E * x)); }
__device__ __forceinline__ u32x4 pack8(const f32x4 a, const f32x4 b) { u32x4 w; w.x = cvt_pk_bf16(a[0], a[1]); w.y = cvt_pk_bf16(a[2], a[3]); w.z = cvt_pk_bf16(b[0], b[1]); w.w = cvt_pk_bf16(b[2], b[3]); return w; }
__device__ __forceinline__ float bf2f(unsigned short h) { return __uint_as_float((unsigned)h << 16); }

template <class T> __device__ __forceinline__ T ldg(const void* base, unsigned off) { return *(const T*)((const char*)base + off); }
template <class T> __device__ __forceinline__ void stg(void* base, unsigned off, T v) { *(T*)((char*)base + off) = v; }
__device__ __forceinline__ float ss4(const f32x4 v) { return (v[0] * v[0] + v[1] * v[1]) + (v[2] * v[2] + v[3] * v[3]); }

struct EpiRes {
    const float* xp; const float* xs; float* out; const float* gate; const float* nscale; bf16_t* An; float* ssn;
    __device__ __forceinline__ void operator()(AccRef acc, const pg8::Unit& u, int wr, int wc, int fr, int fq) const {
        const int cond = cond_of_tile(u.pm);
        const unsigned colbase = u.pn * 256 + wc * 32 + 8 * fq;
        const bool ctx = u.pm < 32;
        const float* xb = ctx ? xp : xs;
        const unsigned rsub = ctx ? 0u : (unsigned)NCTX;
        const unsigned moff = (cond * MODW + colbase) * 4u;
#pragma unroll
        for (int ai = 0; ai < 2; ++ai)
#pragma unroll
            for (int m = 0; m < 4; ++m) {
                const unsigned row = u.pm * 256 + ai * 128 + wr * 64 + m * 16 + fr;
                const unsigned xoff = ((row - rsub) * DM + colbase) * 4u, ooff = (row * DM + colbase) * 4u;
                float ssum = 0.f;
#pragma unroll
                for (int bj = 0; bj < 2; ++bj) {
                    f32x4 xn[2];
#pragma unroll
                    for (int n = 0; n < 2; ++n) {
                        const f32x4 xo = ldg<f32x4>(xb, xoff + bj * 512 + n * 16);
                        const f32x4 gt = ldg<f32x4>(gate, moff + bj * 512 + n * 16);
                        xn[n] = xo + gt * acc[ai][bj][m][n];
                        stg<f32x4>(out, ooff + bj * 512 + n * 16, xn[n]);
                        ssum += ss4(xn[n]);
                    }
                    if (An) {
                        const f32x4 s0 = ldg<f32x4>(nscale, moff + bj * 512) + 1.0f, s1 = ldg<f32x4>(nscale, moff + bj * 512 + 16) + 1.0f;
                        stg<u32x4>(An, (row * DM + colbase) * 2u + bj * 256, pack8(xn[0] * s0, xn[1] * s1));
                    }
                }
                if (ssn) { ssum = red_fq(ssum); if (fq == 0) atomicAdd((float*)((char*)ssn + row * 4u), ssum); }
                asm volatile("" ::: "memory");
            }
    }
};

template <bool EVEN>
struct EpiIn {
    unsigned char* wsb; float* outb;
    const float* qg; const float* kg;
    __device__ __forceinline__ void operator()(AccRef acc, const pg8::Unit& u, int wr, int wc, int fr, int fq) const {
        constexpr unsigned N = EVEN ? EVEN_IN : ODD_IN, QW = EVEN ? 512 : 1024, KVH = EVEN ? 2 : 4, KW = KVH * 64;
        const float* ss = (const float*)(wsb + (EVEN ? WS_SS0 : WS_SS2));
        const float* bias = (const float*)(wsb + WS_BIAS) + (EVEN ? BIAS_INE : BIAS_INO);
        const float* rope = (const float*)(wsb + WS_ROPE);
        bf16_t* Q = (bf16_t*)(wsb + WS_Q); bf16_t* K = (bf16_t*)(wsb + (EVEN ? WS_KE : WS_KO)); bf16_t* Vt = (bf16_t*)(wsb + (EVEN ? WS_VTE : WS_VTO));
        bf16_t* MIX = (bf16_t*)(wsb + WS_MIX); bf16_t* VbT = (bf16_t*)(wsb + WS_VBT); float* ssv = (float*)(wsb + WS_SSV);
        float* outk = outb + (size_t)MTOK * DM + (EVEN ? 0 : NCTX * 256); float* outv = outk + NCTX * KW;
        const int cond = cond_of_tile(u.pm);
        int role; unsigned hidx;
        if (EVEN) { if (u.pn < 2) { role = 0; hidx = 4 * u.pn + wc; } else if (u.pn == 2) { role = wc < 2 ? 1 : 2; hidx = wc & 1; } else if (u.pn < 5) { role = 3; hidx = (u.pn - 3) * 4 + wc; } else { role = 4; hidx = (u.pn - 5) * 4 + wc; } }
        else { if (u.pn < 4) { role = 0; hidx = 4 * u.pn + wc; } else if (u.pn == 4) { role = 1; hidx = wc; } else { role = 2; hidx = wc; } }
        const unsigned boff = (cond * N + u.pn * 256 + wc * 32 + 8 * fq) * 4u;
        const bool lat = u.pm >= 32;
        const unsigned c8 = hidx * 64 + 8 * fq;
        const float* gp = role == 0 ? qg : kg;
#pragma unroll
        for (int ai = 0; ai < 2; ++ai)
#pragma unroll
            for (int m = 0; m < 4; ++m) {
                const unsigned row = u.pm * 256 + ai * 128 + wr * 64 + m * 16 + fr;
                const float rr = 1.0f / sqrtf(ldg<float>(ss, row * 4u) * (1.0f / DM) + EPS);
                f32x4 z[2][2];
#pragma unroll
                for (int bj = 0; bj < 2; ++bj)
#pragma unroll
                    for (int n = 0; n < 2; ++n) z[bj][n] = acc[ai][bj][m][n] * rr + ldg<f32x4>(bias, boff + bj * 512 + n * 16);
                if (role <= 1) {
                    float s2 = (ss4(z[0][0]) + ss4(z[0][1])) + (ss4(z[1][0]) + ss4(z[1][1]));
                    s2 = red_fq(s2);
                    const float rn = 1.0f / sqrtf(s2 * (1.0f / 64.0f) + EPS);
#pragma unroll
                    for (int bj = 0; bj < 2; ++bj)
#pragma unroll
                        for (int n = 0; n < 2; ++n) z[bj][n] = z[bj][n] * rn * ldg<f32x4>(gp, (8 * fq) * 4u + bj * 128 + n * 16);
                    if (role == 1 && !lat) {
#pragma unroll
                        for (int bj = 0; bj < 2; ++bj)
#pragma unroll
                            for (int n = 0; n < 2; ++n) stg<f32x4>(outk, (row * KW + c8) * 4u + bj * 128 + n * 16, z[bj][n]);
                    }
                    if (lat) {
                        const unsigned t = (row - NCTX) & 2047u;
#pragma unroll
                        for (int bj = 0; bj < 2; ++bj) {
                            const unsigned pos = bj == 0 ? (t >> 6) : (t & 63u);
#pragma unroll
                            for (int n = 0; n < 2; ++n) {
                                const f32x4 cs = ldg<f32x4>(rope, (pos * 16 + 4 * fq) * 8u + n * 16);
                                const f32x4 v = z[bj][n];
                                z[bj][n] = (f32x4){v[0] * cs[0] - v[1] * cs[1], v[0] * cs[1] + v[1] * cs[0], v[2] * cs[2] - v[3] * cs[3], v[2] * cs[3] + v[3] * cs[2]};
                            }
                        }
                    }
                    if (role == 0) {
#pragma unroll
                        for (int bj = 0; bj < 2; ++bj) stg<u32x4>(Q, (row * QW + c8) * 2u + bj * 64, pack8(z[bj][0] * (0.125f * LOG2E), z[bj][1] * (0.125f * LOG2E)));
                    } else {
#pragma unroll
                        for (int bj = 0; bj < 2; ++bj) stg<u32x4>(K, (row * KW + c8) * 2u + bj * 64, pack8(z[bj][0], z[bj][1]));
                    }
                } else if (role == 2) {
                    if (!lat) {
#pragma unroll
                        for (int bj = 0; bj < 2; ++bj)
#pragma unroll
                            for (int n = 0; n < 2; ++n) stg<f32x4>(outv, (row * KW + c8) * 4u + bj * 128 + n * 16, z[bj][n]);
                    }
                    unsigned vb, T;
                    if (!lat) { T = 256; vb = ((row >> 8) * KVH + hidx) * 64 * 256 + (row & 255u); }
                    else { T = 2048; vb = NCTX * KW + (((row - NCTX) >> 11) * KVH + hidx) * 64 * 2048 + ((row - NCTX) & 2047u); }
                    vb += 8 * fq * T;
#pragma unroll
                    for (int bj = 0; bj < 2; ++bj)
#pragma unroll
                        for (int n = 0; n < 2; ++n)
#pragma unroll
                            for (int i = 0; i < 4; ++i) stg<bf16_t>(Vt, (vb + (32 * bj + 4 * n + i) * T) * 2u, (bf16_t)(cvt_pk_bf16(z[bj][n][i], 0.f) & 0xffffu));
                } else if (EVEN && role == 3) {
#pragma unroll
                    for (int bj = 0; bj < 2; ++bj) {
                        f32x4 a = z[bj][0], b = z[bj][1];
#pragma unroll
                        for (int i = 0; i < 4; ++i) { a[i] = gelu_tanh(a[i]); b[i] = gelu_tanh(b[i]); }
                        stg<u32x4>(MIX, (row * DM + 512 + c8) * 2u + bj * 64, pack8(a, b));
                    }
                } else if (EVEN) {
                    float s2 = 0.f;
                    const unsigned cb = (row >> 7) * 512 * 128 + (row & 127u) + c8 * 128;
#pragma unroll
                    for (int bj = 0; bj < 2; ++bj)
#pragma unroll
                        for (int n = 0; n < 2; ++n)
#pragma unroll
                            for (int i = 0; i < 4; ++i) {
                                const float gv = gelu_tanh(z[bj][n][i]); s2 += gv * gv;
                                stg<bf16_t>(VbT, (cb + (32 * bj + 4 * n + i) * 128) * 2u, (bf16_t)(cvt_pk_bf16(gv, 0.f) & 0xffffu));
                            }
                    s2 = red_fq(s2);
                    if (fq == 0) atomicAdd((float*)((char*)ssv + row * 4u), s2);
                }
                asm volatile("" ::: "memory");
            }
    }
};

template <int CTRL> __device__ __forceinline__ float dpp_rot(float v) { return __builtin_bit_cast(float, __builtin_amdgcn_update_dpp(0, __builtin_bit_cast(int, v), CTRL, 0xf, 0xf, false)); }
struct EpiUp {
    unsigned char* wsb; unsigned ss_off, bias_off; const float* cw; const float* cbias;
    LAS float* xch;
    __device__ __forceinline__ void operator()(AccRef acc, const pg8::Unit& u, int wr, int wc, int fr, int fq) const {
        const float* ss = (const float*)(wsb + ss_off); const float* bias = (const float*)(wsb + WS_BIAS) + bias_off;
        float* ZB = (float*)(wsb + WS_ZB); bf16_t* ACT = (bf16_t*)(wsb + WS_ACT);
        const int cond = cond_of_tile(u.pm);
        const unsigned nb = u.pn * 256 + wc * 32 + 8 * fq;
        const unsigned boff = (cond * FF2 + nb) * 4u;
#pragma unroll
        for (int ai = 0; ai < 2; ++ai)
#pragma unroll
            for (int m = 0; m < 4; ++m) {
                const unsigned row = u.pm * 256 + ai * 128 + wr * 64 + m * 16 + fr;
                const float rr = 1.0f / sqrtf(ldg<float>(ss, row * 4u) * (1.0f / DM) + EPS);
#pragma unroll
                for (int bj = 0; bj < 2; ++bj)
#pragma unroll
                    for (int n = 0; n < 2; ++n) acc[ai][bj][m][n] = acc[ai][bj][m][n] * rr + ldg<f32x4>(bias, boff + bj * 512 + n * 16);
            }
        if (wr == 0 && fr < 2) {
            const unsigned zo = ((u.pm * 4 + fr) * FF2 + nb) * 4u;
#pragma unroll
            for (int bj = 0; bj < 2; ++bj)
#pragma unroll
                for (int n = 0; n < 2; ++n) stg<f32x4>(ZB, zo + bj * 512 + n * 16, acc[0][bj][0][n]);
        }
        if (wr == 1 && fr >= 14) {
            const unsigned zo = ((u.pm * 4 + 2 + (fr - 14)) * FF2 + nb) * 4u;
#pragma unroll
            for (int bj = 0; bj < 2; ++bj)
#pragma unroll
                for (int n = 0; n < 2; ++n) stg<f32x4>(ZB, zo + bj * 512 + n * 16, acc[1][bj][3][n]);
        }
        LAS float* my = xch + (wr * 4 + wc) * 256 + 8 * fq;
        if (fr == 0) {
#pragma unroll
            for (int ai = 0; ai < 2; ++ai)
#pragma unroll
                for (int bj = 0; bj < 2; ++bj)
#pragma unroll
                    for (int n = 0; n < 2; ++n) *(LAS f32x4*)(my + ai * 128 + bj * 32 + 4 * n) = acc[ai][bj][0][n];
        }
        if (fr == 15) {
#pragma unroll
            for (int ai = 0; ai < 2; ++ai)
#pragma unroll
                for (int bj = 0; bj < 2; ++bj)
#pragma unroll
                    for (int n = 0; n < 2; ++n) *(LAS f32x4*)(my + ai * 128 + 64 + bj * 32 + 4 * n) = acc[ai][bj][3][n];
        }
        asm volatile("s_waitcnt lgkmcnt(0)" ::: "memory"); __builtin_amdgcn_s_barrier(); asm volatile("" ::: "memory");
        const unsigned chb = u.pn * 128 + wc * 32 + 8 * fq;
        const float* cw1 = cw + FF2; const float* cw2 = cw + 2 * FF2;
#pragma unroll
        for (int ai = 0; ai < 2; ++ai) {
            const bool hasp = !(ai == 0 && wr == 0), hasn = !(ai == 1 && wr == 1);
            const LAS float* pp = xch + ((wr == 1 ? 0 : 4) + wc) * 256 + (wr == 1 ? ai : 0) * 128 + 64 + 8 * fq;
            const LAS float* pn = xch + ((wr == 0 ? 4 : 0) + wc) * 256 + (wr == 0 ? ai : 1) * 128 + 8 * fq;
            const unsigned arow = ((u.pm * 256 + ai * 128 + wr * 64 + fr) * FF + chb) * 2u;
#pragma unroll
            for (int n = 0; n < 2; ++n) {
                f32x4 sg[4];
#pragma unroll
                for (int pass = 0; pass < 2; ++pass) {
                    const int bj = 1 - pass;
                    const unsigned ci = (bj * FF + chb + 4 * n) * 4u;
                    const f32x4 w0 = ldg<f32x4>(cw, ci), w1 = ldg<f32x4>(cw1, ci), w2 = ldg<f32x4>(cw2, ci), cb = ldg<f32x4>(cbias, ci);
                    f32x4 hp = (f32x4){0.f, 0.f, 0.f, 0.f}, hn = (f32x4){0.f, 0.f, 0.f, 0.f};
                    if (hasp) hp = *(const LAS f32x4*)(pp + bj * 32 + 4 * n);
                    if (hasn) hn = *(const LAS f32x4*)(pn + bj * 32 + 4 * n);
                    f32x4 prevsrc = hp;
#pragma unroll
                    for (int m = 0; m < 4; ++m) {
                        const f32x4 zc = acc[ai][bj][m][n];
                        const f32x4 nsrc = m < 3 ? acc[ai][bj][m < 3 ? m + 1 : 3][n] : hn;
                        f32x4 pv, nv;
#pragma unroll
                        for (int i = 0; i < 4; ++i) {
                            pv[i] = dpp_rot<0x121>(fr == 15 ? prevsrc[i] : zc[i]);
                            nv[i] = dpp_rot<0x12F>(fr == 0 ? nsrc[i] : zc[i]);
                        }
                        f32x4 res = cb + w0 * pv + w1 * zc + w2 * nv;
                        prevsrc = zc;
                        if (pass == 0) {
#pragma unroll
                            for (int i = 0; i < 4; ++i) res[i] = silu_f(res[i]);
                            sg[m] = res;
                        } else {
                            res = res * sg[m];
                            stg<u32x2>(ACT, arow + m * (16 * FF * 2) + n * 8, (u32x2){cvt_pk_bf16(res[0], res[1]), cvt_pk_bf16(res[2], res[3])});
                        }
                    }
                    asm volatile("" ::: "memory");
                }
                asm volatile("" ::: "memory");
            }
        }
    }
};

__device__ __forceinline__ int crow(int r, int hi) { return (r & 3) + 8 * (r >> 2) + 4 * hi; }
__device__ __forceinline__ void attn_unit(LAS unsigned char* lds, const bf16_t* Q, int qstride, bf16_t* O, int ostride,
                                          const bf16_t* K0, int ks0, const bf16_t* V0, int vs0, int t0lo, int nt0,
                                          const bf16_t* K1, int ks1, const bf16_t* V1, int vs1, int nt1,
                                          float m_init, float l_init, int win_q0, const int tid) {
    const int lane = tid & 63, r32 = lane & 31, hi = lane >> 5, wid = __builtin_amdgcn_readfirstlane(tid >> 6);
    const int qrow = wid * 32 + r32;
    bf16x8 qf[4];
#pragma unroll
    for (int d0 = 0; d0 < 4; ++d0) qf[d0] = *(const bf16x8*)(Q + (size_t)qrow * qstride + d0 * 16 + hi * 8);
    float mrun = m_init;
    f32x16 o0 = {}, o1 = {}, lacc, negm;
#pragma unroll
    for (int r = 0; r < 16; ++r) { lacc[r] = l_init; negm[r] = -m_init; }
    const bf16x8 ones = {0x3F80, 0x3F80, 0x3F80, 0x3F80, 0x3F80, 0x3F80, 0x3F80, 0x3F80};
    const int NT = nt0 + nt1;
    const int lrow = 8 * wid + (lane >> 3), lch = (lane & 7) ^ ((lrow >> 1) & 7);
    auto dma = [&](int t) {
        const bf16_t* kp; const bf16_t* vp;
        if (t < nt0) { kp = K0 + (size_t)((t0lo + t) * 64 + lrow) * ks0 + lch * 8; vp = V0 + (size_t)lrow * vs0 + (t0lo + t) * 64 + lch * 8; }
        else { kp = K1 + (size_t)((t - nt0) * 64 + lrow) * ks1 + lch * 8; vp = V1 + (size_t)lrow * vs1 + (t - nt0) * 64 + lch * 8; }
        LAS unsigned char* dst = lds + (t % 6) * 16384 + wid * 1024;
        __builtin_amdgcn_global_load_lds((const unsigned*)kp, (LAS unsigned*)dst, 16, 0, 0);
        __builtin_amdgcn_global_load_lds((const unsigned*)vp, (LAS unsigned*)(dst + 8192), 16, 0, 0);
    };
    const int krow = (r32 & 0x13) | ((r32 & 4) << 1) | ((r32 & 8) >> 1);
    const int koff = krow * 128 + ((hi ^ ((krow >> 1) & 7)) << 4);
    const int voff = 8192 + r32 * 128 + ((hi ^ ((r32 >> 1) & 7)) << 4);
    dma(0); if (NT > 1) dma(1); if (NT > 2) dma(2); if (NT > 3) dma(3); if (NT > 4) dma(4);
    for (int t = 0; t < NT; ++t) {
        if (t + 4 < NT) asm volatile("s_waitcnt vmcnt(8)" ::: "memory");
        else if (t + 3 < NT) asm volatile("s_waitcnt vmcnt(6)" ::: "memory");
        else if (t + 2 < NT) asm volatile("s_waitcnt vmcnt(4)" ::: "memory");
        else if (t + 1 < NT) asm volatile("s_waitcnt vmcnt(2)" ::: "memory");
        else asm volatile("s_waitcnt vmcnt(0)" ::: "memory");
        __builtin_amdgcn_s_barrier(); asm volatile("" ::: "memory");
        if (t + 5 < NT) dma(t + 5);
        bool active = true;
        int key0 = 0;
        if (win_q0 >= 0 && t < nt0) {
            key0 = (t0lo + t) * 64;
            const int qw0 = win_q0 + wid * 32;
            active = !(key0 + 63 < qw0 - 128 || key0 > qw0 + 31 + 128);
        }
        if (active) {
            const LAS unsigned char* sb = lds + (t % 6) * 16384;
            f32x16 p0 = negm, p1 = negm;
#pragma unroll
            for (int d0 = 0; d0 < 4; ++d0) {
                const bf16x8 k0 = *(const LAS bf16x8*)(sb + (koff ^ (d0 << 5)));
                const bf16x8 k1 = *(const LAS bf16x8*)(sb + (koff ^ (d0 << 5)) + 32 * 128);
                p0 = __builtin_amdgcn_mfma_f32_32x32x16_bf16(k0, qf[d0], p0, 0, 0, 0);
                p1 = __builtin_amdgcn_mfma_f32_32x32x16_bf16(k1, qf[d0], p1, 0, 0, 0);
            }
            if (win_q0 >= 0 && t < nt0) {
                const int qw0 = win_q0 + wid * 32;
                const int bb = key0 + 8 * hi - (win_q0 + qrow);
                if (key0 < qw0 + 31 - 128) {
#pragma unroll
                    for (int r = 0; r < 16; ++r) { const int c = 16 * (r >> 3) + (r & 7); if (bb < -128 - c) p0[r] = -INFINITY; if (bb < -160 - c) p1[r] = -INFINITY; }
                }
                if (key0 + 63 > qw0 + 128) {
#pragma unroll
                    for (int r = 0; r < 16; ++r) { const int c = 16 * (r >> 3) + (r & 7); if (bb > 128 - c) p0[r] = -INFINITY; if (bb > 96 - c) p1[r] = -INFINITY; }
                }
            }
            float mx = __builtin_fmaxf(__builtin_fmaxf(p0[0], p1[0]), __builtin_fmaxf(p0[1], p1[1]));
#pragma unroll
            for (int r = 2; r < 16; r += 2) mx = __builtin_fmaxf(__builtin_fmaxf(mx, p0[r]), __builtin_fmaxf(p1[r], __builtin_fmaxf(p0[r + 1], p1[r + 1])));
            mx = __builtin_fmaxf(mx, __shfl_xor(mx, 32));
            if (__any(mx > 8.0f)) {
                const float dl = mx > 8.0f ? mx : 0.f;
                const float f = __builtin_amdgcn_exp2f(-dl);
                mrun += dl;
                p0 = p0 - dl; p1 = p1 - dl; negm = negm - dl;
#pragma unroll
                for (int r = 0; r < 16; ++r) { o0[r] *= f; o1[r] *= f; lacc[r] *= f; }
            }
#pragma unroll
            for (int r = 0; r < 16; ++r) { p0[r] = __builtin_amdgcn_exp2f(p0[r]); p1[r] = __builtin_amdgcn_exp2f(p1[r]); }
            bf16x8 pw[4];
#pragma unroll
            for (int ks = 0; ks < 4; ++ks) {
                u32x4 w;
                if (ks < 2) { w.x = cvt_pk_bf16(p0[8 * ks + 0], p0[8 * ks + 1]); w.y = cvt_pk_bf16(p0[8 * ks + 2], p0[8 * ks + 3]); w.z = cvt_pk_bf16(p0[8 * ks + 4], p0[8 * ks + 5]); w.w = cvt_pk_bf16(p0[8 * ks + 6], p0[8 * ks + 7]); }
                else { const int k2 = ks - 2; w.x = cvt_pk_bf16(p1[8 * k2 + 0], p1[8 * k2 + 1]); w.y = cvt_pk_bf16(p1[8 * k2 + 2], p1[8 * k2 + 3]); w.z = cvt_pk_bf16(p1[8 * k2 + 4], p1[8 * k2 + 5]); w.w = cvt_pk_bf16(p1[8 * k2 + 6], p1[8 * k2 + 7]); }
                pw[ks] = __builtin_bit_cast(bf16x8, w);
            }
#pragma unroll
            for (int ks = 0; ks < 4; ++ks) {
                const bf16x8 va = *(const LAS bf16x8*)(sb + (voff ^ (ks << 5)));
                const bf16x8 vbb = *(const LAS bf16x8*)(sb + (voff ^ (ks << 5)) + 32 * 128);
                o0 = __builtin_amdgcn_mfma_f32_32x32x16_bf16(va, pw[ks], o0, 0, 0, 0);
                o1 = __builtin_amdgcn_mfma_f32_32x32x16_bf16(vbb, pw[ks], o1, 0, 0, 0);
                lacc = __builtin_amdgcn_mfma_f32_32x32x16_bf16(ones, pw[ks], lacc, 0, 0, 0);
            }
        }
    }
    const float inv = 1.0f / lacc[0];
    bf16_t* orow = O + (size_t)qrow * ostride;
#pragma unroll
    for (int r4 = 0; r4 < 4; ++r4) {
        u32x2 w0, w1;
        w0.x = cvt_pk_bf16(o0[4 * r4 + 0] * inv, o0[4 * r4 + 1] * inv); w0.y = cvt_pk_bf16(o0[4 * r4 + 2] * inv, o0[4 * r4 + 3] * inv);
        w1.x = cvt_pk_bf16(o1[4 * r4 + 0] * inv, o1[4 * r4 + 1] * inv); w1.y = cvt_pk_bf16(o1[4 * r4 + 2] * inv, o1[4 * r4 + 3] * inv);
        *(u32x2*)(orow + 8 * r4 + 4 * hi) = w0;
        *(u32x2*)(orow + 32 + 8 * r4 + 4 * hi) = w1;
    }
    asm volatile("s_waitcnt vmcnt(0) lgkmcnt(0)" ::: "memory"); __builtin_amdgcn_s_barrier(); asm volatile("" ::: "memory");
}

__device__ __forceinline__ void spatial_unit(int chunk, int g, const float* w_s, const float* b_s, const float* v_gain, const float* ssv, const bf16_t* VbT, bf16_t* MIX, const int tid) {
    const int lane = tid & 63, r32 = lane & 31, hi = lane >> 5, wid = __builtin_amdgcn_readfirstlane(tid >> 6);
    const int pblk = wid & 3, chalf = wid >> 2;
    const int p = 32 * pblk + r32;
    bf16x8 yf[8];
#pragma unroll
    for (int ks = 0; ks < 8; ++ks) {
        const int q = 16 * ks + 8 * hi;
        const f32x4 w0 = *(const f32x4*)(w_s + ((size_t)g * 128 + p) * 128 + q), w1 = *(const f32x4*)(w_s + ((size_t)g * 128 + p) * 128 + q + 4);
        const f32x4 s0 = *(const f32x4*)(ssv + chunk * 128 + q), s1 = *(const f32x4*)(ssv + chunk * 128 + q + 4);
        f32x4 a, b;
#pragma unroll
        for (int i = 0; i < 4; ++i) { a[i] = w0[i] / sqrtf(s0[i] * (1.0f / 512.0f) + EPS); b[i] = w1[i] / sqrtf(s1[i] * (1.0f / 512.0f) + EPS); }
        yf[ks] = __builtin_bit_cast(bf16x8, pack8(a, b));
    }
    const float bs = b_s[g * 128 + p];
    const int row = chunk * 128 + p;
#pragma unroll
    for (int cbk = 0; cbk < 2; ++cbk) {
        const int cblk = 2 * chalf + cbk;
        const bf16_t* xr = VbT + ((size_t)chunk * 512 + 128 * g + 32 * cblk + r32) * 128 + 8 * hi;
        f32x16 acc = {};
#pragma unroll
        for (int ks = 0; ks < 8; ++ks) { const bf16x8 xf = *(const bf16x8*)(xr + 16 * ks); acc = __builtin_amdgcn_mfma_f32_32x32x16_bf16(xf, yf[ks], acc, 0, 0, 0); }
#pragma unroll
        for (int r4 = 0; r4 < 4; ++r4) {
            const int ch = 128 * g + 32 * cblk + 8 * r4 + 4 * hi;
            const f32x4 gn = *(const f32x4*)(v_gain + ch);
            bf16_t* up = MIX + (size_t)row * DM + 512 + ch;
            const u32x2 uu = *(const u32x2*)up;
            const float u0 = __uint_as_float(uu.x << 16), u1 = __uint_as_float(uu.x & 0xffff0000u), u2 = __uint_as_float(uu.y << 16), u3 = __uint_as_float(uu.y & 0xffff0000u);
            u32x2 w;
            w.x = cvt_pk_bf16(u0 * (gn[0] * acc[4 * r4 + 0] + bs), u1 * (gn[1] * acc[4 * r4 + 1] + bs));
            w.y = cvt_pk_bf16(u2 * (gn[2] * acc[4 * r4 + 2] + bs), u3 * (gn[3] * acc[4 * r4 + 3] + bs));
            *(u32x2*)up = w;
        }
    }
}

__device__ __forceinline__ unsigned f2bf(float f) { unsigned u = __builtin_bit_cast(unsigned, f); return (u + 0x7fffu + ((u >> 16) & 1u)) >> 16; }
__device__ __forceinline__ unsigned pk2(float lo, float hi) { return f2bf(lo) | (f2bf(hi) << 16); }
__device__ __forceinline__ float wave_sum(float v) {
#pragma unroll
    for (int o = 1; o < 64; o <<= 1) v += __shfl_xor(v, o);
    return v;
}
__device__ __forceinline__ void transpose_item(const float* W, int K, int N, bf16_t* WT, int k0, int n0, int drow, LAS float* scr, int lane) {
#pragma unroll 8
    for (int i = 0; i < 32; ++i) { const int kk = 2 * i + (lane >> 5); scr[kk * 33 + (lane & 31)] = W[(size_t)(k0 + kk) * N + n0 + (lane & 31)]; }
    asm volatile("s_waitcnt lgkmcnt(0)" ::: "memory");
    const int c = lane & 7;
#pragma unroll
    for (int j = 0; j < 4; ++j) { const int n = (lane >> 3) + 8 * j; const LAS float* s = scr + (8 * c) * 33 + n;
        u32x4 o; o.x = pk2(s[0 * 33], s[1 * 33]); o.y = pk2(s[2 * 33], s[3 * 33]); o.z = pk2(s[4 * 33], s[5 * 33]); o.w = pk2(s[6 * 33], s[7 * 33]);
        *(u32x4*)(WT + (size_t)(drow + n) * K + k0 + 8 * c) = o; }
    asm volatile("s_waitcnt lgkmcnt(0)" ::: "memory");
}
__device__ __forceinline__ int perm_in(int n0) { const int pn = n0 >> 8, rem = n0 & 255; return pn * 256 + ((rem & 63) >> 5) * 128 + (rem >> 6) * 32; }
__device__ __forceinline__ int perm_up(int n0) { const int half = n0 / FF, ch = n0 % FF; return (ch >> 7) * 256 + half * 128 + (ch & 127); }


#define XB_TMO      128
#define XB_XCNT(j)  (256  + 64 * (j))
#define XB_XSUB(j)  (1280 + 64 * (j))
#define XB_XGEN(j)  (2304 + 64 * (j))
#define XB_TOP      3328
#define XB_TOPGEN   3392
#define XCD_BAR_WORDS 3456
#define XB_SPIN_CAP (1u << 18)
__device__ __forceinline__ unsigned xb_ld(unsigned* p)              { return __hip_atomic_load(p, __ATOMIC_RELAXED, __HIP_MEMORY_SCOPE_AGENT); }
__device__ __forceinline__ unsigned xb_add(unsigned* p, unsigned v) { return __hip_atomic_fetch_add(p, v, __ATOMIC_RELAXED, __HIP_MEMORY_SCOPE_AGENT); }
__device__ __forceinline__ unsigned xb_xcc_id() { return (unsigned)__builtin_amdgcn_s_getreg((3 << 11) | 20) & 0xFu; }
#define XB_SPIN(cond, bar) do { unsigned _sp = 0; while (cond) { __builtin_amdgcn_s_sleep(1); \
    if ((++_sp & 255u) == 0u) { if (xb_ld(&(bar)[XB_TMO])) break; if (_sp > XB_SPIN_CAP) { atomicAdd(&(bar)[XB_TMO], 1u); break; } } } } while (0)
struct XcdBarrier { unsigned* bar; unsigned x; volatile LAS unsigned* st; };
__device__ __forceinline__ XcdBarrier xcd_barrier_post(unsigned* bar, volatile LAS unsigned* st) {
    XcdBarrier b; b.bar = bar; b.x = xb_xcc_id(); b.st = st;
    if (threadIdx.x == 0) (void)xb_add(&bar[XB_XCNT(b.x)], 1u);
    return b;
}
__device__ __forceinline__ void xcd_barrier_complete(unsigned* bar, unsigned x, unsigned& nloc, unsigned& nx) {
    const unsigned G = gridDim.x * gridDim.y * gridDim.z;
    unsigned sum, cnt, mine, sp = 0u;
    for (;;) {
        sum = 0u; cnt = 0u; mine = 0u;
#pragma unroll
        for (unsigned j = 0; j < 16; ++j) { const unsigned c = xb_ld(&bar[XB_XCNT(j)]); sum += c; cnt += (c > 0u) ? 1u : 0u; mine = (j == x) ? c : mine; }
        if (sum == G) break;
        __builtin_amdgcn_s_sleep(1);
        if ((++sp & 255u) == 0u) { if (xb_ld(&bar[XB_TMO])) break; if (sp > XB_SPIN_CAP) { atomicAdd(&bar[XB_TMO], 1u); break; } }
    }
    nloc = mine > 0u ? mine : 1u; nx = cnt > 0u ? cnt : 1u;
}
__device__ __forceinline__ void xcd_barrier(const XcdBarrier& b) {
    asm volatile("s_waitcnt vmcnt(0)" ::: "memory");
    __syncthreads();
    if (threadIdx.x == 0) {
        unsigned* bar = b.bar;
        __builtin_amdgcn_s_waitcnt(0);
        unsigned nloc = b.st[0], nx = b.st[1];
        if (nloc == 0u) { xcd_barrier_complete(bar, b.x, nloc, nx); b.st[0] = nloc; b.st[1] = nx; }
        const unsigned old = xb_add(&bar[XB_XSUB(b.x)], 1u);
        const unsigned gen = old / nloc;
        if (old + 1u == (gen + 1u) * nloc) {
            __builtin_amdgcn_fence(__ATOMIC_RELEASE, "agent");
            asm volatile("s_waitcnt vmcnt(0)" ::: "memory");
            const unsigned og = xb_add(&bar[XB_TOP], 1u);
            const unsigned tg = og / nx;
            if (og + 1u == (tg + 1u) * nx) xb_add(&bar[XB_TOPGEN], 1u);
            else XB_SPIN(xb_ld(&bar[XB_TOPGEN]) == tg, bar);
            __builtin_amdgcn_fence(__ATOMIC_ACQUIRE, "agent");
            xb_add(&bar[XB_XGEN(b.x)], 1u);
            asm volatile("s_waitcnt vmcnt(0)" ::: "memory");
        } else {
            XB_SPIN(xb_ld(&bar[XB_XGEN(b.x)]) == gen, bar);
            __builtin_amdgcn_fence(__ATOMIC_ACQUIRE, "agent");
            asm volatile("s_waitcnt vmcnt(0)" ::: "memory");
        }
    }
    __syncthreads();
}

template <bool COOP>
__global__ void __launch_bounds__(512, 2) mk_fwd(Params P) {
    extern __shared__ __attribute__((aligned(16))) unsigned char lds_raw[];
    LAS unsigned char* lds = (LAS unsigned char*)lds_raw;
    const int tid = threadIdx.x, lane = tid & 63, wave = __builtin_amdgcn_readfirstlane(tid >> 6);
    const int G = gridDim.x, bx = blockIdx.x;
    const int gw = bx * 8 + wave, NGW = G * 8;
    unsigned char* ws = P.ws;
    float* out = P.out;
    typedef const float* cfp_t; typedef __attribute__((address_space(4))) const cfp_t* kargp_t;
#define INP(i) ({ kargp_t kp_ = (kargp_t)__builtin_amdgcn_kernarg_segment_ptr(); asm volatile("" : "+s"(kp_)); kp_[i]; })
#define out_ka (out + (size_t)MTOK * DM)
#define out_va (out + (size_t)MTOK * DM + NCTX * 128)
#define out_kc (out + (size_t)MTOK * DM + NCTX * 256)
#define out_vc (out + (size_t)MTOK * DM + NCTX * 512)
#define mod ((float*)(ws + WS_MOD))
#define ss0 ((float*)(ws + WS_SS0))
#define ss1 ((float*)(ws + WS_SS1))
#define ss2 ((float*)(ws + WS_SS2))
#define ss3 ((float*)(ws + WS_SS3))
#define ssv ((float*)(ws + WS_SSV))
#define rope ((float*)(ws + WS_ROPE))
#define biasw ((float*)(ws + WS_BIAS))
#define ZB ((float*)(ws + WS_ZB))
#define CK_A ((bf16_t*)(ws + WS_CK_A))
#define CVT_A ((bf16_t*)(ws + WS_CVT_A))
#define CK_C ((bf16_t*)(ws + WS_CK_C))
#define CVT_C ((bf16_t*)(ws + WS_CVT_C))
#define W_INE ((bf16_t*)(ws + WS_W_INE))
#define W_OUTE ((bf16_t*)(ws + WS_W_OUTE))
#define W_INO ((bf16_t*)(ws + WS_W_INO))
#define W_OUTO ((bf16_t*)(ws + WS_W_OUTO))
#define W_UP ((bf16_t*)(ws + WS_W_UP))
#define W_DN ((bf16_t*)(ws + WS_W_DN))
#define Abuf ((bf16_t*)(ws + WS_A))
#define ACT ((bf16_t*)(ws + WS_ACT))
#define MIX ((bf16_t*)(ws + WS_MIX))
#define Qb ((bf16_t*)(ws + WS_Q))
#define KE ((bf16_t*)(ws + WS_KE))
#define VTE ((bf16_t*)(ws + WS_VTE))
#define VBT ((bf16_t*)(ws + WS_VBT))
#define KO ((bf16_t*)(ws + WS_KO))
#define VTO ((bf16_t*)(ws + WS_VTO))
    LAS float* spare = (LAS float*)(lds + LDS_SPARE);

    const int lo = P.ph_lo, hi = P.ph_hi;
    XcdBarrier xbar; xbar.bar = (unsigned*)(ws + WS_BAR); xbar.x = 0; xbar.st = (volatile LAS unsigned*)(lds + LDS_SPARE + 12288);
    if constexpr (COOP) {
        if (tid < 2) ((LAS unsigned*)(lds + LDS_SPARE + 12288))[tid] = 0u;
        __syncthreads();
        xbar = xcd_barrier_post((unsigned*)(ws + WS_BAR), (volatile LAS unsigned*)(lds + LDS_SPARE + 12288));
        if (P.ph_lo < 0) cg::this_grid().sync();
    }
#ifndef MK_PHMASK
#define MK_PHMASK 0x7fff
#endif
#define IN(k) ((((MK_PHMASK) >> (k)) & 1) && lo <= (k) && (k) < hi)
#define SEAM(k) do { if constexpr (COOP) { if (IN(k) && IN((k) + 1)) { xcd_barrier(xbar); } } } while (0)

    if (IN(0)) {
        const float* c_in = INP(6); const float* c_ctx = INP(7); const float* w_mod = INP(8); const float* b_mod = INP(9);
        for (int it = bx; it < 2 * 24 * 16; it += G) {
            const int l = it / 384, cbk = (it % 384) / 16, ksp = it % 16;
            __syncthreads();
            for (int i = tid; i < NCOND * 64; i += 512) { const int cd = i >> 6, k = ksp * 64 + (i & 63); const float v = cd == 0 ? c_ctx[k] : c_in[(cd - 1) * DM + k]; spare[i] = v / (1.0f + __expf(-v)); }
            __syncthreads();
            const int col = cbk * 256 + (tid & 255), kh = tid >> 8;
            float a[NCOND];
#pragma unroll
            for (int cd = 0; cd < NCOND; ++cd) a[cd] = 0.f;
            const float* wp = w_mod + ((size_t)l * DM + ksp * 64 + kh * 32) * MODW + col;
#pragma unroll 4
            for (int k = 0; k < 32; ++k) { const float w = wp[(size_t)k * MODW];
#pragma unroll
                for (int cd = 0; cd < NCOND; ++cd) a[cd] += spare[cd * 64 + kh * 32 + k] * w; }
            const float bm = (ksp == 0 && kh == 0) ? b_mod[l * MODW + col] : 0.f;
#pragma unroll
            for (int cd = 0; cd < NCOND; ++cd) atomicAdd(mod + ((size_t)l * NCOND + cd) * MODW + col, a[cd] + bm);
        }
        __syncthreads();
        {
            const float* w_in_even = INP(10); const float* w_out_even = INP(16); const float* w_in_odd = INP(17); const float* w_out_odd = INP(21); const float* w_up = INP(22); const float* w_down = INP(25);
            LAS float* scr = (LAS float*)(lds + wave * 16384);
            constexpr int I_INE = 16 * 56, I_OUT = 16 * 32, I_INO = 16 * 48, I_UP = 16 * 176, I_DN = 44 * 32;
            constexpr int NIT = I_INE + 2 * I_OUT + I_INO + 2 * I_UP + 2 * I_DN;
            for (int it = gw; it < NIT; it += NGW) {
                int r = it;
                if (r < I_INE) { const int kb = r / 56, nb = r % 56; transpose_item(w_in_even, DM, EVEN_IN, W_INE, 64 * kb, 32 * nb, perm_in(32 * nb), scr, lane); continue; } r -= I_INE;
                if (r < I_OUT) { const int kb = r / 32, nb = r % 32; transpose_item(w_out_even, DM, DM, W_OUTE, 64 * kb, 32 * nb, 32 * nb, scr, lane); continue; } r -= I_OUT;
                if (r < I_INO) { const int kb = r / 48, nb = r % 48; transpose_item(w_in_odd, DM, ODD_IN, W_INO, 64 * kb, 32 * nb, perm_in(32 * nb), scr, lane); continue; } r -= I_INO;
                if (r < I_OUT) { const int kb = r / 32, nb = r % 32; transpose_item(w_out_odd, DM, DM, W_OUTO, 64 * kb, 32 * nb, 32 * nb, scr, lane); continue; } r -= I_OUT;
                if (r < 2 * I_UP) { const int l = r / I_UP, q = r % I_UP, kb = q / 176, nb = q % 176; transpose_item(w_up + (size_t)l * DM * FF2, DM, FF2, W_UP + (size_t)l * FF2 * DM, 64 * kb, 32 * nb, perm_up(32 * nb), scr, lane); continue; } r -= 2 * I_UP;
                { const int l = r / I_DN, q = r % I_DN, kb = q / 32, nb = q % 32; transpose_item(w_down + (size_t)l * FF * DM, FF, DM, W_DN + (size_t)l * DM * FF, 64 * kb, 32 * nb, 32 * nb, scr, lane); }
            }
        }
        {
            const float* cache_k_attn = INP(2); const float* cache_v_attn = INP(3); const float* cache_k_swa = INP(4); const float* cache_v_swa = INP(5);
            const int gt = bx * 512 + tid, NT_ = G * 512;
            for (int i = gt; i < 8 * 512 * 128 / 4; i += NT_) { const f32x4 v = *(const f32x4*)(cache_k_attn + (size_t)i * 4); *(u32x2*)(CK_A + (size_t)i * 4) = (u32x2){pk2(v[0], v[1]), pk2(v[2], v[3])}; }
            for (int i = gt; i < 8 * 512 * 256 / 4; i += NT_) { const f32x4 v = *(const f32x4*)(cache_k_swa + (size_t)i * 4); *(u32x2*)(CK_C + (size_t)i * 4) = (u32x2){pk2(v[0], v[1]), pk2(v[2], v[3])}; }
            for (int i = gt; i < 8 * 64 * 128; i += NT_) { const int cd = i & 127, pc = (i >> 7) & 63, b = i >> 13; const float* s = cache_v_attn + ((size_t)b * 512 + pc * 8) * 128 + cd;
                u32x4 o; o.x = pk2(s[0], s[128]); o.y = pk2(s[256], s[384]); o.z = pk2(s[512], s[640]); o.w = pk2(s[768], s[896]);
                *(u32x4*)(CVT_A + ((size_t)b * 128 + cd) * 512 + pc * 8) = o; }
            for (int i = gt; i < 8 * 64 * 256; i += NT_) { const int cd = i & 255, pc = (i >> 8) & 63, b = i >> 14; const float* s = cache_v_swa + ((size_t)b * 512 + pc * 8) * 256 + cd;
                u32x4 o; o.x = pk2(s[0], s[256]); o.y = pk2(s[512], s[768]); o.z = pk2(s[1024], s[1280]); o.w = pk2(s[1536], s[1792]);
                *(u32x4*)(CVT_C + ((size_t)b * 256 + cd) * 512 + pc * 8) = o; }
            if (gt < 1024) { const int pos = gt >> 4, f = gt & 15; const float inv = exp2f(-(float)f * (13.287712379549449f / 16.0f)); const float ang = (float)pos * inv;
                rope[gt * 2] = cosf(ang); rope[gt * 2 + 1] = sinf(ang); }
        }
    }
    SEAM(0);
    if (IN(1)) {
        const float* x_prompt = INP(0); const float* x_sample = INP(1);
        for (int row = gw; row < MTOK; row += NGW) {
            const float* xr = row < NCTX ? x_prompt + (size_t)row * DM : x_sample + (size_t)(row - NCTX) * DM;
            const int cond = row < NCTX ? 0 : 1 + ((row - NCTX) >> 11);
            const float* sc = mod + (size_t)cond * MODW + 1024;
            f32x4 v[4]; float s = 0.f;
#pragma unroll
            for (int j = 0; j < 4; ++j) { v[j] = *(const f32x4*)(xr + 256 * j + 4 * lane); s += (v[j][0] * v[j][0] + v[j][1] * v[j][1]) + (v[j][2] * v[j][2] + v[j][3] * v[j][3]); }
            s = wave_sum(s);
            if (lane == 0) ss0[row] = s;
#pragma unroll
            for (int j = 0; j < 4; ++j) { const f32x4 s4 = *(const f32x4*)(sc + 256 * j + 4 * lane); const f32x4 h = v[j] * (s4 + 1.0f);
                *(u32x2*)(Abuf + (size_t)row * DM + 256 * j + 4 * lane) = (u32x2){cvt_pk_bf16(h[0], h[1]), cvt_pk_bf16(h[2], h[3])}; }
        }
        constexpr int NB0 = 1792 / 64, NB1 = 5632 / 64, NB2 = 1536 / 64, NBT = NB0 + 2 * NB1 + NB2;
        for (int it = gw; it < NCOND * NBT; it += NGW) {
            const int cond = it / NBT; int r = it % NBT;
            const bf16_t* Wt; const float* sh; float* dst; int N;
            if (r < NB0) { Wt = W_INE; sh = mod + (size_t)cond * MODW; dst = biasw + BIAS_INE; N = 1792; }
            else if ((r -= NB0) < NB1) { Wt = W_UP; sh = mod + (size_t)cond * MODW + 3072; dst = biasw + BIAS_UP0; N = 5632; }
            else if ((r -= NB1) < NB2) { Wt = W_INO; sh = mod + (size_t)(NCOND + cond) * MODW; dst = biasw + BIAS_INO; N = 1536; }
            else { r -= NB2; Wt = W_UP + (size_t)FF2 * DM; sh = mod + (size_t)(NCOND + cond) * MODW + 3072; dst = biasw + BIAS_UP1; N = 5632; }
            float sv[16];
#pragma unroll
            for (int j = 0; j < 4; ++j) { const f32x4 t4 = *(const f32x4*)(sh + 16 * lane + 4 * j); sv[4 * j] = t4[0]; sv[4 * j + 1] = t4[1]; sv[4 * j + 2] = t4[2]; sv[4 * j + 3] = t4[3]; }
            for (int n = 0; n < 64; n += 4) {
                float d[4];
#pragma unroll
                for (int q = 0; q < 4; ++q) {
                    const bf16_t* wr_ = Wt + (size_t)(r * 64 + n + q) * DM + 16 * lane;
                    const u32x4 w0 = *(const u32x4*)wr_, w1 = *(const u32x4*)(wr_ + 8);
                    float dd = 0.f;
#pragma unroll
                    for (int j = 0; j < 4; ++j) { dd += sv[2 * j] * __uint_as_float(w0[j] << 16) + sv[2 * j + 1] * __uint_as_float(w0[j] & 0xffff0000u); dd += sv[8 + 2 * j] * __uint_as_float(w1[j] << 16) + sv[8 + 2 * j + 1] * __uint_as_float(w1[j] & 0xffff0000u); }
                    d[q] = dd;
                }
#pragma unroll
                for (int o = 1; o < 64; o <<= 1) {
#pragma unroll
                    for (int q = 0; q < 4; ++q) d[q] += __shfl_xor(d[q], o);
                }
                if (lane == 0) {
#pragma unroll
                    for (int q = 0; q < 4; ++q) dst[(size_t)cond * N + r * 64 + n + q] = d[q];
                }
            }
        }
    }
    SEAM(1);
    pg8::StaticOrder S;
    for (int ph = (lo > 2 ? lo : 2); ph < hi; ++ph) {
        if (((MK_PHMASK >> ph) & 1) != 0) {
#pragma unroll 1
        for (int slot = 0; slot < 2; ++slot) {
            int st = -1, c0 = 0, nc = G;
            if (slot == 0) { st = ph - 2; if (st > 11) st = -1; if (ph == 8 && G == 256) { c0 = 128; nc = 128; } }
            else {
                switch (ph) { case 3: st = 0; break; case 4: st = 1; break; case 5: st = 2; break; case 7: st = 3; break; case 8: st = 5; break; case 9: st = 6; break;
                              case 10: st = 7; break; case 11: st = 8; break; case 13: st = 9; break; case 14: st = 11; break; default: st = -1; }
                if (G == 256) { if (ph == 3) nc = 224; else if (ph == 5 || ph == 11) { c0 = 128; nc = 128; } else if (ph == 8 || ph == 14) nc = 128; else if (ph == 9) nc = 192; }
            }
            if (st < 0) continue;
            unsigned char* ws = P.ws; asm volatile("" : "+s"(ws));
            float* out = P.out; asm volatile("" : "+s"(out));
            int tid = threadIdx.x; asm volatile("" : "+v"(tid));
            LAS unsigned char* lds = (LAS unsigned char*)lds_raw; { unsigned l_ = (unsigned)(uintptr_t)lds; asm volatile("" : "+s"(l_)); lds = (LAS unsigned char*)(uintptr_t)l_; }
            LAS float* spare = (LAS float*)(lds + LDS_SPARE);
            const int pm0 = slot == 0 ? 32 : 0, nM = slot == 0 ? 64 : 32;
            const int rel = (bx - c0 + G) % G;
            const int L = st >= 6 ? 1 : 0;
            float* modL = mod + (size_t)L * NCOND * MODW;
            if (st == 0) {
                pg8::Gemm g{Abuf, W_INE, MTOK, EVEN_IN, DM}; S.init(pm0, nM, EVEN_IN, G, bx, c0, nc);
                EpiIn<true> E{ws, out, INP(11), INP(12)};
                pg8::gemm_phase<EpiIn<true>, true>(lds, g, S, E, tid);
            } else if (st == 6) {
                pg8::Gemm g{Abuf, W_INO, MTOK, ODD_IN, DM}; S.init(pm0, nM, ODD_IN, G, bx, c0, nc);
                EpiIn<false> E{ws, out, INP(18), INP(19)};
                pg8::gemm_phase<EpiIn<false>, true>(lds, g, S, E, tid);
            } else if (st == 2 || st == 5 || st == 8 || st == 11) {
                const bool dn = (st == 5 || st == 11);
                pg8::Gemm g{dn ? ACT : MIX, dn ? W_DN + (size_t)L * DM * FF : (L ? W_OUTO : W_OUTE), MTOK, DM, dn ? FF : DM}; S.init(pm0, nM, DM, G, bx, c0, nc);
                EpiRes E;
                if (st == 2) { E.xp = INP(0); E.xs = INP(1); } else { E.xp = out; E.xs = out + (size_t)NCTX * DM; }
                E.out = out; E.gate = modL + (dn ? 5120 : 2048);
                E.nscale = st == 11 ? nullptr : (dn ? mod + (size_t)NCOND * MODW + 1024 : modL + 4096);
                E.An = st == 11 ? nullptr : Abuf;
                E.ssn = st == 2 ? ss1 : st == 5 ? ss2 : st == 8 ? ss3 : nullptr;
                pg8::gemm_phase<EpiRes, true>(lds, g, S, E, tid);
            } else if (st == 3 || st == 9) {
                pg8::Gemm g{Abuf, W_UP + (size_t)L * FF2 * DM, MTOK, FF2, DM}; S.init(pm0, nM, FF2, G, bx, c0, nc);
                EpiUp E{ws, (unsigned)(L ? WS_SS3 : WS_SS1), (unsigned)(L ? BIAS_UP1 : BIAS_UP0), INP(23) + (size_t)L * 3 * FF2, INP(24) + (size_t)L * FF2, spare};
                pg8::gemm_phase<EpiUp, true>(lds, g, S, E, tid);
            } else if (st == 4 || st == 10) {
                if (slot == 0) {
                    const float* cw = INP(23) + (size_t)L * 3 * FF2; const float* cb = INP(24) + (size_t)L * FF2;
                    for (int i = bx * 512 + tid; i < 8 * 7 * 2 * FF; i += G * 512) {
                        const int ch = i % FF, rs = i / FF, which = rs & 1, sm = (rs >> 1) % 7, b = rs / 14;
                        const int pmA = 32 + b * 8 + sm;
                        const int zc = (ch >> 7) * 256 + (ch & 127);
                        const float* zA = ZB + (size_t)pmA * 4 * FF2; const float* zB = ZB + (size_t)(pmA + 1) * 4 * FF2;
                        float ra, rg;
                        if (which == 0) {
                            ra = cb[ch] + cw[ch] * zA[2 * FF2 + zc] + cw[FF2 + ch] * zA[3 * FF2 + zc] + cw[2 * FF2 + ch] * zB[zc];
                            rg = cb[FF + ch] + cw[FF + ch] * zA[2 * FF2 + zc + 128] + cw[FF2 + FF + ch] * zA[3 * FF2 + zc + 128] + cw[2 * FF2 + FF + ch] * zB[zc + 128];
                        } else {
                            ra = cb[ch] + cw[ch] * zA[3 * FF2 + zc] + cw[FF2 + ch] * zB[zc] + cw[2 * FF2 + ch] * zB[FF2 + zc];
                            rg = cb[FF + ch] + cw[FF + ch] * zA[3 * FF2 + zc + 128] + cw[FF2 + FF + ch] * zB[zc + 128] + cw[2 * FF2 + FF + ch] * zB[FF2 + zc + 128];
                        }
                        const int row = pmA * 256 + 255 + which;
                        ACT[(size_t)row * FF + ch] = (bf16_t)(cvt_pk_bf16(ra * silu_f(rg), 0.f) & 0xffffu);
                    }
                }
            } else if (st == 1) {
                const float* w_spatial = INP(14); const float* b_spatial = INP(15); const float* v_norm_b = INP(13);
                if (slot == 0) {
                    for (int it = rel; it < 512 + 512; it += nc) {
                        if (it < 512) {
                            const int b = it >> 6, h = (it >> 3) & 7, qb = it & 7, kvh = h >> 2;
                            const size_t row0 = NCTX + (size_t)b * 2048 + qb * 256;
                            attn_unit(lds, Qb + row0 * 512 + h * 64, 512, MIX + row0 * DM + h * 64, DM,
                                      KE + ((size_t)NCTX + (size_t)b * 2048) * 128 + kvh * 64, 128, VTE + (size_t)NCTX * 128 + (size_t)(b * 2 + kvh) * 64 * 2048, 2048, 0, 32,
                                      CK_A + (size_t)b * 512 * 128 + kvh * 64, 128, CVT_A + (size_t)(b * 2 + kvh) * 64 * 512, 512, 8, 0.f, 0.f, -1, tid);
                        } else { const int e = it - 512; spatial_unit(64 + (e >> 2), e & 3, w_spatial, b_spatial, v_norm_b, ssv, VBT, MIX, tid); }
                    }
                } else {
                    for (int it = rel; it < 256 + 256; it += nc) {
                        if (it < 256) {
                            const int b = it >> 3, h = it & 7, kvh = h >> 2;
                            const size_t row0 = (size_t)b * 256;
                            attn_unit(lds, Qb + row0 * 512 + h * 64, 512, MIX + row0 * DM + h * 64, DM,
                                      KE + row0 * 128 + kvh * 64, 128, VTE + (size_t)(b * 2 + kvh) * 64 * 256, 256, 0, 4,
                                      nullptr, 0, nullptr, 0, 0, 0.f, 0.f, -1, tid);
                        } else { const int e = it - 256; spatial_unit(e >> 2, e & 3, w_spatial, b_spatial, v_norm_b, ssv, VBT, MIX, tid); }
                    }
                }
            } else if (st == 7) {
                const float* sink_c = INP(20);
                if (slot == 0) {
                    for (int it = rel; it < 1024; it += nc) {
                        const int b = it >> 7, h = (it >> 3) & 15, qb = it & 7, kvh = h >> 2;
                        const size_t row0 = NCTX + (size_t)b * 2048 + qb * 256;
                        const int q0 = qb * 256; int klo = q0 - 128; if (klo < 0) klo = 0; int khi = q0 + 384; if (khi > 2048) khi = 2048;
                        attn_unit(lds, Qb + row0 * 1024 + h * 64, 1024, MIX + row0 * DM + h * 64, DM,
                                  KO + ((size_t)NCTX + (size_t)b * 2048) * 256 + kvh * 64, 256, VTO + (size_t)NCTX * 256 + (size_t)(b * 4 + kvh) * 64 * 2048, 2048, klo >> 6, (khi - klo) >> 6,
                                  CK_C + (size_t)b * 512 * 256 + kvh * 64, 256, CVT_C + (size_t)(b * 4 + kvh) * 64 * 512, 512, 8, sink_c[h] * LOG2E, 1.0f, q0, tid);
                    }
                } else {
                    for (int it = rel; it < 512; it += nc) {
                        const int b = it >> 4, h = it & 15, kvh = h >> 2;
                        const size_t row0 = (size_t)b * 256;
                        attn_unit(lds, Qb + row0 * 1024 + h * 64, 1024, MIX + row0 * DM + h * 64, DM,
                                  KO + row0 * 256 + kvh * 64, 256, VTO + (size_t)(b * 4 + kvh) * 64 * 256, 256, 0, 4,
                                  nullptr, 0, nullptr, 0, 0, sink_c[h] * LOG2E, 1.0f, -1, tid);
                    }
                }
            }
        }
        }
        if constexpr (COOP) {
            if (ph + 1 < hi) { XcdBarrier xb = xbar; asm volatile("" : "+s"(xb.bar), "+s"(xb.x)); xcd_barrier(xb); }
        }
    }
#undef IN
#undef SEAM
}

constexpr int N_PHASES = 15;

extern "C" void kernel_launch(void* const* d_in, const int* in_sizes, int n_in, void* d_out, int out_size, void* d_ws, size_t ws_size, hipStream_t stream) {
    static int grid = 0;
    if (grid == 0) {
        int dev = 0, cus = 0;
        hipGetDevice(&dev);
        hipDeviceGetAttribute(&cus, hipDeviceAttributeMultiprocessorCount, dev);
        hipFuncSetAttribute((const void*)mk_fwd<true>, hipFuncAttributeMaxDynamicSharedMemorySize, LDS_BYTES);
        hipFuncSetAttribute((const void*)mk_fwd<false>, hipFuncAttributeMaxDynamicSharedMemorySize, LDS_BYTES);
        int per_cu = 0;
        hipOccupancyMaxActiveBlocksPerMultiprocessor(&per_cu, (const void*)mk_fwd<true>, 512, LDS_BYTES);
        (void)hipGetLastError();
        if (per_cu < 1) fprintf(stderr, "kernel_launch: occupancy query says %d blocks/CU\n", per_cu);
        grid = cus > 0 ? cus : 256;
        if (n_in != 26 || ws_size < WS_END) { fprintf(stderr, "kernel_launch: unexpected n_in %d / ws %zu\n", n_in, ws_size); }
    }
    hipMemsetAsync((char*)d_ws, 0, WS_ZERO_BYTES, stream);
    Params p{};
    for (int i = 0; i < 26; ++i) p.in[i] = (const float*)d_in[i];
    p.out = (float*)d_out; p.ws = (unsigned char*)d_ws;
#if MK_COOP
    p.ph_lo = 0; p.ph_hi = N_PHASES;
    void* args[] = {&p};
    hipError_t e = hipLaunchCooperativeKernel((const void*)mk_fwd<true>, dim3(grid), dim3(512), args, LDS_BYTES, stream);
    if (e != hipSuccess) fprintf(stderr, "cooperative launch failed: %s (grid %d)\n", hipGetErrorString(e), grid);
#else
    for (int ph = 0; ph < N_PHASES; ++ph) {
        p.ph_lo = ph; p.ph_hi = ph + 1;
        hipLaunchKernelGGL(mk_fwd<false>, dim3(grid), dim3(512), LDS_BYTES, stream, p);
        if (ph == MK_DUP) hipLaunchKernelGGL(mk_fwd<false>, dim3(grid), dim3(512), LDS_BYTES, stream, p);
    }
#endif
}
```

```cpp
#include <hip/hip_runtime.h>
#include <hip/hip_cooperative_groups.h>
#include <cstdio>
#include <cstdint>
namespace cg = cooperative_groups;

#ifndef MK_COOP
#define MK_COOP 1
#endif

#ifndef MK_DUP
#define MK_DUP -1
#endif
#ifndef MK_TP_LO
#define MK_TP_LO -1
#define MK_TP_HI -1
#endif
#define LAS __attribute__((address_space(3)))
typedef unsigned short bf16_t;
typedef short bf16x8 __attribute__((ext_vector_type(8)));
typedef short s16x4 __attribute__((ext_vector_type(4)));
typedef float f32x4 __attribute__((ext_vector_type(4)));
typedef float f32x2 __attribute__((ext_vector_type(2)));
typedef float f32x16 __attribute__((ext_vector_type(16)));
typedef unsigned u32x4 __attribute__((ext_vector_type(4)));
typedef unsigned u32x2 __attribute__((ext_vector_type(2)));

constexpr int DM = 1024, NCTX = 8192, NLAT = 16384, MTOK = 24576;
constexpr int EVEN_IN = 1792, ODD_IN = 1536, FF = 2816, FF2 = 5632;
constexpr int NCOND = 9, MODW = 6144;
constexpr float EPS = 1e-6f;
constexpr float LOG2E = 1.4426950408889634f;

constexpr size_t MiB = 1u << 20;
constexpr size_t WS_MOD = 0;
constexpr size_t WS_SS1 = 442368, WS_SS2 = WS_SS1 + 98304, WS_SS3 = WS_SS2 + 98304, WS_SSV = WS_SS3 + 98304;
constexpr size_t WS_BAR = 900 * 1024;
constexpr size_t WS_ZERO_BYTES = 1 * MiB;
constexpr size_t WS_SS0 = 1 * MiB;
constexpr size_t WS_ROPE = 1 * MiB + 128 * 1024;
constexpr size_t WS_TS = 1 * MiB + 192 * 1024;
constexpr size_t WS_BIAS = 1 * MiB + 256 * 1024;
constexpr size_t WS_ZB = 2 * MiB;
constexpr size_t WS_CK_A = 11 * MiB, WS_CVT_A = 12 * MiB, WS_CK_C = 13 * MiB, WS_CVT_C = 15 * MiB;
constexpr size_t WS_W_INE = 18 * MiB, WS_W_OUTE = 22 * MiB, WS_W_INO = 24 * MiB, WS_W_OUTO = 27 * MiB, WS_W_UP = 29 * MiB, WS_W_DN = 51 * MiB;
constexpr size_t WS_A = 62 * MiB;
constexpr size_t WS_BIG = 110 * MiB;
constexpr size_t WS_ACT = WS_BIG;
constexpr size_t WS_MIX = WS_BIG;
constexpr size_t WS_Q = WS_BIG + 48 * MiB;
constexpr size_t WS_KE = WS_Q + 24 * MiB, WS_VTE = WS_KE + 6 * MiB, WS_VBT = WS_VTE + 6 * MiB;
constexpr size_t WS_KO = WS_Q + 48 * MiB, WS_VTO = WS_KO + 12 * MiB;
constexpr size_t WS_END = 256 * MiB;
static_assert(WS_VBT + 24 * MiB <= WS_END && WS_VTO + 12 * MiB <= WS_END && WS_ACT + 132 * MiB <= WS_END, "ws map");
constexpr size_t BIAS_INE = 0, BIAS_UP0 = 9 * 1792, BIAS_INO = BIAS_UP0 + 9 * 5632, BIAS_UP1 = BIAS_INO + 9 * 1536;

constexpr int LDS_BYTES = 147456;
constexpr int LDS_SPARE = 131072;

struct Params {
    const float* in[26];
    float* out;
    unsigned char* ws;
    int ph_lo, ph_hi;
};

namespace pg8 {
constexpr int BM = 256, BK = 64, HALF = 128, HTB = HALF * BK * 2, STAGE_BYTES = 8 * HTB, NXCD = 8, WGM = 8;
__host__ __device__ __forceinline__ int lds_byte(int r, int c) { const int st = (r >> 4) * 2 + (c >> 5), rr = r & 15, cc = c & 31, ob = rr * 64 + cc * 2; return st * 1024 + (ob ^ (((ob >> 9) & 1) << 5)); }
__host__ __device__ __forceinline__ void stage_rc(int b, int& R, int& C) { const int st = b / 1024, sb = b % 1024, swz = sb ^ (((sb >> 9) & 1) << 5); R = (st >> 1) * 16 + swz / 64; C = (st & 1) * 32 + (swz % 64) / 2; }
__host__ __device__ __forceinline__ int perm32(int rho) { const int n = rho >> 4, i = rho & 15; return 8 * (i >> 2) + 4 * n + (i & 3); }
struct Unit { int pm, pn; };
struct Gemm { const bf16_t* A; const bf16_t* Bt; int M, N, K; };
struct StaticOrder {
    int nM, nN, nwg, nc, rel, pm0;
    __device__ __forceinline__ void init(int pm0_, int nM_, int N, int G, int c, int c0, int nc_) { pm0 = pm0_; nM = nM_; nN = N / BM; nwg = nM * nN; nc = nc_; rel = (c - c0 + G) % G; }
    __device__ __forceinline__ bool next(int i, Unit& u) const {
        if (rel >= nc) return false;
        const long L = (long)i * nc + rel; if (L >= nwg) return false;
        int wgid = (int)L; { const int q = nwg / NXCD, r = nwg % NXCD, xcd = wgid % NXCD, off = wgid / NXCD; wgid = (xcd < r ? xcd * (q + 1) : r * (q + 1) + (xcd - r) * q) + off; }
        const int nig = WGM * nN, gid = wgid / nig, fm = gid * WGM, gsz = (nM - fm) < WGM ? (nM - fm) : WGM;
        u.pm = pm0 + fm + ((wgid % nig) % gsz); u.pn = (wgid % nig) / gsz; return true;
    }
};
__device__ __forceinline__ unsigned cvt_pk_bf16(float lo, float hi) { unsigned r; asm volatile("v_cvt_pk_bf16_f32 %0, %1, %2" : "=v"(r) : "v"(lo), "v"(hi)); return r; }

template <class Epi, bool ALIGN_EPI>
__device__ __forceinline__ void gemm_phase(LAS unsigned char* lds, const Gemm g, const StaticOrder& S, const Epi& E, const int tid) {
    const int wid = __builtin_amdgcn_readfirstlane(tid >> 6), lane = tid & 63, wr = wid >> 2, wc = wid & 3, fr = lane & 15, fq = lane >> 4;
    const int K = g.K, nt = K / BK;
    unsigned voffA[2], voffB[2];
#pragma unroll
    for (int i = 0; i < 2; ++i) { int R, C; stage_rc(tid * 16 + i * 8192, R, C); const int Rb = (R & ~31) + perm32(R & 31);
        voffA[i] = (unsigned)(R * K + C) * 2u; voffB[i] = (unsigned)(Rb * K + C) * 2u; }
    const size_t kstep = (size_t)(BK * 2);
    const size_t hstep = (size_t)HALF * K * 2;
    const size_t tstep = 2 * hstep;
    const unsigned ldsw = (unsigned)wid * 1024u;
    const int aoff = lds_byte(wr * 64 + fr, fq * 8), boff = lds_byte(wc * 32 + fr, fq * 8);
#define PG8_SA(b, h) (((b) * 2 + (h)) * HTB)
#define PG8_SB(b, h) ((4 + (b) * 2 + (h)) * HTB)
#define PG8_STAGE(bufoff, gbase, voff) do { _Pragma("unroll") for (int _i = 0; _i < 2; ++_i) \
        __builtin_amdgcn_global_load_lds((const unsigned*)((const char*)(gbase) + (voff)[_i]), (LAS unsigned*)(lds + (bufoff) + ldsw + _i * 8192), 16, 0, 0); } while (0)
#define PG8_LDA(dst, b, h) do { _Pragma("unroll") for (int m = 0; m < 4; ++m) _Pragma("unroll") for (int k = 0; k < 2; ++k) dst[m][k] = *(const LAS bf16x8*)(lds + PG8_SA(b, h) + aoff + m * 2048 + k * 1024); } while (0)
#define PG8_LDB(dst, b, h) do { _Pragma("unroll") for (int n = 0; n < 2; ++n) _Pragma("unroll") for (int k = 0; k < 2; ++k) dst[n][k] = *(const LAS bf16x8*)(lds + PG8_SB(b, h) + boff + n * 2048 + k * 1024); } while (0)
#define PG8_MMA(ai, bj, At, Bt) do { __builtin_amdgcn_s_setprio(1); _Pragma("unroll") for (int m = 0; m < 4; ++m) _Pragma("unroll") for (int n = 0; n < 2; ++n) _Pragma("unroll") for (int k = 0; k < 2; ++k) \
        acc[ai][bj][m][n] = __builtin_amdgcn_mfma_f32_16x16x32_bf16(Bt[n][k], At[m][k], acc[ai][bj][m][n], 0, 0, 0); __builtin_amdgcn_s_setprio(0); } while (0)
#define PG8_WAIT_V(n) asm volatile("s_waitcnt vmcnt(" #n ")" ::: "memory")
#define PG8_WAIT_L(n) asm volatile("s_waitcnt lgkmcnt(" #n ")" ::: "memory")
#define PG8_BAR __builtin_amdgcn_s_barrier()
#define PG8_SCHED __builtin_amdgcn_sched_barrier(0)
    Unit cur, nxt; int ui = 0;
    if (!S.next(0, cur)) return;
    f32x4 acc[2][2][4][2];
#pragma unroll
    for (int a = 0; a < 2; ++a)
#pragma unroll
        for (int b = 0; b < 2; ++b)
#pragma unroll
            for (int m = 0; m < 4; ++m)
#pragma unroll
                for (int n = 0; n < 2; ++n) acc[a][b][m][n] = (f32x4){0.f, 0.f, 0.f, 0.f};
    bf16x8 At[4][2], B0[2][2], B1[2][2];
    const char* cA = (const char*)g.A + (size_t)cur.pm * tstep; const char* cB = (const char*)g.Bt + (size_t)cur.pn * tstep;
    PG8_STAGE(PG8_SB(0, 0), cB, voffB); PG8_STAGE(PG8_SB(0, 1), cB + hstep, voffB); PG8_STAGE(PG8_SA(0, 0), cA, voffA); PG8_STAGE(PG8_SA(0, 1), cA + hstep, voffA);
    if (wr == 1) PG8_BAR;
    PG8_WAIT_V(2); PG8_BAR;
    PG8_STAGE(PG8_SB(1, 0), cB + kstep, voffB); PG8_STAGE(PG8_SA(1, 0), cA + kstep, voffA); PG8_STAGE(PG8_SB(1, 1), cB + hstep + kstep, voffB);
    PG8_WAIT_V(6); PG8_BAR;
    for (;;) {
        const bool has_next = S.next(ui + 1, nxt);
        const char* nA = has_next ? (const char*)g.A + (size_t)nxt.pm * tstep : cA; const char* nB = has_next ? (const char*)g.Bt + (size_t)nxt.pn * tstep : cB;
        for (int t = 0; t < nt; t += 2) {
            const bool last = (t == nt - 2);
            const char* a1 = cA + (size_t)(t + 1) * kstep;
            const char* a2 = last ? nA : cA + (size_t)(t + 2) * kstep; const char* b2 = last ? nB : cB + (size_t)(t + 2) * kstep;
            const char* a3 = a2 + kstep; const char* b3 = b2 + kstep;
            PG8_LDB(B0, 0, 0); PG8_LDB(B1, 0, 1); PG8_SCHED; PG8_LDA(At, 0, 0); PG8_STAGE(PG8_SA(1, 1), a1 + hstep, voffA);
            PG8_WAIT_V(8); PG8_WAIT_L(0); PG8_BAR; PG8_MMA(0, 0, At, B0); PG8_MMA(0, 1, At, B1); PG8_BAR; PG8_SCHED;
            PG8_LDA(At, 0, 1); PG8_STAGE(PG8_SB(0, 0), b2, voffB); PG8_STAGE(PG8_SB(0, 1), b2 + hstep, voffB); PG8_STAGE(PG8_SA(0, 0), a2, voffA);
            PG8_WAIT_V(8); PG8_WAIT_L(0); PG8_BAR; PG8_MMA(1, 0, At, B0); PG8_MMA(1, 1, At, B1); PG8_BAR; PG8_SCHED;
            PG8_LDB(B0, 1, 0); PG8_LDB(B1, 1, 1); PG8_SCHED; PG8_LDA(At, 1, 0); PG8_STAGE(PG8_SA(0, 1), a2 + hstep, voffA);
            PG8_WAIT_V(8); PG8_WAIT_L(0); PG8_BAR; PG8_MMA(0, 0, At, B0); PG8_MMA(0, 1, At, B1); PG8_BAR; PG8_SCHED;
            PG8_LDA(At, 1, 1); PG8_STAGE(PG8_SB(1, 0), b3, voffB); PG8_STAGE(PG8_SB(1, 1), b3 + hstep, voffB); PG8_STAGE(PG8_SA(1, 0), a3, voffA);
            PG8_WAIT_V(8); PG8_WAIT_L(0); PG8_BAR; PG8_MMA(1, 0, At, B0); PG8_MMA(1, 1, At, B1); PG8_BAR; PG8_SCHED;
        }
        if constexpr (ALIGN_EPI) { if (wr == 0) PG8_BAR; }
        E(acc, cur, wr, wc, fr, fq);
        if (!has_next) break;
#pragma unroll
        for (int a = 0; a < 2; ++a)
#pragma unroll
            for (int b = 0; b < 2; ++b)
#pragma unroll
                for (int m = 0; m < 4; ++m)
#pragma unroll
                    for (int n = 0; n < 2; ++n) acc[a][b][m][n] = (f32x4){0.f, 0.f, 0.f, 0.f};
        cur = nxt; cA = nA; cB = nB; ++ui;
        if constexpr (ALIGN_EPI) { if (wr == 1) PG8_BAR; }
    }
    PG8_WAIT_V(0);
    if constexpr (!ALIGN_EPI) { if (wr == 0) PG8_BAR; }
    PG8_BAR;
#undef PG8_SA
#undef PG8_SB
#undef PG8_STAGE
#undef PG8_LDA
#undef PG8_LDB
#undef PG8_MMA
#undef PG8_WAIT_V
#undef PG8_WAIT_L
#undef PG8_BAR
#undef PG8_SCHED
}
}

using pg8::cvt_pk_bf16;
typedef f32x4 (&AccRef)[2][2][4][2];

__device__ __forceinline__ int cond_of_tile(int pm) { return pm < 32 ? 0 : 1 + ((pm - 32) >> 3); }
__device__ __forceinline__ float red_fq(float v) { v += __shfl_xor(v, 16); v += __shfl_xor(v, 32); return v; }
__device__ __forceinline__ float gelu_tanh(float x) { const float u = x + 0.044715f * x * x * x; return x * __builtin_amdgcn_rcpf(1.0f + __builtin_amdgcn_exp2f(-2.302208198f * u)); }
__device__ __forceinline__ float silu_f(float x) { return x * __builtin_amdgcn_rcpf(1.0f + __builtin_amdgcn_exp2f(-LOG2E * x)); }
__device__ __forceinline__ u32x4 pack8(const f32x4 a, const f32x4 b) { u32x4 w; w.x = cvt_pk_bf16(a[0], a[1]); w.y = cvt_pk_bf16(a[2], a[3]); w.z = cvt_pk_bf16(b[0], b[1]); w.w = cvt_pk_bf16(b[2], b[3]); return w; }
__device__ __forceinline__ float bf2f(unsigned short h) { return __uint_as_float((unsigned)h << 16); }

template <class T> __device__ __forceinline__ T ldg(const void* base, unsigned off) { return *(const T*)((const char*)base + off); }
template <class T> __device__ __forceinline__ void stg(void* base, unsigned off, T v) { *(T*)((char*)base + off) = v; }
__device__ __forceinline__ float ss4(const f32x4 v) { return (v[0] * v[0] + v[1] * v[1]) + (v[2] * v[2] + v[3] * v[3]); }

struct EpiRes {
    const float* xp; const float* xs; float* out; const float* gate; const float* nscale; bf16_t* An; float* ssn;
    __device__ __forceinline__ void operator()(AccRef acc, const pg8::Unit& u, int wr, int wc, int fr, int fq) const {
        const int cond = cond_of_tile(u.pm);
        const unsigned colbase = u.pn * 256 + wc * 32 + 8 * fq;
        const bool ctx = u.pm < 32;
        const float* xb = ctx ? xp : xs;
        const unsigned rsub = ctx ? 0u : (unsigned)NCTX;
        const unsigned moff = (cond * MODW + colbase) * 4u;
        f32x4 gt[2][2], sc[2][2];
#pragma unroll
        for (int bj = 0; bj < 2; ++bj)
#pragma unroll
            for (int n = 0; n < 2; ++n) {
                gt[bj][n] = ldg<f32x4>(gate, moff + bj * 512 + n * 16);
                sc[bj][n] = An ? ldg<f32x4>(nscale, moff + bj * 512 + n * 16) + 1.0f : (f32x4){1.f, 1.f, 1.f, 1.f};
            }
#pragma unroll
        for (int ai = 0; ai < 2; ++ai)
#pragma unroll
            for (int mp = 0; mp < 2; ++mp) {
                f32x4 xo[2][2][2];
#pragma unroll
                for (int q = 0; q < 2; ++q) {
                    const unsigned row = u.pm * 256 + ai * 128 + wr * 64 + (2 * mp + q) * 16 + fr;
                    const unsigned xoff = ((row - rsub) * DM + colbase) * 4u;
#pragma unroll
                    for (int bj = 0; bj < 2; ++bj)
#pragma unroll
                        for (int n = 0; n < 2; ++n) xo[q][bj][n] = ldg<f32x4>(xb, xoff + bj * 512 + n * 16);
                }
#pragma unroll
                for (int q = 0; q < 2; ++q) {
                    const int m = 2 * mp + q;
                    const unsigned row = u.pm * 256 + ai * 128 + wr * 64 + m * 16 + fr;
                    const unsigned ooff = (row * DM + colbase) * 4u;
                    float ssum = 0.f;
#pragma unroll
                    for (int bj = 0; bj < 2; ++bj) {
                        f32x4 xn[2];
#pragma unroll
                        for (int n = 0; n < 2; ++n) {
                            xn[n] = xo[q][bj][n] + gt[bj][n] * acc[ai][bj][m][n];
                            stg<f32x4>(out, ooff + bj * 512 + n * 16, xn[n]);
                            ssum += ss4(xn[n]);
                        }
                        if (An) stg<u32x4>(An, (row * DM + colbase) * 2u + bj * 256, pack8(xn[0] * sc[bj][0], xn[1] * sc[bj][1]));
                    }
                    if (ssn) { ssum = red_fq(ssum); if (fq == 0) atomicAdd((float*)((char*)ssn + row * 4u), ssum); }
                }
                asm volatile("" ::: "memory");
            }
    }
};

template <bool EVEN>
struct EpiIn {
    unsigned char* wsb; float* outb;
    const float* qg; const float* kg;
    __device__ __forceinline__ void operator()(AccRef acc, const pg8::Unit& u, int wr, int wc, int fr, int fq) const {
        constexpr unsigned N = EVEN ? EVEN_IN : ODD_IN, QW = EVEN ? 512 : 1024, KVH = EVEN ? 2 : 4, KW = KVH * 64;
        const float* ss = (const float*)(wsb + (EVEN ? WS_SS0 : WS_SS2));
        const float* bias = (const float*)(wsb + WS_BIAS) + (EVEN ? BIAS_INE : BIAS_INO);
        const float* rope = (const float*)(wsb + WS_ROPE);
        bf16_t* Q = (bf16_t*)(wsb + WS_Q); bf16_t* K = (bf16_t*)(wsb + (EVEN ? WS_KE : WS_KO)); bf16_t* Vt = (bf16_t*)(wsb + (EVEN ? WS_VTE : WS_VTO));
        bf16_t* MIX = (bf16_t*)(wsb + WS_MIX); bf16_t* VbT = (bf16_t*)(wsb + WS_VBT); float* ssv = (float*)(wsb + WS_SSV);
        float* outk = outb + (size_t)MTOK * DM + (EVEN ? 0 : NCTX * 256); float* outv = outk + NCTX * KW;
        const int cond = cond_of_tile(u.pm);
        int role; unsigned hidx;
        if (EVEN) { if (u.pn < 2) { role = 0; hidx = 4 * u.pn + wc; } else if (u.pn == 2) { role = wc < 2 ? 1 : 2; hidx = wc & 1; } else if (u.pn < 5) { role = 3; hidx = (u.pn - 3) * 4 + wc; } else { role = 4; hidx = (u.pn - 5) * 4 + wc; } }
        else { if (u.pn < 4) { role = 0; hidx = 4 * u.pn + wc; } else if (u.pn == 4) { role = 1; hidx = wc; } else { role = 2; hidx = wc; } }
        const unsigned boff = (cond * N + u.pn * 256 + wc * 32 + 8 * fq) * 4u;
        const bool lat = u.pm >= 32;
        const unsigned c8 = hidx * 64 + 8 * fq;
        const float* gp = role == 0 ? qg : kg;
        f32x4 bvh[2][2];
#pragma unroll
        for (int bj = 0; bj < 2; ++bj)
#pragma unroll
            for (int n = 0; n < 2; ++n) bvh[bj][n] = ldg<f32x4>(bias, boff + bj * 512 + n * 16);
        float rrs[8];
#pragma unroll
        for (int g8 = 0; g8 < 8; ++g8) rrs[g8] = ldg<float>(ss, (u.pm * 256 + (g8 >> 2) * 128 + wr * 64 + (g8 & 3) * 16 + fr) * 4u);
#pragma unroll
        for (int g8 = 0; g8 < 8; ++g8) rrs[g8] = __builtin_amdgcn_rsqf(rrs[g8] * (1.0f / DM) + EPS);
#pragma unroll
        for (int ai = 0; ai < 2; ++ai)
#pragma unroll
            for (int m = 0; m < 4; ++m) {
                const unsigned row = u.pm * 256 + ai * 128 + wr * 64 + m * 16 + fr;
                const float rr = rrs[ai * 4 + m];
                f32x4 z[2][2];
#pragma unroll
                for (int bj = 0; bj < 2; ++bj)
#pragma unroll
                    for (int n = 0; n < 2; ++n) z[bj][n] = acc[ai][bj][m][n] * rr + bvh[bj][n];
                if (role <= 1) {
                    float s2 = (ss4(z[0][0]) + ss4(z[0][1])) + (ss4(z[1][0]) + ss4(z[1][1]));
                    s2 = red_fq(s2);
                    const float rn = __builtin_amdgcn_rsqf(s2 * (1.0f / 64.0f) + EPS);
#pragma unroll
                    for (int bj = 0; bj < 2; ++bj)
#pragma unroll
                        for (int n = 0; n < 2; ++n) z[bj][n] = z[bj][n] * rn * ldg<f32x4>(gp, (8 * fq) * 4u + bj * 128 + n * 16);
                    if (role == 1 && !lat) {
#pragma unroll
                        for (int bj = 0; bj < 2; ++bj)
#pragma unroll
                            for (int n = 0; n < 2; ++n) stg<f32x4>(outk, (row * KW + c8) * 4u + bj * 128 + n * 16, z[bj][n]);
                    }
                    if (lat) {
                        const unsigned t = (row - NCTX) & 2047u;
#pragma unroll
                        for (int bj = 0; bj < 2; ++bj) {
                            const unsigned pos = bj == 0 ? (t >> 6) : (t & 63u);
#pragma unroll
                            for (int n = 0; n < 2; ++n) {
                                const f32x4 cs = ldg<f32x4>(rope, (pos * 16 + 4 * fq) * 8u + n * 16);
                                const f32x4 v = z[bj][n];
                                z[bj][n] = (f32x4){v[0] * cs[0] - v[1] * cs[1], v[0] * cs[1] + v[1] * cs[0], v[2] * cs[2] - v[3] * cs[3], v[2] * cs[3] + v[3] * cs[2]};
                            }
                        }
                    }
                    if (role == 0) {
#pragma unroll
                        for (int bj = 0; bj < 2; ++bj) stg<u32x4>(Q, (row * QW + c8) * 2u + bj * 64, pack8(z[bj][0] * (0.125f * LOG2E), z[bj][1] * (0.125f * LOG2E)));
                    } else {
#pragma unroll
                        for (int bj = 0; bj < 2; ++bj) stg<u32x4>(K, (row * KW + c8) * 2u + bj * 64, pack8(z[bj][0], z[bj][1]));
                    }
                } else if (role == 2) {
                    if (!lat) {
#pragma unroll
                        for (int bj = 0; bj < 2; ++bj)
#pragma unroll
                            for (int n = 0; n < 2; ++n) stg<f32x4>(outv, (row * KW + c8) * 4u + bj * 128 + n * 16, z[bj][n]);
                    }
                    unsigned vb, T;
                    if (!lat) { T = 256; vb = ((row >> 8) * KVH + hidx) * 64 * 256 + (row & 255u); }
                    else { T = 2048; vb = NCTX * KW + (((row - NCTX) >> 11) * KVH + hidx) * 64 * 2048 + ((row - NCTX) & 2047u); }
                    vb += 8 * fq * T;
#pragma unroll
                    for (int bj = 0; bj < 2; ++bj)
#pragma unroll
                        for (int n = 0; n < 2; ++n)
#pragma unroll
                            for (int i = 0; i < 4; ++i) stg<bf16_t>(Vt, (vb + (32 * bj + 4 * n + i) * T) * 2u, (bf16_t)(cvt_pk_bf16(z[bj][n][i], 0.f) & 0xffffu));
                } else if (EVEN && role == 3) {
#pragma unroll
                    for (int bj = 0; bj < 2; ++bj) {
                        f32x4 a = z[bj][0], b = z[bj][1];
#pragma unroll
                        for (int i = 0; i < 4; ++i) { a[i] = gelu_tanh(a[i]); b[i] = gelu_tanh(b[i]); }
                        stg<u32x4>(MIX, (row * DM + 512 + c8) * 2u + bj * 64, pack8(a, b));
                    }
                } else if (EVEN) {
                    float s2 = 0.f;
                    const unsigned cb = (row >> 7) * 512 * 128 + (row & 127u) + c8 * 128;
#pragma unroll
                    for (int bj = 0; bj < 2; ++bj)
#pragma unroll
                        for (int n = 0; n < 2; ++n)
#pragma unroll
                            for (int i = 0; i < 4; ++i) {
                                const float gv = gelu_tanh(z[bj][n][i]); s2 += gv * gv;
                                stg<bf16_t>(VbT, (cb + (32 * bj + 4 * n + i) * 128) * 2u, (bf16_t)(cvt_pk_bf16(gv, 0.f) & 0xffffu));
                            }
                    s2 = red_fq(s2);
                    if (fq == 0) atomicAdd((float*)((char*)ssv + row * 4u), s2);
                }
                asm volatile("" ::: "memory");
            }
    }
};

template <int CTRL> __device__ __forceinline__ float dpp_rot(float v) { return __builtin_bit_cast(float, __builtin_amdgcn_update_dpp(0, __builtin_bit_cast(int, v), CTRL, 0xf, 0xf, false)); }
__device__ __forceinline__ void conv_taps(f32x4& res, const f32x4 sp, const f32x4 sn, const f32x4 w0, const f32x4 w2) {
    float r0 = res[0], r1 = res[1], r2 = res[2], r3 = res[3];
    asm("s_nop 1\n\t"
        "v_fmac_f32_dpp %0, %4, %12 row_ror:1 row_mask:0xf bank_mask:0xf\n\t"
        "v_fmac_f32_dpp %1, %5, %13 row_ror:1 row_mask:0xf bank_mask:0xf\n\t"
        "v_fmac_f32_dpp %2, %6, %14 row_ror:1 row_mask:0xf bank_mask:0xf\n\t"
        "v_fmac_f32_dpp %3, %7, %15 row_ror:1 row_mask:0xf bank_mask:0xf\n\t"
        "v_fmac_f32_dpp %0, %8, %16 row_ror:15 row_mask:0xf bank_mask:0xf\n\t"
        "v_fmac_f32_dpp %1, %9, %17 row_ror:15 row_mask:0xf bank_mask:0xf\n\t"
        "v_fmac_f32_dpp %2, %10, %18 row_ror:15 row_mask:0xf bank_mask:0xf\n\t"
        "v_fmac_f32_dpp %3, %11, %19 row_ror:15 row_mask:0xf bank_mask:0xf"
        : "+v"(r0), "+v"(r1), "+v"(r2), "+v"(r3)
        : "v"(sp[0]), "v"(sp[1]), "v"(sp[2]), "v"(sp[3]), "v"(sn[0]), "v"(sn[1]), "v"(sn[2]), "v"(sn[3]),
          "v"(w0[0]), "v"(w0[1]), "v"(w0[2]), "v"(w0[3]), "v"(w2[0]), "v"(w2[1]), "v"(w2[2]), "v"(w2[3]));
    res = (f32x4){r0, r1, r2, r3};
}
struct EpiUp {
    unsigned char* wsb; unsigned ss_off, bias_off; const float* cw; const float* cbias;
    LAS float* xch;
    __device__ __forceinline__ void operator()(AccRef acc, const pg8::Unit& u, int wr, int wc, int fr, int fq) const {
        const float* ss = (const float*)(wsb + ss_off); const float* bias = (const float*)(wsb + WS_BIAS) + bias_off;
        float* ZB = (float*)(wsb + WS_ZB); bf16_t* ACT = (bf16_t*)(wsb + WS_ACT);
        const int cond = cond_of_tile(u.pm);
        const unsigned nb = u.pn * 256 + wc * 32 + 8 * fq;
        const unsigned boff = (cond * FF2 + nb) * 4u;
#pragma unroll
        for (int ai = 0; ai < 2; ++ai)
#pragma unroll
            for (int m = 0; m < 4; ++m) {
                const unsigned row = u.pm * 256 + ai * 128 + wr * 64 + m * 16 + fr;
                const float rr = __builtin_amdgcn_rsqf(ldg<float>(ss, row * 4u) * (1.0f / DM) + EPS);
#pragma unroll
                for (int bj = 0; bj < 2; ++bj)
#pragma unroll
                    for (int n = 0; n < 2; ++n) acc[ai][bj][m][n] = acc[ai][bj][m][n] * rr + ldg<f32x4>(bias, boff + bj * 512 + n * 16);
            }
        if (wr == 0 && fr < 2) {
            const unsigned zo = ((u.pm * 4 + fr) * FF2 + nb) * 4u;
#pragma unroll
            for (int bj = 0; bj < 2; ++bj)
#pragma unroll
                for (int n = 0; n < 2; ++n) stg<f32x4>(ZB, zo + bj * 512 + n * 16, acc[0][bj][0][n]);
        }
        if (wr == 1 && fr >= 14) {
            const unsigned zo = ((u.pm * 4 + 2 + (fr - 14)) * FF2 + nb) * 4u;
#pragma unroll
            for (int bj = 0; bj < 2; ++bj)
#pragma unroll
                for (int n = 0; n < 2; ++n) stg<f32x4>(ZB, zo + bj * 512 + n * 16, acc[1][bj][3][n]);
        }
        LAS float* my = xch + (wr * 4 + wc) * 256 + 8 * fq;
        if (fr == 0) {
#pragma unroll
            for (int ai = 0; ai < 2; ++ai)
#pragma unroll
                for (int bj = 0; bj < 2; ++bj)
#pragma unroll
                    for (int n = 0; n < 2; ++n) *(LAS f32x4*)(my + ai * 128 + bj * 32 + 4 * n) = acc[ai][bj][0][n];
        }
        if (fr == 15) {
#pragma unroll
            for (int ai = 0; ai < 2; ++ai)
#pragma unroll
                for (int bj = 0; bj < 2; ++bj)
#pragma unroll
                    for (int n = 0; n < 2; ++n) *(LAS f32x4*)(my + ai * 128 + 64 + bj * 32 + 4 * n) = acc[ai][bj][3][n];
        }
        asm volatile("s_waitcnt lgkmcnt(0)" ::: "memory"); __builtin_amdgcn_s_barrier(); asm volatile("" ::: "memory");
        const unsigned chb = u.pn * 128 + wc * 32 + 8 * fq;
        const float* cw1 = cw + FF2; const float* cw2 = cw + 2 * FF2;
#pragma unroll
        for (int n = 0; n < 2; ++n) {
            const unsigned cia = (chb + 4 * n) * 4u, cig = (FF + chb + 4 * n) * 4u;
            const f32x4 wa0 = ldg<f32x4>(cw, cia), wa1 = ldg<f32x4>(cw1, cia), wa2 = ldg<f32x4>(cw2, cia), cba = ldg<f32x4>(cbias, cia);
            const f32x4 wg0 = ldg<f32x4>(cw, cig), wg1 = ldg<f32x4>(cw1, cig), wg2 = ldg<f32x4>(cw2, cig), cbg = ldg<f32x4>(cbias, cig);
#pragma unroll
            for (int ai = 0; ai < 2; ++ai) {
                const bool hasp = !(ai == 0 && wr == 0), hasn = !(ai == 1 && wr == 1);
                const LAS float* pp = xch + ((wr == 1 ? 0 : 4) + wc) * 256 + (wr == 1 ? ai : 0) * 128 + 64 + 8 * fq;
                const LAS float* pn = xch + ((wr == 0 ? 4 : 0) + wc) * 256 + (wr == 0 ? ai : 1) * 128 + 8 * fq;
                const unsigned arow = ((u.pm * 256 + ai * 128 + wr * 64 + fr) * FF + chb) * 2u;
                f32x4 sg[4];
#pragma unroll
                for (int pass = 0; pass < 2; ++pass) {
                    const int bj = 1 - pass;
                    const f32x4 w0 = pass == 0 ? wg0 : wa0, w1 = pass == 0 ? wg1 : wa1, w2 = pass == 0 ? wg2 : wa2, cb = pass == 0 ? cbg : cba;
                    f32x4 hp = (f32x4){0.f, 0.f, 0.f, 0.f}, hn = (f32x4){0.f, 0.f, 0.f, 0.f};
                    if (hasp) hp = *(const LAS f32x4*)(pp + bj * 32 + 4 * n);
                    if (hasn) hn = *(const LAS f32x4*)(pn + bj * 32 + 4 * n);
                    f32x4 prevsrc = hp;
#pragma unroll
                    for (int m = 0; m < 4; ++m) {
                        const f32x4 zc = acc[ai][bj][m][n];
                        const f32x4 nsrc = m < 3 ? acc[ai][bj][m < 3 ? m + 1 : 3][n] : hn;
                        f32x4 sp, sn;
#pragma unroll
                        for (int i = 0; i < 4; ++i) { sp[i] = fr == 15 ? prevsrc[i] : zc[i]; sn[i] = fr == 0 ? nsrc[i] : zc[i]; }
                        f32x4 res = cb + w1 * zc;
                        conv_taps(res, sp, sn, w0, w2);
                        prevsrc = zc;
                        if (pass == 0) {
#pragma unroll
                            for (int i = 0; i < 4; ++i) res[i] = silu_f(res[i]);
                            sg[m] = res;
                        } else {
                            res = res * sg[m];
                            stg<u32x2>(ACT, arow + m * (16 * FF * 2) + n * 8, (u32x2){cvt_pk_bf16(res[0], res[1]), cvt_pk_bf16(res[2], res[3])});
                        }
                    }
                }
                asm volatile("" ::: "memory");
            }
        }
    }
};

__device__ __forceinline__ int crow(int r, int hi) { return (r & 3) + 8 * (r >> 2) + 4 * hi; }
__device__ __forceinline__ void attn_unit(LAS unsigned char* lds, const bf16_t* Q, int qstride, bf16_t* O, int ostride,
                                          const bf16_t* K0, int ks0, const bf16_t* V0, int vs0, int t0lo, int nt0,
                                          const bf16_t* K1, int ks1, const bf16_t* V1, int vs1, int nt1,
                                          float m_init, float l_init, int win_q0, const int tid) {
    const int lane = tid & 63, r32 = lane & 31, hi = lane >> 5, wid = __builtin_amdgcn_readfirstlane(tid >> 6);
    const int qrow = wid * 32 + r32;
    bf16x8 qf[4];
#pragma unroll
    for (int d0 = 0; d0 < 4; ++d0) qf[d0] = *(const bf16x8*)(Q + (size_t)qrow * qstride + d0 * 16 + hi * 8);
    float mrun = m_init;
    f32x16 o0 = {}, o1 = {}, lacc, negm;
#pragma unroll
    for (int r = 0; r < 16; ++r) { lacc[r] = l_init; negm[r] = -m_init; }
    const bf16x8 ones = {0x3F80, 0x3F80, 0x3F80, 0x3F80, 0x3F80, 0x3F80, 0x3F80, 0x3F80};
    const int NT = nt0 + nt1;
    const int lrow = 8 * wid + (lane >> 3), lch = (lane & 7) ^ ((lrow >> 1) & 7);
    auto dma = [&](int t) {
        const bf16_t* kp; const bf16_t* vp;
        if (t < nt0) { kp = K0 + (size_t)((t0lo + t) * 64 + lrow) * ks0 + lch * 8; vp = V0 + (size_t)lrow * vs0 + (t0lo + t) * 64 + lch * 8; }
        else { kp = K1 + (size_t)((t - nt0) * 64 + lrow) * ks1 + lch * 8; vp = V1 + (size_t)lrow * vs1 + (t - nt0) * 64 + lch * 8; }
        LAS unsigned char* dst = lds + (t % 6) * 16384 + wid * 1024;
        __builtin_amdgcn_global_load_lds((const unsigned*)kp, (LAS unsigned*)dst, 16, 0, 0);
        __builtin_amdgcn_global_load_lds((const unsigned*)vp, (LAS unsigned*)(dst + 8192), 16, 0, 0);
    };
    const int krow = (r32 & 0x13) | ((r32 & 4) << 1) | ((r32 & 8) >> 1);
    const int koff = krow * 128 + ((hi ^ ((krow >> 1) & 7)) << 4);
    const int voff = 8192 + r32 * 128 + ((hi ^ ((r32 >> 1) & 7)) << 4);
    dma(0); if (NT > 1) dma(1); if (NT > 2) dma(2); if (NT > 3) dma(3); if (NT > 4) dma(4);
    for (int t = 0; t < NT; ++t) {
        if (t + 4 < NT) asm volatile("s_waitcnt vmcnt(8)" ::: "memory");
        else if (t + 3 < NT) asm volatile("s_waitcnt vmcnt(6)" ::: "memory");
        else if (t + 2 < NT) asm volatile("s_waitcnt vmcnt(4)" ::: "memory");
        else if (t + 1 < NT) asm volatile("s_waitcnt vmcnt(2)" ::: "memory");
        else asm volatile("s_waitcnt vmcnt(0)" ::: "memory");
        __builtin_amdgcn_s_barrier(); asm volatile("" ::: "memory");
        if (t + 5 < NT) dma(t + 5);
        bool active = true;
        int key0 = 0;
        if (win_q0 >= 0 && t < nt0) {
            key0 = (t0lo + t) * 64;
            const int qw0 = win_q0 + wid * 32;
            active = !(key0 + 63 < qw0 - 128 || key0 > qw0 + 31 + 128);
        }
        if (active) {
            const LAS unsigned char* sb = lds + (t % 6) * 16384;
            f32x16 p0 = negm, p1 = negm;
#pragma unroll
            for (int d0 = 0; d0 < 4; ++d0) {
                const bf16x8 k0 = *(const LAS bf16x8*)(sb + (koff ^ (d0 << 5)));
                const bf16x8 k1 = *(const LAS bf16x8*)(sb + (koff ^ (d0 << 5)) + 32 * 128);
                p0 = __builtin_amdgcn_mfma_f32_32x32x16_bf16(k0, qf[d0], p0, 0, 0, 0);
                p1 = __builtin_amdgcn_mfma_f32_32x32x16_bf16(k1, qf[d0], p1, 0, 0, 0);
            }
            if (win_q0 >= 0 && t < nt0) {
                const int qw0 = win_q0 + wid * 32;
                const int bb = key0 + 8 * hi - (win_q0 + qrow);
                if (key0 < qw0 + 31 - 128) {
#pragma unroll
                    for (int r = 0; r < 16; ++r) { const int c = 16 * (r >> 3) + (r & 7); if (bb < -128 - c) p0[r] = -INFINITY; if (bb < -160 - c) p1[r] = -INFINITY; }
                }
                if (key0 + 63 > qw0 + 128) {
#pragma unroll
                    for (int r = 0; r < 16; ++r) { const int c = 16 * (r >> 3) + (r & 7); if (bb > 128 - c) p0[r] = -INFINITY; if (bb > 96 - c) p1[r] = -INFINITY; }
                }
            }
            float mx = __builtin_fmaxf(__builtin_fmaxf(p0[0], p1[0]), __builtin_fmaxf(p0[1], p1[1]));
#pragma unroll
            for (int r = 2; r < 16; r += 2) mx = __builtin_fmaxf(__builtin_fmaxf(mx, p0[r]), __builtin_fmaxf(p1[r], __builtin_fmaxf(p0[r + 1], p1[r + 1])));
            mx = __builtin_fmaxf(mx, __shfl_xor(mx, 32));
            if (__any(mx > 8.0f)) {
                const float dl = mx > 8.0f ? mx : 0.f;
                const float f = __builtin_amdgcn_exp2f(-dl);
                mrun += dl;
                p0 = p0 - dl; p1 = p1 - dl; negm = negm - dl;
#pragma unroll
                for (int r = 0; r < 16; ++r) { o0[r] *= f; o1[r] *= f; lacc[r] *= f; }
            }
#pragma unroll
            for (int r = 0; r < 16; ++r) { p0[r] = __builtin_amdgcn_exp2f(p0[r]); p1[r] = __builtin_amdgcn_exp2f(p1[r]); }
            bf16x8 pw[4];
#pragma unroll
            for (int ks = 0; ks < 4; ++ks) {
                u32x4 w;
                if (ks < 2) { w.x = cvt_pk_bf16(p0[8 * ks + 0], p0[8 * ks + 1]); w.y = cvt_pk_bf16(p0[8 * ks + 2], p0[8 * ks + 3]); w.z = cvt_pk_bf16(p0[8 * ks + 4], p0[8 * ks + 5]); w.w = cvt_pk_bf16(p0[8 * ks + 6], p0[8 * ks + 7]); }
                else { const int k2 = ks - 2; w.x = cvt_pk_bf16(p1[8 * k2 + 0], p1[8 * k2 + 1]); w.y = cvt_pk_bf16(p1[8 * k2 + 2], p1[8 * k2 + 3]); w.z = cvt_pk_bf16(p1[8 * k2 + 4], p1[8 * k2 + 5]); w.w = cvt_pk_bf16(p1[8 * k2 + 6], p1[8 * k2 + 7]); }
                pw[ks] = __builtin_bit_cast(bf16x8, w);
            }
#pragma unroll
            for (int ks = 0; ks < 4; ++ks) {
                const bf16x8 va = *(const LAS bf16x8*)(sb + (voff ^ (ks << 5)));
                const bf16x8 vbb = *(const LAS bf16x8*)(sb + (voff ^ (ks << 5)) + 32 * 128);
                o0 = __builtin_amdgcn_mfma_f32_32x32x16_bf16(va, pw[ks], o0, 0, 0, 0);
                o1 = __builtin_amdgcn_mfma_f32_32x32x16_bf16(vbb, pw[ks], o1, 0, 0, 0);
                lacc = __builtin_amdgcn_mfma_f32_32x32x16_bf16(ones, pw[ks], lacc, 0, 0, 0);
            }
        }
    }
    const float inv = 1.0f / lacc[0];
    bf16_t* orow = O + (size_t)qrow * ostride;
#pragma unroll
    for (int r4 = 0; r4 < 4; ++r4) {
        u32x2 w0, w1;
        w0.x = cvt_pk_bf16(o0[4 * r4 + 0] * inv, o0[4 * r4 + 1] * inv); w0.y = cvt_pk_bf16(o0[4 * r4 + 2] * inv, o0[4 * r4 + 3] * inv);
        w1.x = cvt_pk_bf16(o1[4 * r4 + 0] * inv, o1[4 * r4 + 1] * inv); w1.y = cvt_pk_bf16(o1[4 * r4 + 2] * inv, o1[4 * r4 + 3] * inv);
        *(u32x2*)(orow + 8 * r4 + 4 * hi) = w0;
        *(u32x2*)(orow + 32 + 8 * r4 + 4 * hi) = w1;
    }
    asm volatile("s_waitcnt vmcnt(0) lgkmcnt(0)" ::: "memory"); __builtin_amdgcn_s_barrier(); asm volatile("" ::: "memory");
}

__device__ __forceinline__ void spatial_unit(LAS unsigned char* lds, int chunk, int g, const float* w_s, const float* b_s, const float* v_gain, const float* ssv, const bf16_t* VbT, bf16_t* MIX, const int tid) {
    const int lane = tid & 63, r32 = lane & 31, hi = lane >> 5, wid = __builtin_amdgcn_readfirstlane(tid >> 6);
    const int pblk = wid & 3, chalf = wid >> 2;
    const int p = 32 * pblk + r32;
    bf16x8 yf[8];
#pragma unroll
    for (int ks = 0; ks < 8; ++ks) {
        const int q = 16 * ks + 8 * hi;
        const f32x4 w0 = *(const f32x4*)(w_s + ((size_t)g * 128 + p) * 128 + q), w1 = *(const f32x4*)(w_s + ((size_t)g * 128 + p) * 128 + q + 4);
        const f32x4 s0 = *(const f32x4*)(ssv + chunk * 128 + q), s1 = *(const f32x4*)(ssv + chunk * 128 + q + 4);
        f32x4 a, b;
#pragma unroll
        for (int i = 0; i < 4; ++i) { a[i] = w0[i] * __builtin_amdgcn_rsqf(s0[i] * (1.0f / 512.0f) + EPS); b[i] = w1[i] * __builtin_amdgcn_rsqf(s1[i] * (1.0f / 512.0f) + EPS); }
        yf[ks] = __builtin_bit_cast(bf16x8, pack8(a, b));
    }
    const float bs = b_s[g * 128 + p];
    LAS float* stg = (LAS float*)(lds + wid * 8704);
#pragma unroll
    for (int cbk = 0; cbk < 2; ++cbk) {
        const int cblk = 2 * chalf + cbk;
        const bf16_t* xr = VbT + ((size_t)chunk * 512 + 128 * g + 32 * cblk + r32) * 128 + 8 * hi;
        f32x16 acc = {};
#pragma unroll
        for (int ks = 0; ks < 8; ++ks) { const bf16x8 xf = *(const bf16x8*)(xr + 16 * ks); acc = __builtin_amdgcn_mfma_f32_32x32x16_bf16(xf, yf[ks], acc, 0, 0, 0); }
#pragma unroll
        for (int r4 = 0; r4 < 4; ++r4) {
            const int c4 = 32 * cbk + 8 * r4 + 4 * hi;
            const f32x4 gn = *(const f32x4*)(v_gain + 128 * g + 64 * chalf + c4);
            *(LAS f32x4*)(stg + r32 * 68 + c4) = (f32x4){gn[0] * acc[4 * r4 + 0] + bs, gn[1] * acc[4 * r4 + 1] + bs, gn[2] * acc[4 * r4 + 2] + bs, gn[3] * acc[4 * r4 + 3] + bs};
        }
    }
    asm volatile("s_waitcnt lgkmcnt(0)" ::: "memory");
#pragma unroll
    for (int i = 0; i < 4; ++i) {
        const int prow = i * 8 + (lane >> 3), ch8 = (lane & 7) * 8;
        const f32x4 m0 = *(const LAS f32x4*)(stg + prow * 68 + ch8), m1 = *(const LAS f32x4*)(stg + prow * 68 + ch8 + 4);
        bf16_t* up = MIX + (size_t)(chunk * 128 + 32 * pblk + prow) * DM + 512 + 128 * g + 64 * chalf + ch8;
        const u32x4 uu = *(const u32x4*)up;
        f32x4 a, b;
        a[0] = __uint_as_float(uu.x << 16) * m0[0]; a[1] = __uint_as_float(uu.x & 0xffff0000u) * m0[1]; a[2] = __uint_as_float(uu.y << 16) * m0[2]; a[3] = __uint_as_float(uu.y & 0xffff0000u) * m0[3];
        b[0] = __uint_as_float(uu.z << 16) * m1[0]; b[1] = __uint_as_float(uu.z & 0xffff0000u) * m1[1]; b[2] = __uint_as_float(uu.w << 16) * m1[2]; b[3] = __uint_as_float(uu.w & 0xffff0000u) * m1[3];
        *(u32x4*)up = pack8(a, b);
    }
    asm volatile("s_waitcnt lgkmcnt(0)" ::: "memory"); __builtin_amdgcn_s_barrier(); asm volatile("" ::: "memory");
}

__device__ __forceinline__ unsigned f2bf(float f) { unsigned u = __builtin_bit_cast(unsigned, f); return (u + 0x7fffu + ((u >> 16) & 1u)) >> 16; }
__device__ __forceinline__ unsigned pk2(float lo, float hi) { return f2bf(lo) | (f2bf(hi) << 16); }
__device__ __forceinline__ float wave_sum(float v) {
#pragma unroll
    for (int o = 1; o < 64; o <<= 1) v += __shfl_xor(v, o);
    return v;
}
__device__ __forceinline__ void transpose_item(const float* W, int K, int N, bf16_t* WT, int k0, int n0, int drow, LAS float* scr, int lane) {
    float tv[32];
#pragma unroll
    for (int i = 0; i < 32; ++i) tv[i] = W[(size_t)(k0 + 2 * i + (lane >> 5)) * N + n0 + (lane & 31)];
#pragma unroll
    for (int i = 0; i < 32; ++i) scr[(2 * i + (lane >> 5)) * 33 + (lane & 31)] = tv[i];
    asm volatile("s_waitcnt lgkmcnt(0)" ::: "memory");
    const int c = lane & 7;
#pragma unroll
    for (int j = 0; j < 4; ++j) { const int n = (lane >> 3) + 8 * j; const LAS float* s = scr + (8 * c) * 33 + n;
        u32x4 o; o.x = pk2(s[0 * 33], s[1 * 33]); o.y = pk2(s[2 * 33], s[3 * 33]); o.z = pk2(s[4 * 33], s[5 * 33]); o.w = pk2(s[6 * 33], s[7 * 33]);
        *(u32x4*)(WT + (size_t)(drow + n) * K + k0 + 8 * c) = o; }
    asm volatile("s_waitcnt lgkmcnt(0)" ::: "memory");
}
__device__ __forceinline__ int perm_in(int n0) { const int pn = n0 >> 8, rem = n0 & 255; return pn * 256 + ((rem & 63) >> 5) * 128 + (rem >> 6) * 32; }
__device__ __forceinline__ int perm_up(int n0) { const int half = n0 / FF, ch = n0 % FF; return (ch >> 7) * 256 + half * 128 + (ch & 127); }


#define XB_TMO      128
#define XB_XCNT(j)  (256  + 64 * (j))
#define XB_XSUB(j)  (1280 + 64 * (j))
#define XB_XGEN(j)  (2304 + 64 * (j))
#define XB_TOP      3328
#define XB_TOPGEN   3392
#define XCD_BAR_WORDS 3456
#define XB_SPIN_CAP (1u << 18)
__device__ __forceinline__ unsigned xb_ld(unsigned* p)              { return __hip_atomic_load(p, __ATOMIC_RELAXED, __HIP_MEMORY_SCOPE_AGENT); }
__device__ __forceinline__ unsigned xb_add(unsigned* p, unsigned v) { return __hip_atomic_fetch_add(p, v, __ATOMIC_RELAXED, __HIP_MEMORY_SCOPE_AGENT); }
__device__ __forceinline__ unsigned xb_xcc_id() { return (unsigned)__builtin_amdgcn_s_getreg((3 << 11) | 20) & 0xFu; }
#define XB_SPIN(cond, bar) do { unsigned _sp = 0; while (cond) { __builtin_amdgcn_s_sleep(1); \
    if ((++_sp & 255u) == 0u) { if (xb_ld(&(bar)[XB_TMO])) break; if (_sp > XB_SPIN_CAP) { atomicAdd(&(bar)[XB_TMO], 1u); break; } } } } while (0)
struct XcdBarrier { unsigned* bar; unsigned x; volatile LAS unsigned* st; };
__device__ __forceinline__ XcdBarrier xcd_barrier_post(unsigned* bar, volatile LAS unsigned* st) {
    XcdBarrier b; b.bar = bar; b.x = xb_xcc_id(); b.st = st;
    if (threadIdx.x == 0) (void)xb_add(&bar[XB_XCNT(b.x)], 1u);
    return b;
}
__device__ __forceinline__ void xcd_barrier_complete(unsigned* bar, unsigned x, unsigned& nloc, unsigned& nx) {
    const unsigned G = gridDim.x * gridDim.y * gridDim.z;
    unsigned sum, cnt, mine, sp = 0u;
    for (;;) {
        sum = 0u; cnt = 0u; mine = 0u;
#pragma unroll
        for (unsigned j = 0; j < 16; ++j) { const unsigned c = xb_ld(&bar[XB_XCNT(j)]); sum += c; cnt += (c > 0u) ? 1u : 0u; mine = (j == x) ? c : mine; }
        if (sum == G) break;
        __builtin_amdgcn_s_sleep(1);
        if ((++sp & 255u) == 0u) { if (xb_ld(&bar[XB_TMO])) break; if (sp > XB_SPIN_CAP) { atomicAdd(&bar[XB_TMO], 1u); break; } }
    }
    nloc = mine > 0u ? mine : 1u; nx = cnt > 0u ? cnt : 1u;
}
__device__ __forceinline__ void xcd_barrier(const XcdBarrier& b) {
    asm volatile("s_waitcnt vmcnt(0)" ::: "memory");
    __syncthreads();
    if (threadIdx.x == 0) {
        unsigned* bar = b.bar;
        __builtin_amdgcn_s_waitcnt(0);
        unsigned nloc = b.st[0], nx = b.st[1];
        if (nloc == 0u) { xcd_barrier_complete(bar, b.x, nloc, nx); b.st[0] = nloc; b.st[1] = nx; }
        const unsigned old = xb_add(&bar[XB_XSUB(b.x)], 1u);
        const unsigned gen = old / nloc;
        if (old + 1u == (gen + 1u) * nloc) {
            __builtin_amdgcn_fence(__ATOMIC_RELEASE, "agent");
            asm volatile("s_waitcnt vmcnt(0)" ::: "memory");
            const unsigned og = xb_add(&bar[XB_TOP], 1u);
            const unsigned tg = og / nx;
            if (og + 1u == (tg + 1u) * nx) xb_add(&bar[XB_TOPGEN], 1u);
            else XB_SPIN(xb_ld(&bar[XB_TOPGEN]) == tg, bar);
            __builtin_amdgcn_fence(__ATOMIC_ACQUIRE, "agent");
            xb_add(&bar[XB_XGEN(b.x)], 1u);
            asm volatile("s_waitcnt vmcnt(0)" ::: "memory");
        } else {
            XB_SPIN(xb_ld(&bar[XB_XGEN(b.x)]) == gen, bar);
            __builtin_amdgcn_fence(__ATOMIC_ACQUIRE, "agent");
            asm volatile("s_waitcnt vmcnt(0)" ::: "memory");
        }
    }
    __syncthreads();
}

template <bool COOP>
__global__ void __launch_bounds__(512, 2) mk_fwd(Params P) {
    extern __shared__ __attribute__((aligned(16))) unsigned char lds_raw[];
    LAS unsigned char* lds = (LAS unsigned char*)lds_raw;
    const int tid = threadIdx.x, lane = tid & 63, wave = __builtin_amdgcn_readfirstlane(tid >> 6);
    const int G = gridDim.x, bx = blockIdx.x;
    const int gw = bx * 8 + wave, NGW = G * 8;
    unsigned char* ws = P.ws;
    float* out = P.out;
    typedef const float* cfp_t; typedef __attribute__((address_space(4))) const cfp_t* kargp_t;
#define INP(i) ({ kargp_t kp_ = (kargp_t)__builtin_amdgcn_kernarg_segment_ptr(); asm volatile("" : "+s"(kp_)); kp_[i]; })
#define out_ka (out + (size_t)MTOK * DM)
#define out_va (out + (size_t)MTOK * DM + NCTX * 128)
#define out_kc (out + (size_t)MTOK * DM + NCTX * 256)
#define out_vc (out + (size_t)MTOK * DM + NCTX * 512)
#define mod ((float*)(ws + WS_MOD))
#define ss0 ((float*)(ws + WS_SS0))
#define ss1 ((float*)(ws + WS_SS1))
#define ss2 ((float*)(ws + WS_SS2))
#define ss3 ((float*)(ws + WS_SS3))
#define ssv ((float*)(ws + WS_SSV))
#define rope ((float*)(ws + WS_ROPE))
#define biasw ((float*)(ws + WS_BIAS))
#define ZB ((float*)(ws + WS_ZB))
#define CK_A ((bf16_t*)(ws + WS_CK_A))
#define CVT_A ((bf16_t*)(ws + WS_CVT_A))
#define CK_C ((bf16_t*)(ws + WS_CK_C))
#define CVT_C ((bf16_t*)(ws + WS_CVT_C))
#define W_INE ((bf16_t*)(ws + WS_W_INE))
#define W_OUTE ((bf16_t*)(ws + WS_W_OUTE))
#define W_INO ((bf16_t*)(ws + WS_W_INO))
#define W_OUTO ((bf16_t*)(ws + WS_W_OUTO))
#define W_UP ((bf16_t*)(ws + WS_W_UP))
#define W_DN ((bf16_t*)(ws + WS_W_DN))
#define Abuf ((bf16_t*)(ws + WS_A))
#define ACT ((bf16_t*)(ws + WS_ACT))
#define MIX ((bf16_t*)(ws + WS_MIX))
#define Qb ((bf16_t*)(ws + WS_Q))
#define KE ((bf16_t*)(ws + WS_KE))
#define VTE ((bf16_t*)(ws + WS_VTE))
#define VBT ((bf16_t*)(ws + WS_VBT))
#define KO ((bf16_t*)(ws + WS_KO))
#define VTO ((bf16_t*)(ws + WS_VTO))
    LAS float* spare = (LAS float*)(lds + LDS_SPARE);

    const int lo = P.ph_lo, hi = P.ph_hi;
#define TSTAMP(k) do { if (MK_TP_LO >= 0 && blockIdx.x == 0 && threadIdx.x == 0) { if ((k) == MK_TP_LO) ((unsigned long long*)(P.ws + WS_TS))[0] = __builtin_amdgcn_s_memrealtime(); if ((k) == MK_TP_HI + 1) ((unsigned long long*)(P.ws + WS_TS))[1] = __builtin_amdgcn_s_memrealtime(); } } while (0)
    XcdBarrier xbar; xbar.bar = (unsigned*)(ws + WS_BAR); xbar.x = 0; xbar.st = (volatile LAS unsigned*)(lds + LDS_SPARE + 12288);
    if constexpr (COOP) {
        if (tid < 2) ((LAS unsigned*)(lds + LDS_SPARE + 12288))[tid] = 0u;
        __syncthreads();
        xbar = xcd_barrier_post((unsigned*)(ws + WS_BAR), (volatile LAS unsigned*)(lds + LDS_SPARE + 12288));
        if (P.ph_lo < 0) cg::this_grid().sync();
    }
#ifndef MK_PHMASK
#define MK_PHMASK 0x7fff
#endif
#define IN(k) ((((MK_PHMASK) >> (k)) & 1) && lo <= (k) && (k) < hi)
#define SEAM(k) do { if constexpr (COOP) { if (IN(k) && IN((k) + 1)) { xcd_barrier(xbar); } } } while (0)

    if constexpr (!COOP) { TSTAMP(lo); }
    if (IN(0)) {
        const float* c_in = INP(6); const float* c_ctx = INP(7); const float* w_mod = INP(8); const float* b_mod = INP(9);
        for (int it = bx; it < 2 * 24 * 16; it += G) {
            const int l = it / 384, cbk = (it % 384) / 16, ksp = it % 16;
            __syncthreads();
            for (int i = tid; i < NCOND * 64; i += 512) { const int cd = i >> 6, k = ksp * 64 + (i & 63); const float v = cd == 0 ? c_ctx[k] : c_in[(cd - 1) * DM + k]; spare[i] = v / (1.0f + __expf(-v)); }
            __syncthreads();
            const int col = cbk * 256 + (tid & 255), kh = tid >> 8;
            float a[NCOND];
#pragma unroll
            for (int cd = 0; cd < NCOND; ++cd) a[cd] = 0.f;
            const float* wp = w_mod + ((size_t)l * DM + ksp * 64 + kh * 32) * MODW + col;
#pragma unroll 1
            for (int k0 = 0; k0 < 32; k0 += 8) {
                float wv[8];
#pragma unroll
                for (int k = 0; k < 8; ++k) wv[k] = wp[(size_t)(k0 + k) * MODW];
#pragma unroll
                for (int k = 0; k < 8; ++k) {
#pragma unroll
                    for (int cd = 0; cd < NCOND; ++cd) a[cd] += spare[cd * 64 + kh * 32 + k0 + k] * wv[k]; }
            }
            const float bm = (ksp == 0 && kh == 0) ? b_mod[l * MODW + col] : 0.f;
#pragma unroll
            for (int cd = 0; cd < NCOND; ++cd) atomicAdd(mod + ((size_t)l * NCOND + cd) * MODW + col, a[cd] + bm);
        }
        __syncthreads();
        {
            const float* w_in_even = INP(10); const float* w_out_even = INP(16); const float* w_in_odd = INP(17); const float* w_out_odd = INP(21); const float* w_up = INP(22); const float* w_down = INP(25);
            LAS float* scr = (LAS float*)(lds + wave * 16384);
            constexpr int I_INE = 16 * 56, I_OUT = 16 * 32, I_INO = 16 * 48, I_UP = 16 * 176, I_DN = 44 * 32;
            constexpr int NIT = I_INE + 2 * I_OUT + I_INO + 2 * I_UP + 2 * I_DN;
            for (int it = gw; it < NIT; it += NGW) {
                int r = it;
                if (r < I_INE) { const int kb = r / 56, nb = r % 56; transpose_item(w_in_even, DM, EVEN_IN, W_INE, 64 * kb, 32 * nb, perm_in(32 * nb), scr, lane); continue; } r -= I_INE;
                if (r < I_OUT) { const int kb = r / 32, nb = r % 32; transpose_item(w_out_even, DM, DM, W_OUTE, 64 * kb, 32 * nb, 32 * nb, scr, lane); continue; } r -= I_OUT;
                if (r < I_INO) { const int kb = r / 48, nb = r % 48; transpose_item(w_in_odd, DM, ODD_IN, W_INO, 64 * kb, 32 * nb, perm_in(32 * nb), scr, lane); continue; } r -= I_INO;
                if (r < I_OUT) { const int kb = r / 32, nb = r % 32; transpose_item(w_out_odd, DM, DM, W_OUTO, 64 * kb, 32 * nb, 32 * nb, scr, lane); continue; } r -= I_OUT;
                if (r < 2 * I_UP) { const int l = r / I_UP, q = r % I_UP, kb = q / 176, nb = q % 176; transpose_item(w_up + (size_t)l * DM * FF2, DM, FF2, W_UP + (size_t)l * FF2 * DM, 64 * kb, 32 * nb, perm_up(32 * nb), scr, lane); continue; } r -= 2 * I_UP;
                { const int l = r / I_DN, q = r % I_DN, kb = q / 32, nb = q % 32; transpose_item(w_down + (size_t)l * FF * DM, FF, DM, W_DN + (size_t)l * DM * FF, 64 * kb, 32 * nb, 32 * nb, scr, lane); }
            }
        }
        {
            const float* cache_k_attn = INP(2); const float* cache_v_attn = INP(3); const float* cache_k_swa = INP(4); const float* cache_v_swa = INP(5);
            const int gt = bx * 512 + tid, NT_ = G * 512;
            for (int i = gt; i < 8 * 512 * 128 / 4; i += NT_) { const f32x4 v = *(const f32x4*)(cache_k_attn + (size_t)i * 4); *(u32x2*)(CK_A + (size_t)i * 4) = (u32x2){pk2(v[0], v[1]), pk2(v[2], v[3])}; }
            for (int i = gt; i < 8 * 512 * 256 / 4; i += NT_) { const f32x4 v = *(const f32x4*)(cache_k_swa + (size_t)i * 4); *(u32x2*)(CK_C + (size_t)i * 4) = (u32x2){pk2(v[0], v[1]), pk2(v[2], v[3])}; }
            for (int i = gt; i < 8 * 64 * 128; i += NT_) { const int cd = i & 127, pc = (i >> 7) & 63, b = i >> 13; const float* s = cache_v_attn + ((size_t)b * 512 + pc * 8) * 128 + cd;
                u32x4 o; o.x = pk2(s[0], s[128]); o.y = pk2(s[256], s[384]); o.z = pk2(s[512], s[640]); o.w = pk2(s[768], s[896]);
                *(u32x4*)(CVT_A + ((size_t)b * 128 + cd) * 512 + pc * 8) = o; }
            for (int i = gt; i < 8 * 64 * 256; i += NT_) { const int cd = i & 255, pc = (i >> 8) & 63, b = i >> 14; const float* s = cache_v_swa + ((size_t)b * 512 + pc * 8) * 256 + cd;
                u32x4 o; o.x = pk2(s[0], s[256]); o.y = pk2(s[512], s[768]); o.z = pk2(s[1024], s[1280]); o.w = pk2(s[1536], s[1792]);
                *(u32x4*)(CVT_C + ((size_t)b * 256 + cd) * 512 + pc * 8) = o; }
            if (gt < 1024) { const int pos = gt >> 4, f = gt & 15; const float inv = exp2f(-(float)f * (13.287712379549449f / 16.0f)); const float ang = (float)pos * inv;
                rope[gt * 2] = cosf(ang); rope[gt * 2 + 1] = sinf(ang); }
        }
    }
    SEAM(0);
    if (IN(1)) {
        const float* x_prompt = INP(0); const float* x_sample = INP(1);
        for (int row0 = gw; row0 < MTOK; row0 += 2 * NGW) {
            f32x4 v[2][4], s4v[2][4]; float sq[2];
#pragma unroll
            for (int u = 0; u < 2; ++u) {
                const int row = row0 + u * NGW; sq[u] = 0.f;
                if (row < MTOK) {
                    const float* xr = row < NCTX ? x_prompt + (size_t)row * DM : x_sample + (size_t)(row - NCTX) * DM;
                    const float* sc = mod + (size_t)(row < NCTX ? 0 : 1 + ((row - NCTX) >> 11)) * MODW + 1024;
#pragma unroll
                    for (int j = 0; j < 4; ++j) { v[u][j] = *(const f32x4*)(xr + 256 * j + 4 * lane); s4v[u][j] = *(const f32x4*)(sc + 256 * j + 4 * lane); }
                }
            }
#pragma unroll
            for (int u = 0; u < 2; ++u) {
                if (row0 + u * NGW < MTOK) {
#pragma unroll
                    for (int j = 0; j < 4; ++j) sq[u] += (v[u][j][0] * v[u][j][0] + v[u][j][1] * v[u][j][1]) + (v[u][j][2] * v[u][j][2] + v[u][j][3] * v[u][j][3]);
                }
            }
#pragma unroll
            for (int o = 1; o < 64; o <<= 1) { sq[0] += __shfl_xor(sq[0], o); sq[1] += __shfl_xor(sq[1], o); }
#pragma unroll
            for (int u = 0; u < 2; ++u) {
                const int row = row0 + u * NGW;
                if (row < MTOK) {
                    if (lane == 0) ss0[row] = sq[u];
#pragma unroll
                    for (int j = 0; j < 4; ++j) { const f32x4 h = v[u][j] * (s4v[u][j] + 1.0f);
                        *(u32x2*)(Abuf + (size_t)row * DM + 256 * j + 4 * lane) = (u32x2){cvt_pk_bf16(h[0], h[1]), cvt_pk_bf16(h[2], h[3])}; }
                }
            }
        }
        constexpr int NB0 = 1792 / 16, NB1 = 5632 / 16, NB2 = 1536 / 16, NBT = NB0 + 2 * NB1 + NB2;
        for (int it = gw; it < NCOND * NBT; it += NGW) {
            const int cond = it / NBT; int r = it % NBT;
            const bf16_t* Wt; const float* sh; float* dst; int N;
            if (r < NB0) { Wt = W_INE; sh = mod + (size_t)cond * MODW; dst = biasw + BIAS_INE; N = 1792; }
            else if ((r -= NB0) < NB1) { Wt = W_UP; sh = mod + (size_t)cond * MODW + 3072; dst = biasw + BIAS_UP0; N = 5632; }
            else if ((r -= NB1) < NB2) { Wt = W_INO; sh = mod + (size_t)(NCOND + cond) * MODW; dst = biasw + BIAS_INO; N = 1536; }
            else { r -= NB2; Wt = W_UP + (size_t)FF2 * DM; sh = mod + (size_t)(NCOND + cond) * MODW + 3072; dst = biasw + BIAS_UP1; N = 5632; }
            float sv[16];
#pragma unroll
            for (int j = 0; j < 4; ++j) { const f32x4 t4 = *(const f32x4*)(sh + 16 * lane + 4 * j); sv[4 * j] = t4[0]; sv[4 * j + 1] = t4[1]; sv[4 * j + 2] = t4[2]; sv[4 * j + 3] = t4[3]; }
            { const int n = 0;
                float d[16];
#pragma unroll
                for (int q = 0; q < 16; ++q) {
                    const bf16_t* wr_ = Wt + (size_t)(r * 16 + n + q) * DM + 16 * lane;
                    const u32x4 w0 = *(const u32x4*)wr_, w1 = *(const u32x4*)(wr_ + 8);
                    float dd = 0.f;
#pragma unroll
                    for (int j = 0; j < 4; ++j) { dd += sv[2 * j] * __uint_as_float(w0[j] << 16) + sv[2 * j + 1] * __uint_as_float(w0[j] & 0xffff0000u); dd += sv[8 + 2 * j] * __uint_as_float(w1[j] << 16) + sv[8 + 2 * j + 1] * __uint_as_float(w1[j] & 0xffff0000u); }
                    d[q] = dd;
                }
#pragma unroll
                for (int o = 1; o < 64; o <<= 1) {
#pragma unroll
                    for (int q = 0; q < 16; ++q) d[q] += __shfl_xor(d[q], o);
                }
                if (lane == 0) {
#pragma unroll
                    for (int q = 0; q < 16; ++q) dst[(size_t)cond * N + r * 16 + n + q] = d[q];
                }
            }
        }
    }
    SEAM(1);
    pg8::StaticOrder S;
    for (int ph = (lo > 2 ? lo : 2); ph < hi; ++ph) {
        if (((MK_PHMASK >> ph) & 1) != 0) {
#pragma unroll 1
        for (int slot_ = 0; slot_ < 3; ++slot_) {
            const int slot = ((ph == 4 || ph == 10) && (bx & 1) && slot_ < 2) ? 1 - slot_ : slot_;
            int st = -1, pm0 = 32, nM = 64, c0 = 0, nc = G;
            const bool g256 = (G == 256);
            switch (ph * 4 + slot) {
                case 2 * 4 + 0: st = 0; break;
                case 2 * 4 + 1: st = 0; pm0 = 0; nM = 9; if (g256) { c0 = 192; nc = 64; } break;
                case 3 * 4 + 0: st = 1; break;
                case 3 * 4 + 1: st = 0; pm0 = 9; nM = 23; if (g256) nc = 168; break;
                case 4 * 4 + 0: st = 2; break;
                case 4 * 4 + 1: st = 1; pm0 = 0; nM = 32; break;
                case 5 * 4 + 0: st = 3; break;
                case 5 * 4 + 1: st = 2; pm0 = 0; nM = 32; if (g256) { c0 = 128; nc = 128; } break;
                case 6 * 4 + 0: st = 4; break;
                case 7 * 4 + 0: st = 5; break;
                case 7 * 4 + 1: st = 3; pm0 = 0; nM = 32; break;
                case 8 * 4 + 0: st = 6; if (g256) { c0 = 128; nc = 128; } break;
                case 8 * 4 + 1: st = 5; pm0 = 0; nM = 32; if (g256) nc = 128; break;
                case 9 * 4 + 0: st = 7; break;
                case 9 * 4 + 1: st = 6; pm0 = 0; nM = 32; if (g256) nc = 192; break;
                case 10 * 4 + 0: st = 8; break;
                case 10 * 4 + 1: st = 7; pm0 = 0; nM = 32; break;
                case 11 * 4 + 0: st = 9; break;
                case 11 * 4 + 1: st = 8; pm0 = 0; nM = 32; if (g256) { c0 = 128; nc = 128; } break;
                case 12 * 4 + 0: st = 10; break;
                case 13 * 4 + 0: st = 11; pm0 = 32; nM = 32; if (g256) { c0 = 128; nc = 128; } break;
                case 13 * 4 + 1: st = 9; pm0 = 0; nM = 23; if (g256) nc = 128; break;
                case 13 * 4 + 2: st = 9; pm0 = 23; nM = 9; if (g256) { c0 = 128; nc = 128; } break;
                case 14 * 4 + 0: st = 11; pm0 = 64; nM = 32; if (g256) { c0 = 128; nc = 128; } break;
                case 14 * 4 + 1: st = 11; pm0 = 0; nM = 32; if (g256) nc = 128; break;
                default: break;
            }
            const bool lat = pm0 >= 32;
            if (st < 0) continue;
            unsigned char* ws = P.ws; asm volatile("" : "+s"(ws));
            float* out = P.out; asm volatile("" : "+s"(out));
            int tid = threadIdx.x; asm volatile("" : "+v"(tid));
            LAS unsigned char* lds = (LAS unsigned char*)lds_raw; { unsigned l_ = (unsigned)(uintptr_t)lds; asm volatile("" : "+s"(l_)); lds = (LAS unsigned char*)(uintptr_t)l_; }
            LAS float* spare = (LAS float*)(lds + LDS_SPARE);
            const int rel = (bx - c0 + G) % G;
            const int L = st >= 6 ? 1 : 0;
            float* modL = mod + (size_t)L * NCOND * MODW;
            if (st == 0) {
                pg8::Gemm g{Abuf, W_INE, MTOK, EVEN_IN, DM}; S.init(pm0, nM, EVEN_IN, G, bx, c0, nc);
                EpiIn<true> E{ws, out, INP(11), INP(12)};
                pg8::gemm_phase<EpiIn<true>, true>(lds, g, S, E, tid);
            } else if (st == 6) {
                pg8::Gemm g{Abuf, W_INO, MTOK, ODD_IN, DM}; S.init(pm0, nM, ODD_IN, G, bx, c0, nc);
                EpiIn<false> E{ws, out, INP(18), INP(19)};
                pg8::gemm_phase<EpiIn<false>, true>(lds, g, S, E, tid);
            } else if (st == 2 || st == 5 || st == 8 || st == 11) {
                const bool dn = (st == 5 || st == 11);
                pg8::Gemm g{dn ? ACT : MIX, dn ? W_DN + (size_t)L * DM * FF : (L ? W_OUTO : W_OUTE), MTOK, DM, dn ? FF : DM}; S.init(pm0, nM, DM, G, bx, c0, nc);
                EpiRes E;
                if (st == 2) { E.xp = INP(0); E.xs = INP(1); } else { E.xp = out; E.xs = out + (size_t)NCTX * DM; }
                E.out = out; E.gate = modL + (dn ? 5120 : 2048);
                E.nscale = st == 11 ? nullptr : (dn ? mod + (size_t)NCOND * MODW + 1024 : modL + 4096);
                E.An = st == 11 ? nullptr : Abuf;
                E.ssn = st == 2 ? ss1 : st == 5 ? ss2 : st == 8 ? ss3 : nullptr;
                pg8::gemm_phase<EpiRes, true>(lds, g, S, E, tid);
            } else if (st == 3 || st == 9) {
                pg8::Gemm g{Abuf, W_UP + (size_t)L * FF2 * DM, MTOK, FF2, DM}; S.init(pm0, nM, FF2, G, bx, c0, nc);
                EpiUp E{ws, (unsigned)(L ? WS_SS3 : WS_SS1), (unsigned)(L ? BIAS_UP1 : BIAS_UP0), INP(23) + (size_t)L * 3 * FF2, INP(24) + (size_t)L * FF2, spare};
                pg8::gemm_phase<EpiUp, true>(lds, g, S, E, tid);
            } else if (st == 4 || st == 10) {
                if (lat) {
                    const float* cw = INP(23) + (size_t)L * 3 * FF2; const float* cb = INP(24) + (size_t)L * FF2;
                    for (int i = bx * 512 + tid; i < 8 * 7 * 2 * FF; i += G * 512) {
                        const int ch = i % FF, rs = i / FF, which = rs & 1, sm = (rs >> 1) % 7, b = rs / 14;
                        const int pmA = 32 + b * 8 + sm;
                        const int zc = (ch >> 7) * 256 + (ch & 127);
                        const float* zA = ZB + (size_t)pmA * 4 * FF2; const float* zB = ZB + (size_t)(pmA + 1) * 4 * FF2;
                        float ra, rg;
                        if (which == 0) {
                            ra = cb[ch] + cw[ch] * zA[2 * FF2 + zc] + cw[FF2 + ch] * zA[3 * FF2 + zc] + cw[2 * FF2 + ch] * zB[zc];
                            rg = cb[FF + ch] + cw[FF + ch] * zA[2 * FF2 + zc + 128] + cw[FF2 + FF + ch] * zA[3 * FF2 + zc + 128] + cw[2 * FF2 + FF + ch] * zB[zc + 128];
                        } else {
                            ra = cb[ch] + cw[ch] * zA[3 * FF2 + zc] + cw[FF2 + ch] * zB[zc] + cw[2 * FF2 + ch] * zB[FF2 + zc];
                            rg = cb[FF + ch] + cw[FF + ch] * zA[3 * FF2 + zc + 128] + cw[FF2 + FF + ch] * zB[zc + 128] + cw[2 * FF2 + FF + ch] * zB[FF2 + zc + 128];
                        }
                        const int row = pmA * 256 + 255 + which;
                        ACT[(size_t)row * FF + ch] = (bf16_t)(cvt_pk_bf16(ra * silu_f(rg), 0.f) & 0xffffu);
                    }
                }
            } else if (st == 1) {
                const float* w_spatial = INP(14); const float* b_spatial = INP(15); const float* v_norm_b = INP(13);
                if (lat) {
                    for (int it = rel; it < 512; it += nc) {
                        const int b = it >> 6, h = (it >> 3) & 7, qb = it & 7, kvh = h >> 2;
                        const size_t row0 = NCTX + (size_t)b * 2048 + qb * 256;
                        attn_unit(lds, Qb + row0 * 512 + h * 64, 512, MIX + row0 * DM + h * 64, DM,
                                  KE + ((size_t)NCTX + (size_t)b * 2048) * 128 + kvh * 64, 128, VTE + (size_t)NCTX * 128 + (size_t)(b * 2 + kvh) * 64 * 2048, 2048, 0, 32,
                                  CK_A + (size_t)b * 512 * 128 + kvh * 64, 128, CVT_A + (size_t)(b * 2 + kvh) * 64 * 512, 512, 8, 0.f, 0.f, -1, tid);
                    }
                    if (G == 256) {
                        if (bx >= 168) { for (int j = 0; j < 4; ++j) { const int e = (bx - 168) * 4 + j; spatial_unit(lds, 64 + (e >> 2), e & 3, w_spatial, b_spatial, v_norm_b, ssv, VBT, MIX, tid); } }
                        else if (bx < 160) { const int e = 352 + bx; spatial_unit(lds, 64 + (e >> 2), e & 3, w_spatial, b_spatial, v_norm_b, ssv, VBT, MIX, tid); }
                    } else {
                        for (int e = rel; e < 512; e += nc) spatial_unit(lds, 64 + (e >> 2), e & 3, w_spatial, b_spatial, v_norm_b, ssv, VBT, MIX, tid);
                    }
                } else {
                    for (int it = rel; it < 256 + 256; it += nc) {
                        if (it < 256) {
                            const int b = it >> 3, h = it & 7, kvh = h >> 2;
                            const size_t row0 = (size_t)b * 256;
                            attn_unit(lds, Qb + row0 * 512 + h * 64, 512, MIX + row0 * DM + h * 64, DM,
                                      KE + row0 * 128 + kvh * 64, 128, VTE + (size_t)(b * 2 + kvh) * 64 * 256, 256, 0, 4,
                                      nullptr, 0, nullptr, 0, 0, 0.f, 0.f, -1, tid);
                        } else { const int e = it - 256; spatial_unit(lds, e >> 2, e & 3, w_spatial, b_spatial, v_norm_b, ssv, VBT, MIX, tid); }
                    }
                }
            } else if (st == 7) {
                const float* sink_c = INP(20);
                if (lat) {
                    for (int it = rel; it < 1024; it += nc) {
                        const int b = it >> 7, h = (it >> 3) & 15, qb = it & 7, kvh = h >> 2;
                        const size_t row0 = NCTX + (size_t)b * 2048 + qb * 256;
                        const int q0 = qb * 256; int klo = q0 - 128; if (klo < 0) klo = 0; int khi = q0 + 384; if (khi > 2048) khi = 2048;
                        attn_unit(lds, Qb + row0 * 1024 + h * 64, 1024, MIX + row0 * DM + h * 64, DM,
                                  KO + ((size_t)NCTX + (size_t)b * 2048) * 256 + kvh * 64, 256, VTO + (size_t)NCTX * 256 + (size_t)(b * 4 + kvh) * 64 * 2048, 2048, klo >> 6, (khi - klo) >> 6,
                                  CK_C + (size_t)b * 512 * 256 + kvh * 64, 256, CVT_C + (size_t)(b * 4 + kvh) * 64 * 512, 512, 8, sink_c[h] * LOG2E, 1.0f, q0, tid);
                    }
                } else {
                    for (int it = rel; it < 512; it += nc) {
                        const int b = it >> 4, h = it & 15, kvh = h >> 2;
                        const size_t row0 = (size_t)b * 256;
                        attn_unit(lds, Qb + row0 * 1024 + h * 64, 1024, MIX + row0 * DM + h * 64, DM,
                                  KO + row0 * 256 + kvh * 64, 256, VTO + (size_t)(b * 4 + kvh) * 64 * 256, 256, 0, 4,
                                  nullptr, 0, nullptr, 0, 0, sink_c[h] * LOG2E, 1.0f, -1, tid);
                    }
                }
            }
        }
        }
        if constexpr (COOP) {
            if (ph + 1 < hi) { XcdBarrier xb = xbar; asm volatile("" : "+s"(xb.bar), "+s"(xb.x)); xcd_barrier(xb); }
        }
    }
    if (!COOP && MK_TP_LO >= 0 && lo == 14 && blockIdx.x == 0 && threadIdx.x == 0) {
        const unsigned long long* ts = (const unsigned long long*)(P.ws + WS_TS);
        float* o = P.out + (size_t)MTOK * DM;
        o[0] += (float)(ts[1] - ts[0]) * 1e-4f;
    }
#undef IN
#undef SEAM
}

constexpr int N_PHASES = 15;

extern "C" void kernel_launch(void* const* d_in, const int* in_sizes, int n_in, void* d_out, int out_size, void* d_ws, size_t ws_size, hipStream_t stream) {
    static int grid = 0;
    if (grid == 0) {
        int dev = 0, cus = 0;
        hipGetDevice(&dev);
        hipDeviceGetAttribute(&cus, hipDeviceAttributeMultiprocessorCount, dev);
        hipFuncSetAttribute((const void*)mk_fwd<true>, hipFuncAttributeMaxDynamicSharedMemorySize, LDS_BYTES);
        hipFuncSetAttribute((const void*)mk_fwd<false>, hipFuncAttributeMaxDynamicSharedMemorySize, LDS_BYTES);
        int per_cu = 0;
        hipOccupancyMaxActiveBlocksPerMultiprocessor(&per_cu, (const void*)mk_fwd<true>, 512, LDS_BYTES);
        (void)hipGetLastError();
        if (per_cu < 1) fprintf(stderr, "kernel_launch: occupancy query says %d blocks/CU\n", per_cu);
        grid = cus > 0 ? cus : 256;
        if (n_in != 26 || ws_size < WS_END) { fprintf(stderr, "kernel_launch: unexpected n_in %d / ws %zu\n", n_in, ws_size); }
    }
    hipMemsetAsync((char*)d_ws, 0, WS_ZERO_BYTES, stream);
    Params p{};
    for (int i = 0; i < 26; ++i) p.in[i] = (const float*)d_in[i];
    p.out = (float*)d_out; p.ws = (unsigned char*)d_ws;
#if MK_COOP
    p.ph_lo = 0; p.ph_hi = N_PHASES;
    void* args[] = {&p};
    hipError_t e = hipLaunchCooperativeKernel((const void*)mk_fwd<true>, dim3(grid), dim3(512), args, LDS_BYTES, stream);
    if (e != hipSuccess) fprintf(stderr, "cooperative launch failed: %s (grid %d)\n", hipGetErrorString(e), grid);
#else
    for (int ph = 0; ph < N_PHASES; ++ph) {
        p.ph_lo = ph; p.ph_hi = ph + 1;
        hipLaunchKernelGGL(mk_fwd<false>, dim3(grid), dim3(512), LDS_BYTES, stream, p);
        if (ph == MK_DUP) hipLaunchKernelGGL(mk_fwd<false>, dim3(grid), dim3(512), LDS_BYTES, stream, p);
    }
#endif
}
```

```cpp
#include <hip/hip_runtime.h>
#include <hip/hip_cooperative_groups.h>
#include <cstdio>
#include <cstdint>
namespace cg = cooperative_groups;

#ifndef MK_COOP
#define MK_COOP 1
#endif

#ifndef MK_DUP
#define MK_DUP -1
#endif
#ifndef MK_TP_LO
#define MK_TP_LO -1
#define MK_TP_HI -1
#endif
#define LAS __attribute__((address_space(3)))
typedef unsigned short bf16_t;
typedef short bf16x8 __attribute__((ext_vector_type(8)));
typedef short s16x4 __attribute__((ext_vector_type(4)));
typedef float f32x4 __attribute__((ext_vector_type(4)));
typedef float f32x2 __attribute__((ext_vector_type(2)));
typedef float f32x16 __attribute__((ext_vector_type(16)));
typedef unsigned u32x4 __attribute__((ext_vector_type(4)));
typedef unsigned u32x2 __attribute__((ext_vector_type(2)));

constexpr int DM = 1024, NCTX = 8192, NLAT = 16384, MTOK = 24576;
constexpr int EVEN_IN = 1792, ODD_IN = 1536, FF = 2816, FF2 = 5632;
constexpr int NCOND = 9, MODW = 6144;
constexpr float EPS = 1e-6f;
constexpr float LOG2E = 1.4426950408889634f;

constexpr size_t MiB = 1u << 20;
constexpr size_t WS_MOD = 0;
constexpr size_t WS_SS1 = 442368, WS_SS2 = WS_SS1 + 98304, WS_SS3 = WS_SS2 + 98304, WS_SSV = WS_SS3 + 98304;
constexpr size_t WS_BAR = 900 * 1024;
constexpr size_t WS_ZERO_BYTES = 1 * MiB;
constexpr size_t WS_SS0 = 1 * MiB;
constexpr size_t WS_ROPE = 1 * MiB + 128 * 1024;
constexpr size_t WS_TS = 1 * MiB + 192 * 1024;
constexpr size_t WS_BIAS = 1 * MiB + 256 * 1024;
constexpr size_t WS_ZB = 2 * MiB;
constexpr size_t WS_CK_A = 11 * MiB, WS_CVT_A = 12 * MiB, WS_CK_C = 13 * MiB, WS_CVT_C = 15 * MiB;
constexpr size_t WS_W_INE = 18 * MiB, WS_W_OUTE = 22 * MiB, WS_W_INO = 24 * MiB, WS_W_OUTO = 27 * MiB, WS_W_UP = 29 * MiB, WS_W_DN = 51 * MiB;
constexpr size_t WS_A = 62 * MiB;
constexpr size_t WS_BIG = 110 * MiB;
constexpr size_t WS_ACT = WS_BIG;
constexpr size_t WS_MIX = WS_BIG;
constexpr size_t WS_Q = WS_BIG + 48 * MiB;
constexpr size_t WS_KE = WS_Q + 24 * MiB, WS_VTE = WS_KE + 6 * MiB, WS_VBT = WS_VTE + 6 * MiB;
constexpr size_t WS_KO = WS_Q + 48 * MiB, WS_VTO = WS_KO + 12 * MiB;
constexpr size_t WS_END = 256 * MiB;
static_assert(WS_VBT + 24 * MiB <= WS_END && WS_VTO + 12 * MiB <= WS_END && WS_ACT + 132 * MiB <= WS_END, "ws map");
constexpr size_t BIAS_INE = 0, BIAS_UP0 = 9 * 1792, BIAS_INO = BIAS_UP0 + 9 * 5632, BIAS_UP1 = BIAS_INO + 9 * 1536;

constexpr int LDS_BYTES = 147456;
constexpr int LDS_SPARE = 131072;

struct Params {
    const float* in[26];
    float* out;
    unsigned char* ws;
    int ph_lo, ph_hi;
};

namespace pg8 {
constexpr int BM = 256, BK = 64, HALF = 128, HTB = HALF * BK * 2, STAGE_BYTES = 8 * HTB, NXCD = 8, WGM = 8;
__host__ __device__ __forceinline__ int lds_byte(int r, int c) { const int st = (r >> 4) * 2 + (c >> 5), rr = r & 15, cc = c & 31, ob = rr * 64 + cc * 2; return st * 1024 + (ob ^ (((ob >> 9) & 1) << 5)); }
__host__ __device__ __forceinline__ void stage_rc(int b, int& R, int& C) { const int st = b / 1024, sb = b % 1024, swz = sb ^ (((sb >> 9) & 1) << 5); R = (st >> 1) * 16 + swz / 64; C = (st & 1) * 32 + (swz % 64) / 2; }
__host__ __device__ __forceinline__ int perm32(int rho) { const int n = rho >> 4, i = rho & 15; return 8 * (i >> 2) + 4 * n + (i & 3); }
struct Unit { int pm, pn; };
struct Gemm { const bf16_t* A; const bf16_t* Bt; int M, N, K; };
struct StaticOrder {
    int nM, nN, nwg, nc, rel, pm0;
    __device__ __forceinline__ void init(int pm0_, int nM_, int N, int G, int c, int c0, int nc_) { pm0 = pm0_; nM = nM_; nN = N / BM; nwg = nM * nN; nc = nc_; rel = (c - c0 + G) % G; }
    __device__ __forceinline__ bool next(int i, Unit& u) const {
        if (rel >= nc) return false;
        const long L = (long)i * nc + rel; if (L >= nwg) return false;
        int wgid = (int)L; { const int q = nwg / NXCD, r = nwg % NXCD, xcd = wgid % NXCD, off = wgid / NXCD; wgid = (xcd < r ? xcd * (q + 1) : r * (q + 1) + (xcd - r) * q) + off; }
        const int nig = WGM * nN, gid = wgid / nig, fm = gid * WGM, gsz = (nM - fm) < WGM ? (nM - fm) : WGM;
        u.pm = pm0 + fm + ((wgid % nig) % gsz); u.pn = (wgid % nig) / gsz; return true;
    }
};
__device__ __forceinline__ unsigned cvt_pk_bf16(float lo, float hi) { unsigned r; asm volatile("v_cvt_pk_bf16_f32 %0, %1, %2" : "=v"(r) : "v"(lo), "v"(hi)); return r; }

template <class Epi, bool ALIGN_EPI>
__device__ __forceinline__ void gemm_phase(LAS unsigned char* lds, const Gemm g, const StaticOrder& S, const Epi& E, const int tid) {
    const int wid = __builtin_amdgcn_readfirstlane(tid >> 6), lane = tid & 63, wr = wid >> 2, wc = wid & 3, fr = lane & 15, fq = lane >> 4;
    const int K = g.K, nt = K / BK;
    unsigned voffA[2], voffB[2];
#pragma unroll
    for (int i = 0; i < 2; ++i) { int R, C; stage_rc(tid * 16 + i * 8192, R, C); const int Rb = (R & ~31) + perm32(R & 31);
        voffA[i] = (unsigned)(R * K + C) * 2u; voffB[i] = (unsigned)(Rb * K + C) * 2u; }
    const size_t kstep = (size_t)(BK * 2);
    const size_t hstep = (size_t)HALF * K * 2;
    const size_t tstep = 2 * hstep;
    const unsigned ldsw = (unsigned)wid * 1024u;
    const int aoff = lds_byte(wr * 64 + fr, fq * 8), boff = lds_byte(wc * 32 + fr, fq * 8);
#define PG8_SA(b, h) (((b) * 2 + (h)) * HTB)
#define PG8_SB(b, h) ((4 + (b) * 2 + (h)) * HTB)
#define PG8_STAGE(bufoff, gbase, voff) do { _Pragma("unroll") for (int _i = 0; _i < 2; ++_i) \
        __builtin_amdgcn_global_load_lds((const unsigned*)((const char*)(gbase) + (voff)[_i]), (LAS unsigned*)(lds + (bufoff) + ldsw + _i * 8192), 16, 0, 0); } while (0)
#define PG8_LDA(dst, b, h) do { _Pragma("unroll") for (int m = 0; m < 4; ++m) _Pragma("unroll") for (int k = 0; k < 2; ++k) dst[m][k] = *(const LAS bf16x8*)(lds + PG8_SA(b, h) + aoff + m * 2048 + k * 1024); } while (0)
#define PG8_LDB(dst, b, h) do { _Pragma("unroll") for (int n = 0; n < 2; ++n) _Pragma("unroll") for (int k = 0; k < 2; ++k) dst[n][k] = *(const LAS bf16x8*)(lds + PG8_SB(b, h) + boff + n * 2048 + k * 1024); } while (0)
#define PG8_MMA(ai, bj, At, Bt) do { __builtin_amdgcn_s_setprio(1); _Pragma("unroll") for (int m = 0; m < 4; ++m) _Pragma("unroll") for (int n = 0; n < 2; ++n) _Pragma("unroll") for (int k = 0; k < 2; ++k) \
        acc[ai][bj][m][n] = __builtin_amdgcn_mfma_f32_16x16x32_bf16(Bt[n][k], At[m][k], acc[ai][bj][m][n], 0, 0, 0); __builtin_amdgcn_s_setprio(0); } while (0)
#define PG8_WAIT_V(n) asm volatile("s_waitcnt vmcnt(" #n ")" ::: "memory")
#define PG8_WAIT_L(n) asm volatile("s_waitcnt lgkmcnt(" #n ")" ::: "memory")
#define PG8_BAR __builtin_amdgcn_s_barrier()
#define PG8_SCHED __builtin_amdgcn_sched_barrier(0)
    Unit cur, nxt; int ui = 0;
    if (!S.next(0, cur)) return;
    f32x4 acc[2][2][4][2];
#pragma unroll
    for (int a = 0; a < 2; ++a)
#pragma unroll
        for (int b = 0; b < 2; ++b)
#pragma unroll
            for (int m = 0; m < 4; ++m)
#pragma unroll
                for (int n = 0; n < 2; ++n) acc[a][b][m][n] = (f32x4){0.f, 0.f, 0.f, 0.f};
    bf16x8 At[4][2], B0[2][2], B1[2][2];
    const char* cA = (const char*)g.A + (size_t)cur.pm * tstep; const char* cB = (const char*)g.Bt + (size_t)cur.pn * tstep;
    PG8_STAGE(PG8_SB(0, 0), cB, voffB); PG8_STAGE(PG8_SB(0, 1), cB + hstep, voffB); PG8_STAGE(PG8_SA(0, 0), cA, voffA); PG8_STAGE(PG8_SA(0, 1), cA + hstep, voffA);
    if (wr == 1) PG8_BAR;
    PG8_WAIT_V(2); PG8_BAR;
    PG8_STAGE(PG8_SB(1, 0), cB + kstep, voffB); PG8_STAGE(PG8_SA(1, 0), cA + kstep, voffA); PG8_STAGE(PG8_SB(1, 1), cB + hstep + kstep, voffB);
    PG8_WAIT_V(6); PG8_BAR;
    for (;;) {
        const bool has_next = S.next(ui + 1, nxt);
        const char* nA = has_next ? (const char*)g.A + (size_t)nxt.pm * tstep : cA; const char* nB = has_next ? (const char*)g.Bt + (size_t)nxt.pn * tstep : cB;
        for (int t = 0; t < nt; t += 2) {
            const bool last = (t == nt - 2);
            const char* a1 = cA + (size_t)(t + 1) * kstep;
            const char* a2 = last ? nA : cA + (size_t)(t + 2) * kstep; const char* b2 = last ? nB : cB + (size_t)(t + 2) * kstep;
            const char* a3 = a2 + kstep; const char* b3 = b2 + kstep;
            PG8_LDB(B0, 0, 0); PG8_LDB(B1, 0, 1); PG8_SCHED; PG8_LDA(At, 0, 0); PG8_STAGE(PG8_SA(1, 1), a1 + hstep, voffA);
            PG8_WAIT_V(8); PG8_WAIT_L(0); PG8_BAR; PG8_MMA(0, 0, At, B0); PG8_MMA(0, 1, At, B1); PG8_BAR; PG8_SCHED;
            PG8_LDA(At, 0, 1); PG8_STAGE(PG8_SB(0, 0), b2, voffB); PG8_STAGE(PG8_SB(0, 1), b2 + hstep, voffB); PG8_STAGE(PG8_SA(0, 0), a2, voffA);
            PG8_WAIT_V(8); PG8_WAIT_L(0); PG8_BAR; PG8_MMA(1, 0, At, B0); PG8_MMA(1, 1, At, B1); PG8_BAR; PG8_SCHED;
            PG8_LDB(B0, 1, 0); PG8_LDB(B1, 1, 1); PG8_SCHED; PG8_LDA(At, 1, 0); PG8_STAGE(PG8_SA(0, 1), a2 + hstep, voffA);
            PG8_WAIT_V(8); PG8_WAIT_L(0); PG8_BAR; PG8_MMA(0, 0, At, B0); PG8_MMA(0, 1, At, B1); PG8_BAR; PG8_SCHED;
            PG8_LDA(At, 1, 1); PG8_STAGE(PG8_SB(1, 0), b3, voffB); PG8_STAGE(PG8_SB(1, 1), b3 + hstep, voffB); PG8_STAGE(PG8_SA(1, 0), a3, voffA);
            PG8_WAIT_V(8); PG8_WAIT_L(0); PG8_BAR; PG8_MMA(1, 0, At, B0); PG8_MMA(1, 1, At, B1); PG8_BAR; PG8_SCHED;
        }
        typename Epi::Pre pre; E.prefetch(pre, cur, wr, wc, fr, fq);
        if constexpr (ALIGN_EPI) { if (wr == 0) PG8_BAR; }
        E(acc, cur, wr, wc, fr, fq, pre);
        if (!has_next) break;
#pragma unroll
        for (int a = 0; a < 2; ++a)
#pragma unroll
            for (int b = 0; b < 2; ++b)
#pragma unroll
                for (int m = 0; m < 4; ++m)
#pragma unroll
                    for (int n = 0; n < 2; ++n) acc[a][b][m][n] = (f32x4){0.f, 0.f, 0.f, 0.f};
        cur = nxt; cA = nA; cB = nB; ++ui;
        if constexpr (ALIGN_EPI) { if (wr == 1) PG8_BAR; }
    }
    PG8_WAIT_V(0);
    if constexpr (!ALIGN_EPI) { if (wr == 0) PG8_BAR; }
    PG8_BAR;
#undef PG8_SA
#undef PG8_SB
#undef PG8_STAGE
#undef PG8_LDA
#undef PG8_LDB
#undef PG8_MMA
#undef PG8_WAIT_V
#undef PG8_WAIT_L
#undef PG8_BAR
#undef PG8_SCHED
}
}

using pg8::cvt_pk_bf16;
typedef f32x4 (&AccRef)[2][2][4][2];

__device__ __forceinline__ int cond_of_tile(int pm) { return pm < 32 ? 0 : 1 + ((pm - 32) >> 3); }
__device__ __forceinline__ float red_fq(float v) { v += __shfl_xor(v, 16); v += __shfl_xor(v, 32); return v; }
__device__ __forceinline__ float gelu_tanh(float x) { const float u = x + 0.044715f * x * x * x; return x * __builtin_amdgcn_rcpf(1.0f + __builtin_amdgcn_exp2f(-2.302208198f * u)); }
__device__ __forceinline__ float silu_f(float x) { return x * __builtin_amdgcn_rcpf(1.0f + __builtin_amdgcn_exp2f(-LOG2E * x)); }
__device__ __forceinline__ u32x4 pack8(const f32x4 a, const f32x4 b) { u32x4 w; w.x = cvt_pk_bf16(a[0], a[1]); w.y = cvt_pk_bf16(a[2], a[3]); w.z = cvt_pk_bf16(b[0], b[1]); w.w = cvt_pk_bf16(b[2], b[3]); return w; }
__device__ __forceinline__ float bf2f(unsigned short h) { return __uint_as_float((unsigned)h << 16); }

template <class T> __device__ __forceinline__ T ldg(const void* base, unsigned off) { return *(const T*)((const char*)base + off); }
template <class T> __device__ __forceinline__ void stg(void* base, unsigned off, T v) { *(T*)((char*)base + off) = v; }
__device__ __forceinline__ float ss4(const f32x4 v) { return (v[0] * v[0] + v[1] * v[1]) + (v[2] * v[2] + v[3] * v[3]); }

struct EpiRes {
    const float* xp; const float* xs; float* out; const float* gate; const float* nscale; bf16_t* An; float* ssn;
    struct Pre { f32x4 x[2][2][2]; };
    __device__ __forceinline__ void prefetch(Pre& p, const pg8::Unit& u, int wr, int wc, int fr, int fq) const {
        const unsigned colbase = u.pn * 256 + wc * 32 + 8 * fq;
        const bool ctx = u.pm < 32; const float* xb = ctx ? xp : xs; const unsigned rsub = ctx ? 0u : (unsigned)NCTX;
#pragma unroll
        for (int q = 0; q < 2; ++q) {
            const unsigned row = u.pm * 256 + wr * 64 + q * 16 + fr;
            const unsigned xoff = ((row - rsub) * DM + colbase) * 4u;
#pragma unroll
            for (int bj = 0; bj < 2; ++bj)
#pragma unroll
                for (int n = 0; n < 2; ++n) p.x[q][bj][n] = ldg<f32x4>(xb, xoff + bj * 512 + n * 16);
        }
    }
    __device__ __forceinline__ void operator()(AccRef acc, const pg8::Unit& u, int wr, int wc, int fr, int fq, const Pre& pre) const {
        const int cond = cond_of_tile(u.pm);
        const unsigned colbase = u.pn * 256 + wc * 32 + 8 * fq;
        const bool ctx = u.pm < 32;
        const float* xb = ctx ? xp : xs;
        const unsigned rsub = ctx ? 0u : (unsigned)NCTX;
        const unsigned moff = (cond * MODW + colbase) * 4u;
        f32x4 gt[2][2], sc[2][2];
#pragma unroll
        for (int bj = 0; bj < 2; ++bj)
#pragma unroll
            for (int n = 0; n < 2; ++n) {
                gt[bj][n] = ldg<f32x4>(gate, moff + bj * 512 + n * 16);
                sc[bj][n] = An ? ldg<f32x4>(nscale, moff + bj * 512 + n * 16) + 1.0f : (f32x4){1.f, 1.f, 1.f, 1.f};
            }
#pragma unroll
        for (int ai = 0; ai < 2; ++ai)
#pragma unroll
            for (int mp = 0; mp < 2; ++mp) {
                f32x4 xo[2][2][2];
#pragma unroll
                for (int q = 0; q < 2; ++q) {
                    const unsigned row = u.pm * 256 + ai * 128 + wr * 64 + (2 * mp + q) * 16 + fr;
                    const unsigned xoff = ((row - rsub) * DM + colbase) * 4u;
#pragma unroll
                    for (int bj = 0; bj < 2; ++bj)
#pragma unroll
                        for (int n = 0; n < 2; ++n) xo[q][bj][n] = (ai == 0 && mp == 0) ? pre.x[q][bj][n] : ldg<f32x4>(xb, xoff + bj * 512 + n * 16);
                }
#pragma unroll
                for (int q = 0; q < 2; ++q) {
                    const int m = 2 * mp + q;
                    const unsigned row = u.pm * 256 + ai * 128 + wr * 64 + m * 16 + fr;
                    const unsigned ooff = (row * DM + colbase) * 4u;
                    float ssum = 0.f;
#pragma unroll
                    for (int bj = 0; bj < 2; ++bj) {
                        f32x4 xn[2];
#pragma unroll
                        for (int n = 0; n < 2; ++n) {
                            xn[n] = xo[q][bj][n] + gt[bj][n] * acc[ai][bj][m][n];
                            stg<f32x4>(out, ooff + bj * 512 + n * 16, xn[n]);
                            ssum += ss4(xn[n]);
                        }
                        if (An) stg<u32x4>(An, (row * DM + colbase) * 2u + bj * 256, pack8(xn[0] * sc[bj][0], xn[1] * sc[bj][1]));
                    }
                    if (ssn) { ssum = red_fq(ssum); if (fq == 0) atomicAdd((float*)((char*)ssn + row * 4u), ssum); }
                }
                asm volatile("" ::: "memory");
            }
    }
};

template <bool EVEN>
struct EpiIn {
    unsigned char* wsb; float* outb;
    const float* qg; const float* kg;
    struct Pre {}; __device__ __forceinline__ void prefetch(Pre&, const pg8::Unit&, int, int, int, int) const {}
    __device__ __forceinline__ void operator()(AccRef acc, const pg8::Unit& u, int wr, int wc, int fr, int fq, const Pre&) const {
        constexpr unsigned N = EVEN ? EVEN_IN : ODD_IN, QW = EVEN ? 512 : 1024, KVH = EVEN ? 2 : 4, KW = KVH * 64;
        const float* ss = (const float*)(wsb + (EVEN ? WS_SS0 : WS_SS2));
        const float* bias = (const float*)(wsb + WS_BIAS) + (EVEN ? BIAS_INE : BIAS_INO);
        const float* rope = (const float*)(wsb + WS_ROPE);
        bf16_t* Q = (bf16_t*)(wsb + WS_Q); bf16_t* K = (bf16_t*)(wsb + (EVEN ? WS_KE : WS_KO)); bf16_t* Vt = (bf16_t*)(wsb + (EVEN ? WS_VTE : WS_VTO));
        bf16_t* MIX = (bf16_t*)(wsb + WS_MIX); bf16_t* VbT = (bf16_t*)(wsb + WS_VBT); float* ssv = (float*)(wsb + WS_SSV);
        float* outk = outb + (size_t)MTOK * DM + (EVEN ? 0 : NCTX * 256); float* outv = outk + NCTX * KW;
        const int cond = cond_of_tile(u.pm);
        int role; unsigned hidx;
        if (EVEN) { if (u.pn < 2) { role = 0; hidx = 4 * u.pn + wc; } else if (u.pn == 2) { role = wc < 2 ? 1 : 2; hidx = wc & 1; } else if (u.pn < 5) { role = 3; hidx = (u.pn - 3) * 4 + wc; } else { role = 4; hidx = (u.pn - 5) * 4 + wc; } }
        else { if (u.pn < 4) { role = 0; hidx = 4 * u.pn + wc; } else if (u.pn == 4) { role = 1; hidx = wc; } else { role = 2; hidx = wc; } }
        const unsigned boff = (cond * N + u.pn * 256 + wc * 32 + 8 * fq) * 4u;
        const bool lat = u.pm >= 32;
        const unsigned c8 = hidx * 64 + 8 * fq;
        const float* gp = role == 0 ? qg : kg;
        f32x4 bvh[2][2];
#pragma unroll
        for (int bj = 0; bj < 2; ++bj)
#pragma unroll
            for (int n = 0; n < 2; ++n) bvh[bj][n] = ldg<f32x4>(bias, boff + bj * 512 + n * 16);
        float rrs[8];
#pragma unroll
        for (int g8 = 0; g8 < 8; ++g8) rrs[g8] = ldg<float>(ss, (u.pm * 256 + (g8 >> 2) * 128 + wr * 64 + (g8 & 3) * 16 + fr) * 4u);
#pragma unroll
        for (int g8 = 0; g8 < 8; ++g8) rrs[g8] = __builtin_amdgcn_rsqf(rrs[g8] * (1.0f / DM) + EPS);
#pragma unroll
        for (int ai = 0; ai < 2; ++ai)
#pragma unroll
            for (int m = 0; m < 4; ++m) {
                const unsigned row = u.pm * 256 + ai * 128 + wr * 64 + m * 16 + fr;
                const float rr = rrs[ai * 4 + m];
                f32x4 z[2][2];
#pragma unroll
                for (int bj = 0; bj < 2; ++bj)
#pragma unroll
                    for (int n = 0; n < 2; ++n) z[bj][n] = acc[ai][bj][m][n] * rr + bvh[bj][n];
                if (role <= 1) {
                    float s2 = (ss4(z[0][0]) + ss4(z[0][1])) + (ss4(z[1][0]) + ss4(z[1][1]));
                    s2 = red_fq(s2);
                    const float rn = __builtin_amdgcn_rsqf(s2 * (1.0f / 64.0f) + EPS);
#pragma unroll
                    for (int bj = 0; bj < 2; ++bj)
#pragma unroll
                        for (int n = 0; n < 2; ++n) z[bj][n] = z[bj][n] * rn * ldg<f32x4>(gp, (8 * fq) * 4u + bj * 128 + n * 16);
                    if (role == 1 && !lat) {
#pragma unroll
                        for (int bj = 0; bj < 2; ++bj)
#pragma unroll
                            for (int n = 0; n < 2; ++n) stg<f32x4>(outk, (row * KW + c8) * 4u + bj * 128 + n * 16, z[bj][n]);
                    }
                    if (lat) {
                        const unsigned t = (row - NCTX) & 2047u;
#pragma unroll
                        for (int bj = 0; bj < 2; ++bj) {
                            const unsigned pos = bj == 0 ? (t >> 6) : (t & 63u);
#pragma unroll
                            for (int n = 0; n < 2; ++n) {
                                const f32x4 cs = ldg<f32x4>(rope, (pos * 16 + 4 * fq) * 8u + n * 16);
                                const f32x4 v = z[bj][n];
                                z[bj][n] = (f32x4){v[0] * cs[0] - v[1] * cs[1], v[0] * cs[1] + v[1] * cs[0], v[2] * cs[2] - v[3] * cs[3], v[2] * cs[3] + v[3] * cs[2]};
                            }
                        }
                    }
                    if (role == 0) {
#pragma unroll
                        for (int bj = 0; bj < 2; ++bj) stg<u32x4>(Q, (row * QW + c8) * 2u + bj * 64, pack8(z[bj][0] * (0.125f * LOG2E), z[bj][1] * (0.125f * LOG2E)));
                    } else {
#pragma unroll
                        for (int bj = 0; bj < 2; ++bj) stg<u32x4>(K, (row * KW + c8) * 2u + bj * 64, pack8(z[bj][0], z[bj][1]));
                    }
                } else if (role == 2) {
                    if (!lat) {
#pragma unroll
                        for (int bj = 0; bj < 2; ++bj)
#pragma unroll
                            for (int n = 0; n < 2; ++n) stg<f32x4>(outv, (row * KW + c8) * 4u + bj * 128 + n * 16, z[bj][n]);
                    }
                    unsigned vb, T;
                    if (!lat) { T = 256; vb = ((row >> 8) * KVH + hidx) * 64 * 256 + (row & 255u); }
                    else { T = 2048; vb = NCTX * KW + (((row - NCTX) >> 11) * KVH + hidx) * 64 * 2048 + ((row - NCTX) & 2047u); }
                    vb += 8 * fq * T;
#pragma unroll
                    for (int bj = 0; bj < 2; ++bj)
#pragma unroll
                        for (int n = 0; n < 2; ++n)
#pragma unroll
                            for (int i = 0; i < 4; ++i) stg<bf16_t>(Vt, (vb + (32 * bj + 4 * n + i) * T) * 2u, (bf16_t)(cvt_pk_bf16(z[bj][n][i], 0.f) & 0xffffu));
                } else if (EVEN && role == 3) {
#pragma unroll
                    for (int bj = 0; bj < 2; ++bj) {
                        f32x4 a = z[bj][0], b = z[bj][1];
#pragma unroll
                        for (int i = 0; i < 4; ++i) { a[i] = gelu_tanh(a[i]); b[i] = gelu_tanh(b[i]); }
                        stg<u32x4>(MIX, (row * DM + 512 + c8) * 2u + bj * 64, pack8(a, b));
                    }
                } else if (EVEN) {
                    float s2 = 0.f;
                    const unsigned cb = (row >> 7) * 512 * 128 + (row & 127u) + c8 * 128;
#pragma unroll
                    for (int bj = 0; bj < 2; ++bj)
#pragma unroll
                        for (int n = 0; n < 2; ++n)
#pragma unroll
                            for (int i = 0; i < 4; ++i) {
                                const float gv = gelu_tanh(z[bj][n][i]); s2 += gv * gv;
                                stg<bf16_t>(VbT, (cb + (32 * bj + 4 * n + i) * 128) * 2u, (bf16_t)(cvt_pk_bf16(gv, 0.f) & 0xffffu));
                            }
                    s2 = red_fq(s2);
                    if (fq == 0) atomicAdd((float*)((char*)ssv + row * 4u), s2);
                }
                asm volatile("" ::: "memory");
            }
    }
};

template <int CTRL> __device__ __forceinline__ float dpp_rot(float v) { return __builtin_bit_cast(float, __builtin_amdgcn_update_dpp(0, __builtin_bit_cast(int, v), CTRL, 0xf, 0xf, false)); }
__device__ __forceinline__ void conv_taps(f32x4& res, const f32x4 sp, const f32x4 sn, const f32x4 w0, const f32x4 w2) {
    float r0 = res[0], r1 = res[1], r2 = res[2], r3 = res[3];
    asm("s_nop 1\n\t"
        "v_fmac_f32_dpp %0, %4, %12 row_ror:1 row_mask:0xf bank_mask:0xf\n\t"
        "v_fmac_f32_dpp %1, %5, %13 row_ror:1 row_mask:0xf bank_mask:0xf\n\t"
        "v_fmac_f32_dpp %2, %6, %14 row_ror:1 row_mask:0xf bank_mask:0xf\n\t"
        "v_fmac_f32_dpp %3, %7, %15 row_ror:1 row_mask:0xf bank_mask:0xf\n\t"
        "v_fmac_f32_dpp %0, %8, %16 row_ror:15 row_mask:0xf bank_mask:0xf\n\t"
        "v_fmac_f32_dpp %1, %9, %17 row_ror:15 row_mask:0xf bank_mask:0xf\n\t"
        "v_fmac_f32_dpp %2, %10, %18 row_ror:15 row_mask:0xf bank_mask:0xf\n\t"
        "v_fmac_f32_dpp %3, %11, %19 row_ror:15 row_mask:0xf bank_mask:0xf"
        : "+v"(r0), "+v"(r1), "+v"(r2), "+v"(r3)
        : "v"(sp[0]), "v"(sp[1]), "v"(sp[2]), "v"(sp[3]), "v"(sn[0]), "v"(sn[1]), "v"(sn[2]), "v"(sn[3]),
          "v"(w0[0]), "v"(w0[1]), "v"(w0[2]), "v"(w0[3]), "v"(w2[0]), "v"(w2[1]), "v"(w2[2]), "v"(w2[3]));
    res = (f32x4){r0, r1, r2, r3};
}
struct EpiUp {
    unsigned char* wsb; unsigned ss_off, bias_off; const float* cw; const float* cbias;
    LAS float* xch;
    struct Pre {}; __device__ __forceinline__ void prefetch(Pre&, const pg8::Unit&, int, int, int, int) const {}
    __device__ __forceinline__ void operator()(AccRef acc, const pg8::Unit& u, int wr, int wc, int fr, int fq, const Pre&) const {
        const float* ss = (const float*)(wsb + ss_off); const float* bias = (const float*)(wsb + WS_BIAS) + bias_off;
        float* ZB = (float*)(wsb + WS_ZB); bf16_t* ACT = (bf16_t*)(wsb + WS_ACT);
        const int cond = cond_of_tile(u.pm);
        const unsigned nb = u.pn * 256 + wc * 32 + 8 * fq;
        const unsigned boff = (cond * FF2 + nb) * 4u;
#pragma unroll
        for (int ai = 0; ai < 2; ++ai)
#pragma unroll
            for (int m = 0; m < 4; ++m) {
                const unsigned row = u.pm * 256 + ai * 128 + wr * 64 + m * 16 + fr;
                const float rr = __builtin_amdgcn_rsqf(ldg<float>(ss, row * 4u) * (1.0f / DM) + EPS);
#pragma unroll
                for (int bj = 0; bj < 2; ++bj)
#pragma unroll
                    for (int n = 0; n < 2; ++n) acc[ai][bj][m][n] = acc[ai][bj][m][n] * rr + ldg<f32x4>(bias, boff + bj * 512 + n * 16);
            }
        if (wr == 0 && fr < 2) {
            const unsigned zo = ((u.pm * 4 + fr) * FF2 + nb) * 4u;
#pragma unroll
            for (int bj = 0; bj < 2; ++bj)
#pragma unroll
                for (int n = 0; n < 2; ++n) stg<f32x4>(ZB, zo + bj * 512 + n * 16, acc[0][bj][0][n]);
        }
        if (wr == 1 && fr >= 14) {
            const unsigned zo = ((u.pm * 4 + 2 + (fr - 14)) * FF2 + nb) * 4u;
#pragma unroll
            for (int bj = 0; bj < 2; ++bj)
#pragma unroll
                for (int n = 0; n < 2; ++n) stg<f32x4>(ZB, zo + bj * 512 + n * 16, acc[1][bj][3][n]);
        }
        LAS float* my = xch + (wr * 4 + wc) * 256 + 8 * fq;
        if (fr == 0) {
#pragma unroll
            for (int ai = 0; ai < 2; ++ai)
#pragma unroll
                for (int bj = 0; bj < 2; ++bj)
#pragma unroll
                    for (int n = 0; n < 2; ++n) *(LAS f32x4*)(my + ai * 128 + bj * 32 + 4 * n) = acc[ai][bj][0][n];
        }
        if (fr == 15) {
#pragma unroll
            for (int ai = 0; ai < 2; ++ai)
#pragma unroll
                for (int bj = 0; bj < 2; ++bj)
#pragma unroll
                    for (int n = 0; n < 2; ++n) *(LAS f32x4*)(my + ai * 128 + 64 + bj * 32 + 4 * n) = acc[ai][bj][3][n];
        }
        asm volatile("s_waitcnt lgkmcnt(0)" ::: "memory"); __builtin_amdgcn_s_barrier(); asm volatile("" ::: "memory");
        const unsigned chb = u.pn * 128 + wc * 32 + 8 * fq;
        const float* cw1 = cw + FF2; const float* cw2 = cw + 2 * FF2;
#pragma unroll
        for (int n = 0; n < 2; ++n) {
            const unsigned cia = (chb + 4 * n) * 4u, cig = (FF + chb + 4 * n) * 4u;
            const f32x4 wa0 = ldg<f32x4>(cw, cia), wa1 = ldg<f32x4>(cw1, cia), wa2 = ldg<f32x4>(cw2, cia), cba = ldg<f32x4>(cbias, cia);
            const f32x4 wg0 = ldg<f32x4>(cw, cig), wg1 = ldg<f32x4>(cw1, cig), wg2 = ldg<f32x4>(cw2, cig), cbg = ldg<f32x4>(cbias, cig);
#pragma unroll
            for (int ai = 0; ai < 2; ++ai) {
                const bool hasp = !(ai == 0 && wr == 0), hasn = !(ai == 1 && wr == 1);
                const LAS float* pp = xch + ((wr == 1 ? 0 : 4) + wc) * 256 + (wr == 1 ? ai : 0) * 128 + 64 + 8 * fq;
                const LAS float* pn = xch + ((wr == 0 ? 4 : 0) + wc) * 256 + (wr == 0 ? ai : 1) * 128 + 8 * fq;
                const unsigned arow = ((u.pm * 256 + ai * 128 + wr * 64 + fr) * FF + chb) * 2u;
                f32x4 sg[4];
#pragma unroll
                for (int pass = 0; pass < 2; ++pass) {
                    const int bj = 1 - pass;
                    const f32x4 w0 = pass == 0 ? wg0 : wa0, w1 = pass == 0 ? wg1 : wa1, w2 = pass == 0 ? wg2 : wa2, cb = pass == 0 ? cbg : cba;
                    f32x4 hp = (f32x4){0.f, 0.f, 0.f, 0.f}, hn = (f32x4){0.f, 0.f, 0.f, 0.f};
                    if (hasp) hp = *(const LAS f32x4*)(pp + bj * 32 + 4 * n);
                    if (hasn) hn = *(const LAS f32x4*)(pn + bj * 32 + 4 * n);
                    f32x4 prevsrc = hp;
#pragma unroll
                    for (int m = 0; m < 4; ++m) {
                        const f32x4 zc = acc[ai][bj][m][n];
                        const f32x4 nsrc = m < 3 ? acc[ai][bj][m < 3 ? m + 1 : 3][n] : hn;
                        f32x4 sp, sn;
#pragma unroll
                        for (int i = 0; i < 4; ++i) { sp[i] = fr == 15 ? prevsrc[i] : zc[i]; sn[i] = fr == 0 ? nsrc[i] : zc[i]; }
                        f32x4 res = cb + w1 * zc;
                        conv_taps(res, sp, sn, w0, w2);
                        prevsrc = zc;
                        if (pass == 0) {
#pragma unroll
                            for (int i = 0; i < 4; ++i) res[i] = silu_f(res[i]);
                            sg[m] = res;
                        } else {
                            res = res * sg[m];
                            stg<u32x2>(ACT, arow + m * (16 * FF * 2) + n * 8, (u32x2){cvt_pk_bf16(res[0], res[1]), cvt_pk_bf16(res[2], res[3])});
                        }
                    }
                }
                asm volatile("" ::: "memory");
            }
        }
    }
};

__device__ __forceinline__ int crow(int r, int hi) { return (r & 3) + 8 * (r >> 2) + 4 * hi; }
__device__ __forceinline__ void attn_unit(LAS unsigned char* lds, const bf16_t* Q, int qstride, bf16_t* O, int ostride,
                                          const bf16_t* K0, int ks0, const bf16_t* V0, int vs0, int t0lo, int nt0,
                                          const bf16_t* K1, int ks1, const bf16_t* V1, int vs1, int nt1,
                                          float m_init, float l_init, int win_q0, const int tid) {
    const int lane = tid & 63, r32 = lane & 31, hi = lane >> 5, wid = __builtin_amdgcn_readfirstlane(tid >> 6);
    const int qrow = wid * 32 + r32;
    bf16x8 qf[4];
#pragma unroll
    for (int d0 = 0; d0 < 4; ++d0) qf[d0] = *(const bf16x8*)(Q + (size_t)qrow * qstride + d0 * 16 + hi * 8);
    float mrun = m_init;
    f32x16 o0 = {}, o1 = {}, lacc, negm;
#pragma unroll
    for (int r = 0; r < 16; ++r) { lacc[r] = l_init; negm[r] = -m_init; }
    const bf16x8 ones = {0x3F80, 0x3F80, 0x3F80, 0x3F80, 0x3F80, 0x3F80, 0x3F80, 0x3F80};
    const int NT = nt0 + nt1;
    const int lrow = 8 * wid + (lane >> 3), lch = (lane & 7) ^ ((lrow >> 1) & 7);
    auto dma = [&](int t) {
        const bf16_t* kp; const bf16_t* vp;
        if (t < nt0) { kp = K0 + (size_t)((t0lo + t) * 64 + lrow) * ks0 + lch * 8; vp = V0 + (size_t)lrow * vs0 + (t0lo + t) * 64 + lch * 8; }
        else { kp = K1 + (size_t)((t - nt0) * 64 + lrow) * ks1 + lch * 8; vp = V1 + (size_t)lrow * vs1 + (t - nt0) * 64 + lch * 8; }
        LAS unsigned char* dst = lds + (t % 6) * 16384 + wid * 1024;
        __builtin_amdgcn_global_load_lds((const unsigned*)kp, (LAS unsigned*)dst, 16, 0, 0);
        __builtin_amdgcn_global_load_lds((const unsigned*)vp, (LAS unsigned*)(dst + 8192), 16, 0, 0);
    };
    const int krow = (r32 & 0x13) | ((r32 & 4) << 1) | ((r32 & 8) >> 1);
    const int koff = krow * 128 + ((hi ^ ((krow >> 1) & 7)) << 4);
    const int voff = 8192 + r32 * 128 + ((hi ^ ((r32 >> 1) & 7)) << 4);
    dma(0); if (NT > 1) dma(1); if (NT > 2) dma(2); if (NT > 3) dma(3); if (NT > 4) dma(4);
    for (int t = 0; t < NT; ++t) {
        if (t + 4 < NT) asm volatile("s_waitcnt vmcnt(8)" ::: "memory");
        else if (t + 3 < NT) asm volatile("s_waitcnt vmcnt(6)" ::: "memory");
        else if (t + 2 < NT) asm volatile("s_waitcnt vmcnt(4)" ::: "memory");
        else if (t + 1 < NT) asm volatile("s_waitcnt vmcnt(2)" ::: "memory");
        else asm volatile("s_waitcnt vmcnt(0)" ::: "memory");
        __builtin_amdgcn_s_barrier(); asm volatile("" ::: "memory");
        if (t + 5 < NT) dma(t + 5);
        bool active = true;
        int key0 = 0;
        if (win_q0 >= 0 && t < nt0) {
            key0 = (t0lo + t) * 64;
            const int qw0 = win_q0 + wid * 32;
            active = !(key0 + 63 < qw0 - 128 || key0 > qw0 + 31 + 128);
        }
        if (active) {
            const LAS unsigned char* sb = lds + (t % 6) * 16384;
            f32x16 p0 = negm, p1 = negm;
#pragma unroll
            for (int d0 = 0; d0 < 4; ++d0) {
                const bf16x8 k0 = *(const LAS bf16x8*)(sb + (koff ^ (d0 << 5)));
                const bf16x8 k1 = *(const LAS bf16x8*)(sb + (koff ^ (d0 << 5)) + 32 * 128);
                p0 = __builtin_amdgcn_mfma_f32_32x32x16_bf16(k0, qf[d0], p0, 0, 0, 0);
                p1 = __builtin_amdgcn_mfma_f32_32x32x16_bf16(k1, qf[d0], p1, 0, 0, 0);
            }
            if (win_q0 >= 0 && t < nt0) {
                const int qw0 = win_q0 + wid * 32;
                const int bb = key0 + 8 * hi - (win_q0 + qrow);
                if (key0 < qw0 + 31 - 128) {
#pragma unroll
                    for (int r = 0; r < 16; ++r) { const int c = 16 * (r >> 3) + (r & 7); if (bb < -128 - c) p0[r] = -INFINITY; if (bb < -160 - c) p1[r] = -INFINITY; }
                }
                if (key0 + 63 > qw0 + 128) {
#pragma unroll
                    for (int r = 0; r < 16; ++r) { const int c = 16 * (r >> 3) + (r & 7); if (bb > 128 - c) p0[r] = -INFINITY; if (bb > 96 - c) p1[r] = -INFINITY; }
                }
            }
            float mx = __builtin_fmaxf(__builtin_fmaxf(p0[0], p1[0]), __builtin_fmaxf(p0[1], p1[1]));
#pragma unroll
            for (int r = 2; r < 16; r += 2) mx = __builtin_fmaxf(__builtin_fmaxf(mx, p0[r]), __builtin_fmaxf(p1[r], __builtin_fmaxf(p0[r + 1], p1[r + 1])));
            mx = __builtin_fmaxf(mx, __shfl_xor(mx, 32));
            if (__any(mx > 8.0f)) {
                const float dl = mx > 8.0f ? mx : 0.f;
                const float f = __builtin_amdgcn_exp2f(-dl);
                mrun += dl;
                p0 = p0 - dl; p1 = p1 - dl; negm = negm - dl;
#pragma unroll
                for (int r = 0; r < 16; ++r) { o0[r] *= f; o1[r] *= f; lacc[r] *= f; }
            }
#pragma unroll
            for (int r = 0; r < 16; ++r) { p0[r] = __builtin_amdgcn_exp2f(p0[r]); p1[r] = __builtin_amdgcn_exp2f(p1[r]); }
            bf16x8 pw[4];
#pragma unroll
            for (int ks = 0; ks < 4; ++ks) {
                u32x4 w;
                if (ks < 2) { w.x = cvt_pk_bf16(p0[8 * ks + 0], p0[8 * ks + 1]); w.y = cvt_pk_bf16(p0[8 * ks + 2], p0[8 * ks + 3]); w.z = cvt_pk_bf16(p0[8 * ks + 4], p0[8 * ks + 5]); w.w = cvt_pk_bf16(p0[8 * ks + 6], p0[8 * ks + 7]); }
                else { const int k2 = ks - 2; w.x = cvt_pk_bf16(p1[8 * k2 + 0], p1[8 * k2 + 1]); w.y = cvt_pk_bf16(p1[8 * k2 + 2], p1[8 * k2 + 3]); w.z = cvt_pk_bf16(p1[8 * k2 + 4], p1[8 * k2 + 5]); w.w = cvt_pk_bf16(p1[8 * k2 + 6], p1[8 * k2 + 7]); }
                pw[ks] = __builtin_bit_cast(bf16x8, w);
            }
#pragma unroll
            for (int ks = 0; ks < 4; ++ks) {
                const bf16x8 va = *(const LAS bf16x8*)(sb + (voff ^ (ks << 5)));
                const bf16x8 vbb = *(const LAS bf16x8*)(sb + (voff ^ (ks << 5)) + 32 * 128);
                o0 = __builtin_amdgcn_mfma_f32_32x32x16_bf16(va, pw[ks], o0, 0, 0, 0);
                o1 = __builtin_amdgcn_mfma_f32_32x32x16_bf16(vbb, pw[ks], o1, 0, 0, 0);
                lacc = __builtin_amdgcn_mfma_f32_32x32x16_bf16(ones, pw[ks], lacc, 0, 0, 0);
            }
        }
    }
    const float inv = 1.0f / lacc[0];
    bf16_t* orow = O + (size_t)qrow * ostride;
#pragma unroll
    for (int r4 = 0; r4 < 4; ++r4) {
        u32x2 w0, w1;
        w0.x = cvt_pk_bf16(o0[4 * r4 + 0] * inv, o0[4 * r4 + 1] * inv); w0.y = cvt_pk_bf16(o0[4 * r4 + 2] * inv, o0[4 * r4 + 3] * inv);
        w1.x = cvt_pk_bf16(o1[4 * r4 + 0] * inv, o1[4 * r4 + 1] * inv); w1.y = cvt_pk_bf16(o1[4 * r4 + 2] * inv, o1[4 * r4 + 3] * inv);
        *(u32x2*)(orow + 8 * r4 + 4 * hi) = w0;
        *(u32x2*)(orow + 32 + 8 * r4 + 4 * hi) = w1;
    }
    asm volatile("s_waitcnt vmcnt(0) lgkmcnt(0)" ::: "memory"); __builtin_amdgcn_s_barrier(); asm volatile("" ::: "memory");
}

__device__ __forceinline__ void spatial_unit(LAS unsigned char* lds, int chunk, int g, const float* w_s, const float* b_s, const float* v_gain, const float* ssv, const bf16_t* VbT, bf16_t* MIX, const int tid) {
    const int lane = tid & 63, r32 = lane & 31, hi = lane >> 5, wid = __builtin_amdgcn_readfirstlane(tid >> 6);
    const int pblk = wid & 3, chalf = wid >> 2;
    const int p = 32 * pblk + r32;
    bf16x8 yf[8];
#pragma unroll
    for (int ks = 0; ks < 8; ++ks) {
        const int q = 16 * ks + 8 * hi;
        const f32x4 w0 = *(const f32x4*)(w_s + ((size_t)g * 128 + p) * 128 + q), w1 = *(const f32x4*)(w_s + ((size_t)g * 128 + p) * 128 + q + 4);
        const f32x4 s0 = *(const f32x4*)(ssv + chunk * 128 + q), s1 = *(const f32x4*)(ssv + chunk * 128 + q + 4);
        f32x4 a, b;
#pragma unroll
        for (int i = 0; i < 4; ++i) { a[i] = w0[i] * __builtin_amdgcn_rsqf(s0[i] * (1.0f / 512.0f) + EPS); b[i] = w1[i] * __builtin_amdgcn_rsqf(s1[i] * (1.0f / 512.0f) + EPS); }
        yf[ks] = __builtin_bit_cast(bf16x8, pack8(a, b));
    }
    const float bs = b_s[g * 128 + p];
    LAS float* stg = (LAS float*)(lds + wid * 8704);
#pragma unroll
    for (int cbk = 0; cbk < 2; ++cbk) {
        const int cblk = 2 * chalf + cbk;
        const bf16_t* xr = VbT + ((size_t)chunk * 512 + 128 * g + 32 * cblk + r32) * 128 + 8 * hi;
        f32x16 acc = {};
#pragma unroll
        for (int ks = 0; ks < 8; ++ks) { const bf16x8 xf = *(const bf16x8*)(xr + 16 * ks); acc = __builtin_amdgcn_mfma_f32_32x32x16_bf16(xf, yf[ks], acc, 0, 0, 0); }
#pragma unroll
        for (int r4 = 0; r4 < 4; ++r4) {
            const int c4 = 32 * cbk + 8 * r4 + 4 * hi;
            const f32x4 gn = *(const f32x4*)(v_gain + 128 * g + 64 * chalf + c4);
            *(LAS f32x4*)(stg + r32 * 68 + c4) = (f32x4){gn[0] * acc[4 * r4 + 0] + bs, gn[1] * acc[4 * r4 + 1] + bs, gn[2] * acc[4 * r4 + 2] + bs, gn[3] * acc[4 * r4 + 3] + bs};
        }
    }
    asm volatile("s_waitcnt lgkmcnt(0)" ::: "memory");
#pragma unroll
    for (int i = 0; i < 4; ++i) {
        const int prow = i * 8 + (lane >> 3), ch8 = (lane & 7) * 8;
        const f32x4 m0 = *(const LAS f32x4*)(stg + prow * 68 + ch8), m1 = *(const LAS f32x4*)(stg + prow * 68 + ch8 + 4);
        bf16_t* up = MIX + (size_t)(chunk * 128 + 32 * pblk + prow) * DM + 512 + 128 * g + 64 * chalf + ch8;
        const u32x4 uu = *(const u32x4*)up;
        f32x4 a, b;
        a[0] = __uint_as_float(uu.x << 16) * m0[0]; a[1] = __uint_as_float(uu.x & 0xffff0000u) * m0[1]; a[2] = __uint_as_float(uu.y << 16) * m0[2]; a[3] = __uint_as_float(uu.y & 0xffff0000u) * m0[3];
        b[0] = __uint_as_float(uu.z << 16) * m1[0]; b[1] = __uint_as_float(uu.z & 0xffff0000u) * m1[1]; b[2] = __uint_as_float(uu.w << 16) * m1[2]; b[3] = __uint_as_float(uu.w & 0xffff0000u) * m1[3];
        *(u32x4*)up = pack8(a, b);
    }
    asm volatile("s_waitcnt lgkmcnt(0)" ::: "memory"); __builtin_amdgcn_s_barrier(); asm volatile("" ::: "memory");
}

__device__ __forceinline__ unsigned f2bf(float f) { unsigned u = __builtin_bit_cast(unsigned, f); return (u + 0x7fffu + ((u >> 16) & 1u)) >> 16; }
__device__ __forceinline__ unsigned pk2(float lo, float hi) { return f2bf(lo) | (f2bf(hi) << 16); }
__device__ __forceinline__ float wave_sum(float v) {
#pragma unroll
    for (int o = 1; o < 64; o <<= 1) v += __shfl_xor(v, o);
    return v;
}
__device__ __forceinline__ void transpose_item(const float* W, int K, int N, bf16_t* WT, int k0, int n0, int drow, LAS float* scr, int lane) {
    float tv[32];
#pragma unroll
    for (int i = 0; i < 32; ++i) tv[i] = W[(size_t)(k0 + 2 * i + (lane >> 5)) * N + n0 + (lane & 31)];
#pragma unroll
    for (int i = 0; i < 32; ++i) scr[(2 * i + (lane >> 5)) * 33 + (lane & 31)] = tv[i];
    asm volatile("s_waitcnt lgkmcnt(0)" ::: "memory");
    const int c = lane & 7;
#pragma unroll
    for (int j = 0; j < 4; ++j) { const int n = (lane >> 3) + 8 * j; const LAS float* s = scr + (8 * c) * 33 + n;
        u32x4 o; o.x = pk2(s[0 * 33], s[1 * 33]); o.y = pk2(s[2 * 33], s[3 * 33]); o.z = pk2(s[4 * 33], s[5 * 33]); o.w = pk2(s[6 * 33], s[7 * 33]);
        *(u32x4*)(WT + (size_t)(drow + n) * K + k0 + 8 * c) = o; }
    asm volatile("s_waitcnt lgkmcnt(0)" ::: "memory");
}
__device__ __forceinline__ int perm_in(int n0) { const int pn = n0 >> 8, rem = n0 & 255; return pn * 256 + ((rem & 63) >> 5) * 128 + (rem >> 6) * 32; }
__device__ __forceinline__ int perm_up(int n0) { const int half = n0 / FF, ch = n0 % FF; return (ch >> 7) * 256 + half * 128 + (ch & 127); }


#define XB_TMO      128
#define XB_XCNT(j)  (256  + 64 * (j))
#define XB_XSUB(j)  (1280 + 64 * (j))
#define XB_XGEN(j)  (2304 + 64 * (j))
#define XB_TOP      3328
#define XB_TOPGEN   3392
#define XCD_BAR_WORDS 3456
#define XB_SPIN_CAP (1u << 18)
__device__ __forceinline__ unsigned xb_ld(unsigned* p)              { return __hip_atomic_load(p, __ATOMIC_RELAXED, __HIP_MEMORY_SCOPE_AGENT); }
__device__ __forceinline__ unsigned xb_add(unsigned* p, unsigned v) { return __hip_atomic_fetch_add(p, v, __ATOMIC_RELAXED, __HIP_MEMORY_SCOPE_AGENT); }
__device__ __forceinline__ unsigned xb_xcc_id() { return (unsigned)__builtin_amdgcn_s_getreg((3 << 11) | 20) & 0xFu; }
#define XB_SPIN(cond, bar) do { unsigned _sp = 0; while (cond) { __builtin_amdgcn_s_sleep(1); \
    if ((++_sp & 255u) == 0u) { if (xb_ld(&(bar)[XB_TMO])) break; if (_sp > XB_SPIN_CAP) { atomicAdd(&(bar)[XB_TMO], 1u); break; } } } } while (0)
struct XcdBarrier { unsigned* bar; unsigned x; volatile LAS unsigned* st; };
__device__ __forceinline__ XcdBarrier xcd_barrier_post(unsigned* bar, volatile LAS unsigned* st) {
    XcdBarrier b; b.bar = bar; b.x = xb_xcc_id(); b.st = st;
    if (threadIdx.x == 0) (void)xb_add(&bar[XB_XCNT(b.x)], 1u);
    return b;
}
__device__ __forceinline__ void xcd_barrier_complete(unsigned* bar, unsigned x, unsigned& nloc, unsigned& nx) {
    const unsigned G = gridDim.x * gridDim.y * gridDim.z;
    unsigned sum, cnt, mine, sp = 0u;
    for (;;) {
        sum = 0u; cnt = 0u; mine = 0u;
#pragma unroll
        for (unsigned j = 0; j < 16; ++j) { const unsigned c = xb_ld(&bar[XB_XCNT(j)]); sum += c; cnt += (c > 0u) ? 1u : 0u; mine = (j == x) ? c : mine; }
        if (sum == G) break;
        __builtin_amdgcn_s_sleep(1);
        if ((++sp & 255u) == 0u) { if (xb_ld(&bar[XB_TMO])) break; if (sp > XB_SPIN_CAP) { atomicAdd(&bar[XB_TMO], 1u); break; } }
    }
    nloc = mine > 0u ? mine : 1u; nx = cnt > 0u ? cnt : 1u;
}
__device__ __forceinline__ void xcd_barrier(const XcdBarrier& b) {
    asm volatile("s_waitcnt vmcnt(0)" ::: "memory");
    __syncthreads();
    if (threadIdx.x == 0) {
        unsigned* bar = b.bar;
        __builtin_amdgcn_s_waitcnt(0);
        unsigned nloc = b.st[0], nx = b.st[1];
        if (nloc == 0u) { xcd_barrier_complete(bar, b.x, nloc, nx); b.st[0] = nloc; b.st[1] = nx; }
        const unsigned old = xb_add(&bar[XB_XSUB(b.x)], 1u);
        const unsigned gen = old / nloc;
        if (old + 1u == (gen + 1u) * nloc) {
            __builtin_amdgcn_fence(__ATOMIC_RELEASE, "agent");
            asm volatile("s_waitcnt vmcnt(0)" ::: "memory");
            const unsigned og = xb_add(&bar[XB_TOP], 1u);
            const unsigned tg = og / nx;
            if (og + 1u == (tg + 1u) * nx) xb_add(&bar[XB_TOPGEN], 1u);
            else XB_SPIN(xb_ld(&bar[XB_TOPGEN]) == tg, bar);
            __builtin_amdgcn_fence(__ATOMIC_ACQUIRE, "agent");
            xb_add(&bar[XB_XGEN(b.x)], 1u);
            asm volatile("s_waitcnt vmcnt(0)" ::: "memory");
        } else {
            XB_SPIN(xb_ld(&bar[XB_XGEN(b.x)]) == gen, bar);
            __builtin_amdgcn_fence(__ATOMIC_ACQUIRE, "agent");
            asm volatile("s_waitcnt vmcnt(0)" ::: "memory");
        }
    }
    __syncthreads();
}

template <bool COOP>
__global__ void __launch_bounds__(512, 2) mk_fwd(Params P) {
    extern __shared__ __attribute__((aligned(16))) unsigned char lds_raw[];
    LAS unsigned char* lds = (LAS unsigned char*)lds_raw;
    const int tid = threadIdx.x, lane = tid & 63, wave = __builtin_amdgcn_readfirstlane(tid >> 6);
    const int G = gridDim.x, bx = blockIdx.x;
    const int gw = bx * 8 + wave, NGW = G * 8;
    unsigned char* ws = P.ws;
    float* out = P.out;
    typedef const float* cfp_t; typedef __attribute__((address_space(4))) const cfp_t* kargp_t;
#define INP(i) ({ kargp_t kp_ = (kargp_t)__builtin_amdgcn_kernarg_segment_ptr(); asm volatile("" : "+s"(kp_)); kp_[i]; })
#define out_ka (out + (size_t)MTOK * DM)
#define out_va (out + (size_t)MTOK * DM + NCTX * 128)
#define out_kc (out + (size_t)MTOK * DM + NCTX * 256)
#define out_vc (out + (size_t)MTOK * DM + NCTX * 512)
#define mod ((float*)(ws + WS_MOD))
#define ss0 ((float*)(ws + WS_SS0))
#define ss1 ((float*)(ws + WS_SS1))
#define ss2 ((float*)(ws + WS_SS2))
#define ss3 ((float*)(ws + WS_SS3))
#define ssv ((float*)(ws + WS_SSV))
#define rope ((float*)(ws + WS_ROPE))
#define biasw ((float*)(ws + WS_BIAS))
#define ZB ((float*)(ws + WS_ZB))
#define CK_A ((bf16_t*)(ws + WS_CK_A))
#define CVT_A ((bf16_t*)(ws + WS_CVT_A))
#define CK_C ((bf16_t*)(ws + WS_CK_C))
#define CVT_C ((bf16_t*)(ws + WS_CVT_C))
#define W_INE ((bf16_t*)(ws + WS_W_INE))
#define W_OUTE ((bf16_t*)(ws + WS_W_OUTE))
#define W_INO ((bf16_t*)(ws + WS_W_INO))
#define W_OUTO ((bf16_t*)(ws + WS_W_OUTO))
#define W_UP ((bf16_t*)(ws + WS_W_UP))
#define W_DN ((bf16_t*)(ws + WS_W_DN))
#define Abuf ((bf16_t*)(ws + WS_A))
#define ACT ((bf16_t*)(ws + WS_ACT))
#define MIX ((bf16_t*)(ws + WS_MIX))
#define Qb ((bf16_t*)(ws + WS_Q))
#define KE ((bf16_t*)(ws + WS_KE))
#define VTE ((bf16_t*)(ws + WS_VTE))
#define VBT ((bf16_t*)(ws + WS_VBT))
#define KO ((bf16_t*)(ws + WS_KO))
#define VTO ((bf16_t*)(ws + WS_VTO))
    LAS float* spare = (LAS float*)(lds + LDS_SPARE);

    const int lo = P.ph_lo, hi = P.ph_hi;
#define TSTAMP(k) do { if (MK_TP_LO >= 0 && blockIdx.x == 0 && threadIdx.x == 0) { if ((k) == MK_TP_LO) ((unsigned long long*)(P.ws + WS_TS))[0] = __builtin_amdgcn_s_memrealtime(); if ((k) == MK_TP_HI + 1) ((unsigned long long*)(P.ws + WS_TS))[1] = __builtin_amdgcn_s_memrealtime(); } } while (0)
    XcdBarrier xbar; xbar.bar = (unsigned*)(ws + WS_BAR); xbar.x = 0; xbar.st = (volatile LAS unsigned*)(lds + LDS_SPARE + 12288);
    if constexpr (COOP) {
        if (tid < 2) ((LAS unsigned*)(lds + LDS_SPARE + 12288))[tid] = 0u;
        __syncthreads();
        xbar = xcd_barrier_post((unsigned*)(ws + WS_BAR), (volatile LAS unsigned*)(lds + LDS_SPARE + 12288));
        if (P.ph_lo < 0) cg::this_grid().sync();
    }
#ifndef MK_PHMASK
#define MK_PHMASK 0x7fff
#endif
#define IN(k) ((((MK_PHMASK) >> (k)) & 1) && lo <= (k) && (k) < hi)
#define SEAM(k) do { if constexpr (COOP) { if (IN(k) && IN((k) + 1)) { xcd_barrier(xbar); } } } while (0)

    if constexpr (!COOP) { TSTAMP(lo); }
    if (IN(0)) {
        const float* c_in = INP(6); const float* c_ctx = INP(7); const float* w_mod = INP(8); const float* b_mod = INP(9);
        for (int it = bx; it < 2 * 24 * 16; it += G) {
            const int l = it / 384, cbk = (it % 384) / 16, ksp = it % 16;
            __syncthreads();
            for (int i = tid; i < NCOND * 64; i += 512) { const int cd = i >> 6, k = ksp * 64 + (i & 63); const float v = cd == 0 ? c_ctx[k] : c_in[(cd - 1) * DM + k]; spare[i] = v / (1.0f + __expf(-v)); }
            __syncthreads();
            const int col = cbk * 256 + (tid & 255), kh = tid >> 8;
            float a[NCOND];
#pragma unroll
            for (int cd = 0; cd < NCOND; ++cd) a[cd] = 0.f;
            const float* wp = w_mod + ((size_t)l * DM + ksp * 64 + kh * 32) * MODW + col;
#pragma unroll 1
            for (int k0 = 0; k0 < 32; k0 += 8) {
                float wv[8];
#pragma unroll
                for (int k = 0; k < 8; ++k) wv[k] = wp[(size_t)(k0 + k) * MODW];
#pragma unroll
                for (int k = 0; k < 8; ++k) {
#pragma unroll
                    for (int cd = 0; cd < NCOND; ++cd) a[cd] += spare[cd * 64 + kh * 32 + k0 + k] * wv[k]; }
            }
            const float bm = (ksp == 0 && kh == 0) ? b_mod[l * MODW + col] : 0.f;
#pragma unroll
            for (int cd = 0; cd < NCOND; ++cd) atomicAdd(mod + ((size_t)l * NCOND + cd) * MODW + col, a[cd] + bm);
        }
        __syncthreads();
        {
            const float* w_in_even = INP(10); const float* w_out_even = INP(16); const float* w_in_odd = INP(17); const float* w_out_odd = INP(21); const float* w_up = INP(22); const float* w_down = INP(25);
            LAS float* scr = (LAS float*)(lds + wave * 16384);
            constexpr int I_INE = 16 * 56, I_OUT = 16 * 32, I_INO = 16 * 48, I_UP = 16 * 176, I_DN = 44 * 32;
            constexpr int NIT = I_INE + 2 * I_OUT + I_INO + 2 * I_UP + 2 * I_DN;
            for (int it = gw; it < NIT; it += NGW) {
                int r = it;
                if (r < I_INE) { const int kb = r / 56, nb = r % 56; transpose_item(w_in_even, DM, EVEN_IN, W_INE, 64 * kb, 32 * nb, perm_in(32 * nb), scr, lane); continue; } r -= I_INE;
                if (r < I_OUT) { const int kb = r / 32, nb = r % 32; transpose_item(w_out_even, DM, DM, W_OUTE, 64 * kb, 32 * nb, 32 * nb, scr, lane); continue; } r -= I_OUT;
                if (r < I_INO) { const int kb = r / 48, nb = r % 48; transpose_item(w_in_odd, DM, ODD_IN, W_INO, 64 * kb, 32 * nb, perm_in(32 * nb), scr, lane); continue; } r -= I_INO;
                if (r < I_OUT) { const int kb = r / 32, nb = r % 32; transpose_item(w_out_odd, DM, DM, W_OUTO, 64 * kb, 32 * nb, 32 * nb, scr, lane); continue; } r -= I_OUT;
                if (r < 2 * I_UP) { const int l = r / I_UP, q = r % I_UP, kb = q / 176, nb = q % 176; transpose_item(w_up + (size_t)l * DM * FF2, DM, FF2, W_UP + (size_t)l * FF2 * DM, 64 * kb, 32 * nb, perm_up(32 * nb), scr, lane); continue; } r -= 2 * I_UP;
                { const int l = r / I_DN, q = r % I_DN, kb = q / 32, nb = q % 32; transpose_item(w_down + (size_t)l * FF * DM, FF, DM, W_DN + (size_t)l * DM * FF, 64 * kb, 32 * nb, 32 * nb, scr, lane); }
            }
        }
        {
            const float* cache_k_attn = INP(2); const float* cache_v_attn = INP(3); const float* cache_k_swa = INP(4); const float* cache_v_swa = INP(5);
            const int gt = bx * 512 + tid, NT_ = G * 512;
            for (int i = gt; i < 8 * 512 * 128 / 4; i += NT_) { const f32x4 v = *(const f32x4*)(cache_k_attn + (size_t)i * 4); *(u32x2*)(CK_A + (size_t)i * 4) = (u32x2){pk2(v[0], v[1]), pk2(v[2], v[3])}; }
            for (int i = gt; i < 8 * 512 * 256 / 4; i += NT_) { const f32x4 v = *(const f32x4*)(cache_k_swa + (size_t)i * 4); *(u32x2*)(CK_C + (size_t)i * 4) = (u32x2){pk2(v[0], v[1]), pk2(v[2], v[3])}; }
            for (int i = gt; i < 8 * 64 * 128; i += NT_) { const int cd = i & 127, pc = (i >> 7) & 63, b = i >> 13; const float* s = cache_v_attn + ((size_t)b * 512 + pc * 8) * 128 + cd;
                u32x4 o; o.x = pk2(s[0], s[128]); o.y = pk2(s[256], s[384]); o.z = pk2(s[512], s[640]); o.w = pk2(s[768], s[896]);
                *(u32x4*)(CVT_A + ((size_t)b * 128 + cd) * 512 + pc * 8) = o; }
            for (int i = gt; i < 8 * 64 * 256; i += NT_) { const int cd = i & 255, pc = (i >> 8) & 63, b = i >> 14; const float* s = cache_v_swa + ((size_t)b * 512 + pc * 8) * 256 + cd;
                u32x4 o; o.x = pk2(s[0], s[256]); o.y = pk2(s[512], s[768]); o.z = pk2(s[1024], s[1280]); o.w = pk2(s[1536], s[1792]);
                *(u32x4*)(CVT_C + ((size_t)b * 256 + cd) * 512 + pc * 8) = o; }
            if (gt < 1024) { const int pos = gt >> 4, f = gt & 15; const float inv = exp2f(-(float)f * (13.287712379549449f / 16.0f)); const float ang = (float)pos * inv;
                rope[gt * 2] = cosf(ang); rope[gt * 2 + 1] = sinf(ang); }
        }
    }
    SEAM(0);
    if (IN(1)) {
        const float* x_prompt = INP(0); const float* x_sample = INP(1);
        for (int row0 = gw; row0 < MTOK; row0 += 2 * NGW) {
            f32x4 v[2][4]; float sq[2];
#pragma unroll
            for (int u = 0; u < 2; ++u) {
                const int row = row0 + u * NGW; sq[u] = 0.f;
                if (row < MTOK) {
                    const float* xr = row < NCTX ? x_prompt + (size_t)row * DM : x_sample + (size_t)(row - NCTX) * DM;
#pragma unroll
                    for (int j = 0; j < 4; ++j) v[u][j] = *(const f32x4*)(xr + 256 * j + 4 * lane);
                }
            }
#pragma unroll
            for (int u = 0; u < 2; ++u) {
                if (row0 + u * NGW < MTOK) {
#pragma unroll
                    for (int j = 0; j < 4; ++j) sq[u] += (v[u][j][0] * v[u][j][0] + v[u][j][1] * v[u][j][1]) + (v[u][j][2] * v[u][j][2] + v[u][j][3] * v[u][j][3]);
                }
            }
#pragma unroll
            for (int o = 1; o < 64; o <<= 1) { sq[0] += __shfl_xor(sq[0], o); sq[1] += __shfl_xor(sq[1], o); }
#pragma unroll
            for (int u = 0; u < 2; ++u) {
                const int row = row0 + u * NGW;
                if (row < MTOK) {
                    const int cond = row < NCTX ? 0 : 1 + ((row - NCTX) >> 11);
                    const float* sc = mod + (size_t)cond * MODW + 1024;
                    if (lane == 0) ss0[row] = sq[u];
#pragma unroll
                    for (int j = 0; j < 4; ++j) { const f32x4 s4 = *(const f32x4*)(sc + 256 * j + 4 * lane); const f32x4 h = v[u][j] * (s4 + 1.0f);
                        *(u32x2*)(Abuf + (size_t)row * DM + 256 * j + 4 * lane) = (u32x2){cvt_pk_bf16(h[0], h[1]), cvt_pk_bf16(h[2], h[3])}; }
                }
            }
        }
        constexpr int NB0 = 1792 / 16, NB1 = 5632 / 16, NB2 = 1536 / 16, NBT = NB0 + 2 * NB1 + NB2;
        for (int it = gw; it < NCOND * NBT; it += NGW) {
            const int cond = it / NBT; int r = it % NBT;
            const bf16_t* Wt; const float* sh; float* dst; int N;
            if (r < NB0) { Wt = W_INE; sh = mod + (size_t)cond * MODW; dst = biasw + BIAS_INE; N = 1792; }
            else if ((r -= NB0) < NB1) { Wt = W_UP; sh = mod + (size_t)cond * MODW + 3072; dst = biasw + BIAS_UP0; N = 5632; }
            else if ((r -= NB1) < NB2) { Wt = W_INO; sh = mod + (size_t)(NCOND + cond) * MODW; dst = biasw + BIAS_INO; N = 1536; }
            else { r -= NB2; Wt = W_UP + (size_t)FF2 * DM; sh = mod + (size_t)(NCOND + cond) * MODW + 3072; dst = biasw + BIAS_UP1; N = 5632; }
            float sv[16];
#pragma unroll
            for (int j = 0; j < 4; ++j) { const f32x4 t4 = *(const f32x4*)(sh + 16 * lane + 4 * j); sv[4 * j] = t4[0]; sv[4 * j + 1] = t4[1]; sv[4 * j + 2] = t4[2]; sv[4 * j + 3] = t4[3]; }
            for (int n = 0; n < 16; n += 8) {
                float d[8];
#pragma unroll
                for (int q = 0; q < 8; ++q) {
                    const bf16_t* wr_ = Wt + (size_t)(r * 16 + n + q) * DM + 16 * lane;
                    const u32x4 w0 = *(const u32x4*)wr_, w1 = *(const u32x4*)(wr_ + 8);
                    float dd = 0.f;
#pragma unroll
                    for (int j = 0; j < 4; ++j) { dd += sv[2 * j] * __uint_as_float(w0[j] << 16) + sv[2 * j + 1] * __uint_as_float(w0[j] & 0xffff0000u); dd += sv[8 + 2 * j] * __uint_as_float(w1[j] << 16) + sv[8 + 2 * j + 1] * __uint_as_float(w1[j] & 0xffff0000u); }
                    d[q] = dd;
                }
#pragma unroll
                for (int o = 1; o < 64; o <<= 1) {
#pragma unroll
                    for (int q = 0; q < 8; ++q) d[q] += __shfl_xor(d[q], o);
                }
                if (lane == 0) {
#pragma unroll
                    for (int q = 0; q < 8; ++q) dst[(size_t)cond * N + r * 16 + n + q] = d[q];
                }
            }
        }
    }
    SEAM(1);
    pg8::StaticOrder S;
    for (int ph = (lo > 2 ? lo : 2); ph < hi; ++ph) {
        if (((MK_PHMASK >> ph) & 1) != 0) {
#pragma unroll 1
        for (int slot_ = 0; slot_ < 3; ++slot_) {
            const int slot = ((ph == 4 || ph == 10) && (bx & 1) && slot_ < 2) ? 1 - slot_ : slot_;
            int st = -1, pm0 = 32, nM = 64, c0 = 0, nc = G;
            const bool g256 = (G == 256);
            switch (ph * 4 + slot) {
                case 2 * 4 + 0: st = 0; break;
                case 2 * 4 + 1: st = 0; pm0 = 0; nM = 9; if (g256) { c0 = 192; nc = 64; } break;
                case 3 * 4 + 0: st = 1; break;
                case 3 * 4 + 1: st = 0; pm0 = 9; nM = 23; if (g256) nc = 168; break;
                case 4 * 4 + 0: st = 2; break;
                case 4 * 4 + 1: st = 1; pm0 = 0; nM = 32; break;
                case 5 * 4 + 0: st = 3; break;
                case 5 * 4 + 1: st = 2; pm0 = 0; nM = 32; if (g256) { c0 = 128; nc = 128; } break;
                case 6 * 4 + 0: st = 4; break;
                case 7 * 4 + 0: st = 5; break;
                case 7 * 4 + 1: st = 3; pm0 = 0; nM = 32; break;
                case 8 * 4 + 0: st = 6; if (g256) { c0 = 128; nc = 128; } break;
                case 8 * 4 + 1: st = 5; pm0 = 0; nM = 32; if (g256) nc = 128; break;
                case 9 * 4 + 0: st = 7; break;
                case 9 * 4 + 1: st = 6; pm0 = 0; nM = 32; if (g256) nc = 192; break;
                case 10 * 4 + 0: st = 8; break;
                case 10 * 4 + 1: st = 7; pm0 = 0; nM = 32; break;
                case 11 * 4 + 0: st = 9; break;
                case 11 * 4 + 1: st = 8; pm0 = 0; nM = 32; if (g256) { c0 = 128; nc = 128; } break;
                case 12 * 4 + 0: st = 10; break;
                case 13 * 4 + 0: st = 11; pm0 = 32; nM = 32; if (g256) { c0 = 128; nc = 128; } break;
                case 13 * 4 + 1: st = 9; pm0 = 0; nM = 23; if (g256) nc = 128; break;
                case 13 * 4 + 2: st = 9; pm0 = 23; nM = 9; if (g256) { c0 = 128; nc = 128; } break;
                case 14 * 4 + 0: st = 11; pm0 = 64; nM = 32; if (g256) { c0 = 128; nc = 128; } break;
                case 14 * 4 + 1: st = 11; pm0 = 0; nM = 32; if (g256) nc = 128; break;
                default: break;
            }
            const bool lat = pm0 >= 32;
            if (st < 0) continue;
            unsigned char* ws = P.ws; asm volatile("" : "+s"(ws));
            float* out = P.out; asm volatile("" : "+s"(out));
            int tid = threadIdx.x; asm volatile("" : "+v"(tid));
            LAS unsigned char* lds = (LAS unsigned char*)lds_raw; { unsigned l_ = (unsigned)(uintptr_t)lds; asm volatile("" : "+s"(l_)); lds = (LAS unsigned char*)(uintptr_t)l_; }
            LAS float* spare = (LAS float*)(lds + LDS_SPARE);
            const int rel = (bx - c0 + G) % G;
            const int L = st >= 6 ? 1 : 0;
            float* modL = mod + (size_t)L * NCOND * MODW;
            if (st == 0) {
                pg8::Gemm g{Abuf, W_INE, MTOK, EVEN_IN, DM}; S.init(pm0, nM, EVEN_IN, G, bx, c0, nc);
                EpiIn<true> E{ws, out, INP(11), INP(12)};
                pg8::gemm_phase<EpiIn<true>, true>(lds, g, S, E, tid);
            } else if (st == 6) {
                pg8::Gemm g{Abuf, W_INO, MTOK, ODD_IN, DM}; S.init(pm0, nM, ODD_IN, G, bx, c0, nc);
                EpiIn<false> E{ws, out, INP(18), INP(19)};
                pg8::gemm_phase<EpiIn<false>, true>(lds, g, S, E, tid);
            } else if (st == 2 || st == 5 || st == 8 || st == 11) {
                const bool dn = (st == 5 || st == 11);
                pg8::Gemm g{dn ? ACT : MIX, dn ? W_DN + (size_t)L * DM * FF : (L ? W_OUTO : W_OUTE), MTOK, DM, dn ? FF : DM}; S.init(pm0, nM, DM, G, bx, c0, nc);
                EpiRes E;
                if (st == 2) { E.xp = INP(0); E.xs = INP(1); } else { E.xp = out; E.xs = out + (size_t)NCTX * DM; }
                E.out = out; E.gate = modL + (dn ? 5120 : 2048);
                E.nscale = st == 11 ? nullptr : (dn ? mod + (size_t)NCOND * MODW + 1024 : modL + 4096);
                E.An = st == 11 ? nullptr : Abuf;
                E.ssn = st == 2 ? ss1 : st == 5 ? ss2 : st == 8 ? ss3 : nullptr;
                pg8::gemm_phase<EpiRes, true>(lds, g, S, E, tid);
            } else if (st == 3 || st == 9) {
                pg8::Gemm g{Abuf, W_UP + (size_t)L * FF2 * DM, MTOK, FF2, DM}; S.init(pm0, nM, FF2, G, bx, c0, nc);
                EpiUp E{ws, (unsigned)(L ? WS_SS3 : WS_SS1), (unsigned)(L ? BIAS_UP1 : BIAS_UP0), INP(23) + (size_t)L * 3 * FF2, INP(24) + (size_t)L * FF2, spare};
                pg8::gemm_phase<EpiUp, true>(lds, g, S, E, tid);
            } else if (st == 4 || st == 10) {
                if (lat) {
                    const float* cw = INP(23) + (size_t)L * 3 * FF2; const float* cb = INP(24) + (size_t)L * FF2;
                    for (int i = bx * 512 + tid; i < 8 * 7 * 2 * FF; i += G * 512) {
                        const int ch = i % FF, rs = i / FF, which = rs & 1, sm = (rs >> 1) % 7, b = rs / 14;
                        const int pmA = 32 + b * 8 + sm;
                        const int zc = (ch >> 7) * 256 + (ch & 127);
                        const float* zA = ZB + (size_t)pmA * 4 * FF2; const float* zB = ZB + (size_t)(pmA + 1) * 4 * FF2;
                        float ra, rg;
                        if (which == 0) {
                            ra = cb[ch] + cw[ch] * zA[2 * FF2 + zc] + cw[FF2 + ch] * zA[3 * FF2 + zc] + cw[2 * FF2 + ch] * zB[zc];
                            rg = cb[FF + ch] + cw[FF + ch] * zA[2 * FF2 + zc + 128] + cw[FF2 + FF + ch] * zA[3 * FF2 + zc + 128] + cw[2 * FF2 + FF + ch] * zB[zc + 128];
                        } else {
                            ra = cb[ch] + cw[ch] * zA[3 * FF2 + zc] + cw[FF2 + ch] * zB[zc] + cw[2 * FF2 + ch] * zB[FF2 + zc];
                            rg = cb[FF + ch] + cw[FF + ch] * zA[3 * FF2 + zc + 128] + cw[FF2 + FF + ch] * zB[zc + 128] + cw[2 * FF2 + FF + ch] * zB[FF2 + zc + 128];
                        }
                        const int row = pmA * 256 + 255 + which;
                        ACT[(size_t)row * FF + ch] = (bf16_t)(cvt_pk_bf16(ra * silu_f(rg), 0.f) & 0xffffu);
                    }
                }
            } else if (st == 1) {
                const float* w_spatial = INP(14); const float* b_spatial = INP(15); const float* v_norm_b = INP(13);
                if (lat) {
                    for (int it = rel; it < 512; it += nc) {
                        const int b = it >> 6, h = (it >> 3) & 7, qb = it & 7, kvh = h >> 2;
                        const size_t row0 = NCTX + (size_t)b * 2048 + qb * 256;
                        attn_unit(lds, Qb + row0 * 512 + h * 64, 512, MIX + row0 * DM + h * 64, DM,
                                  KE + ((size_t)NCTX + (size_t)b * 2048) * 128 + kvh * 64, 128, VTE + (size_t)NCTX * 128 + (size_t)(b * 2 + kvh) * 64 * 2048, 2048, 0, 32,
                                  CK_A + (size_t)b * 512 * 128 + kvh * 64, 128, CVT_A + (size_t)(b * 2 + kvh) * 64 * 512, 512, 8, 0.f, 0.f, -1, tid);
                    }
                    if (G == 256) {
                        if (bx >= 168) { for (int j = 0; j < 4; ++j) { const int e = (bx - 168) * 4 + j; spatial_unit(lds, 64 + (e >> 2), e & 3, w_spatial, b_spatial, v_norm_b, ssv, VBT, MIX, tid); } }
                        else if (bx < 160) { const int e = 352 + bx; spatial_unit(lds, 64 + (e >> 2), e & 3, w_spatial, b_spatial, v_norm_b, ssv, VBT, MIX, tid); }
                    } else {
                        for (int e = rel; e < 512; e += nc) spatial_unit(lds, 64 + (e >> 2), e & 3, w_spatial, b_spatial, v_norm_b, ssv, VBT, MIX, tid);
                    }
                } else {
                    for (int it = rel; it < 256 + 256; it += nc) {
                        if (it < 256) {
                            const int b = it >> 3, h = it & 7, kvh = h >> 2;
                            const size_t row0 = (size_t)b * 256;
                            attn_unit(lds, Qb + row0 * 512 + h * 64, 512, MIX + row0 * DM + h * 64, DM,
                                      KE + row0 * 128 + kvh * 64, 128, VTE + (size_t)(b * 2 + kvh) * 64 * 256, 256, 0, 4,
                                      nullptr, 0, nullptr, 0, 0, 0.f, 0.f, -1, tid);
                        } else { const int e = it - 256; spatial_unit(lds, e >> 2, e & 3, w_spatial, b_spatial, v_norm_b, ssv, VBT, MIX, tid); }
                    }
                }
            } else if (st == 7) {
                const float* sink_c = INP(20);
                if (lat) {
                    for (int it = rel; it < 1024; it += nc) {
                        const int b = it >> 7, h = (it >> 3) & 15, qb = it & 7, kvh = h >> 2;
                        const size_t row0 = NCTX + (size_t)b * 2048 + qb * 256;
                        const int q0 = qb * 256; int klo = q0 - 128; if (klo < 0) klo = 0; int khi = q0 + 384; if (khi > 2048) khi = 2048;
                        attn_unit(lds, Qb + row0 * 1024 + h * 64, 1024, MIX + row0 * DM + h * 64, DM,
                                  KO + ((size_t)NCTX + (size_t)b * 2048) * 256 + kvh * 64, 256, VTO + (size_t)NCTX * 256 + (size_t)(b * 4 + kvh) * 64 * 2048, 2048, klo >> 6, (khi - klo) >> 6,
                                  CK_C + (size_t)b * 512 * 256 + kvh * 64, 256, CVT_C + (size_t)(b * 4 + kvh) * 64 * 512, 512, 8, sink_c[h] * LOG2E, 1.0f, q0, tid);
                    }
                } else {
                    for (int it = rel; it < 512; it += nc) {
                        const int b = it >> 4, h = it & 15, kvh = h >> 2;
                        const size_t row0 = (size_t)b * 256;
                        attn_unit(lds, Qb + row0 * 1024 + h * 64, 1024, MIX + row0 * DM + h * 64, DM,
                                  KO + row0 * 256 + kvh * 64, 256, VTO + (size_t)(b * 4 + kvh) * 64 * 256, 256, 0, 4,
                                  nullptr, 0, nullptr, 0, 0, sink_c[h] * LOG2E, 1.0f, -1, tid);
                    }
                }
            }
        }
        }
        if constexpr (COOP) {
            if (ph + 1 < hi) { XcdBarrier xb = xbar; asm volatile("" : "+s"(xb.bar), "+s"(xb.x)); xcd_barrier(xb); }
        }
    }
    if (!COOP && MK_TP_LO >= 0 && lo == 14 && blockIdx.x == 0 && threadIdx.x == 0) {
        const unsigned long long* ts = (const unsigned long long*)(P.ws + WS_TS);
        float* o = P.out + (size_t)MTOK * DM;
        o[0] += (float)(ts[1] - ts[0]) * 1e-4f;
    }
#undef IN
#undef SEAM
}

constexpr int N_PHASES = 15;

extern "C" void kernel_launch(void* const* d_in, const int* in_sizes, int n_in, void* d_out, int out_size, void* d_ws, size_t ws_size, hipStream_t stream) {
    static int grid = 0;
    if (grid == 0) {
        int dev = 0, cus = 0;
        hipGetDevice(&dev);
        hipDeviceGetAttribute(&cus, hipDeviceAttributeMultiprocessorCount, dev);
        hipFuncSetAttribute((const void*)mk_fwd<true>, hipFuncAttributeMaxDynamicSharedMemorySize, LDS_BYTES);
        hipFuncSetAttribute((const void*)mk_fwd<false>, hipFuncAttributeMaxDynamicSharedMemorySize, LDS_BYTES);
        int per_cu = 0;
        hipOccupancyMaxActiveBlocksPerMultiprocessor(&per_cu, (const void*)mk_fwd<true>, 512, LDS_BYTES);
        (void)hipGetLastError();
        if (per_cu < 1) fprintf(stderr, "kernel_launch: occupancy query says %d blocks/CU\n", per_cu);
        grid = cus > 0 ? cus : 256;
        if (n_in != 26 || ws_size < WS_END) { fprintf(stderr, "kernel_launch: unexpected n_in %d / ws %zu\n", n_in, ws_size); }
    }
    hipMemsetAsync((char*)d_ws, 0, WS_ZERO_BYTES, stream);
    Params p{};
    for (int i = 0; i < 26; ++i) p.in[i] = (const float*)d_in[i];
    p.out = (float*)d_out; p.ws = (unsigned char*)d_ws;
#if MK_COOP
    p.ph_lo = 0; p.ph_hi = N_PHASES;
    void* args[] = {&p};
    hipError_t e = hipLaunchCooperativeKernel((const void*)mk_fwd<true>, dim3(grid), dim3(512), args, LDS_BYTES, stream);
    if (e != hipSuccess) fprintf(stderr, "cooperative launch failed: %s (grid %d)\n", hipGetErrorString(e), grid);
#else
    for (int ph = 0; ph < N_PHASES; ++ph) {
        p.ph_lo = ph; p.ph_hi = ph + 1;
        hipLaunchKernelGGL(mk_fwd<false>, dim3(grid), dim3(512), LDS_BYTES, stream, p);
        if (ph == MK_DUP) hipLaunchKernelGGL(mk_fwd<false>, dim3(grid), dim3(512), LDS_BYTES, stream, p);
    }
#endif
}
```

```cpp
#include <hip/hip_runtime.h>
#include <hip/hip_cooperative_groups.h>
#include <cstdio>
#include <cstdint>
namespace cg = cooperative_groups;

#ifndef MK_COOP
#define MK_COOP 1
#endif

#ifndef MK_DUP
#define MK_DUP -1
#endif
#ifndef MK_TP_LO
#define MK_TP_LO -1
#define MK_TP_HI -1
#endif
#define LAS __attribute__((address_space(3)))
typedef unsigned short bf16_t;
typedef short bf16x8 __attribute__((ext_vector_type(8)));
typedef short s16x4 __attribute__((ext_vector_type(4)));
typedef float f32x4 __attribute__((ext_vector_type(4)));
typedef float f32x2 __attribute__((ext_vector_type(2)));
typedef float f32x16 __attribute__((ext_vector_type(16)));
typedef unsigned u32x4 __attribute__((ext_vector_type(4)));
typedef unsigned u32x2 __attribute__((ext_vector_type(2)));

constexpr int DM = 1024, NCTX = 8192, NLAT = 16384, MTOK = 24576;
constexpr int EVEN_IN = 1792, ODD_IN = 1536, FF = 2816, FF2 = 5632;
constexpr int NCOND = 9, MODW = 6144;
constexpr float EPS = 1e-6f;
constexpr float LOG2E = 1.4426950408889634f;

constexpr size_t MiB = 1u << 20;
constexpr size_t WS_MOD = 0;
constexpr size_t WS_SS1 = 442368, WS_SS2 = WS_SS1 + 98304, WS_SS3 = WS_SS2 + 98304, WS_SSV = WS_SS3 + 98304;
constexpr size_t WS_BAR = 900 * 1024;
constexpr size_t WS_ZERO_BYTES = 1 * MiB;
constexpr size_t WS_SS0 = 1 * MiB;
constexpr size_t WS_ROPE = 1 * MiB + 128 * 1024;
constexpr size_t WS_TS = 1 * MiB + 192 * 1024;
constexpr size_t WS_BIAS = 1 * MiB + 256 * 1024;
constexpr size_t WS_ZB = 2 * MiB;
constexpr size_t WS_CK_A = 11 * MiB, WS_CVT_A = 12 * MiB, WS_CK_C = 13 * MiB, WS_CVT_C = 15 * MiB;
constexpr size_t WS_W_INE = 18 * MiB, WS_W_OUTE = 22 * MiB, WS_W_INO = 24 * MiB, WS_W_OUTO = 27 * MiB, WS_W_UP = 29 * MiB, WS_W_DN = 51 * MiB;
constexpr size_t WS_A = 62 * MiB;
constexpr size_t WS_BIG = 110 * MiB;
constexpr size_t WS_ACT = WS_BIG;
constexpr size_t WS_MIX = WS_BIG;
constexpr size_t WS_Q = WS_BIG + 48 * MiB;
constexpr size_t WS_KE = WS_Q + 24 * MiB, WS_VTE = WS_KE + 6 * MiB, WS_VBT = WS_VTE + 6 * MiB;
constexpr size_t WS_KO = WS_Q + 48 * MiB, WS_VTO = WS_KO + 12 * MiB;
constexpr size_t WS_END = 256 * MiB;
static_assert(WS_VBT + 24 * MiB <= WS_END && WS_VTO + 12 * MiB <= WS_END && WS_ACT + 132 * MiB <= WS_END, "ws map");
constexpr size_t BIAS_INE = 0, BIAS_UP0 = 9 * 1792, BIAS_INO = BIAS_UP0 + 9 * 5632, BIAS_UP1 = BIAS_INO + 9 * 1536;

constexpr int LDS_BYTES = 147456;
constexpr int LDS_SPARE = 131072;

struct Params {
    const float* in[26];
    float* out;
    unsigned char* ws;
    int ph_lo, ph_hi;
};

namespace pg8 {
constexpr int BM = 256, BK = 64, HALF = 128, HTB = HALF * BK * 2, STAGE_BYTES = 8 * HTB, NXCD = 8, WGM = 8;
__host__ __device__ __forceinline__ int lds_byte(int r, int c) { const int st = (r >> 4) * 2 + (c >> 5), rr = r & 15, cc = c & 31, ob = rr * 64 + cc * 2; return st * 1024 + (ob ^ (((ob >> 9) & 1) << 5)); }
__host__ __device__ __forceinline__ void stage_rc(int b, int& R, int& C) { const int st = b / 1024, sb = b % 1024, swz = sb ^ (((sb >> 9) & 1) << 5); R = (st >> 1) * 16 + swz / 64; C = (st & 1) * 32 + (swz % 64) / 2; }
__host__ __device__ __forceinline__ int perm32(int rho) { const int n = rho >> 4, i = rho & 15; return 8 * (i >> 2) + 4 * n + (i & 3); }
struct Unit { int pm, pn; };
struct Gemm { const bf16_t* A; const bf16_t* Bt; int M, N, K; };
struct StaticOrder {
    int nM, nN, nwg, nc, rel, pm0;
    __device__ __forceinline__ void init(int pm0_, int nM_, int N, int G, int c, int c0, int nc_) { pm0 = pm0_; nM = nM_; nN = N / BM; nwg = nM * nN; nc = nc_; rel = (c - c0 + G) % G; }
    __device__ __forceinline__ bool next(int i, Unit& u) const {
        if (rel >= nc) return false;
        const long L = (long)i * nc + rel; if (L >= nwg) return false;
        int wgid = (int)L; { const int q = nwg / NXCD, r = nwg % NXCD, xcd = wgid % NXCD, off = wgid / NXCD; wgid = (xcd < r ? xcd * (q + 1) : r * (q + 1) + (xcd - r) * q) + off; }
        const int nig = WGM * nN, gid = wgid / nig, fm = gid * WGM, gsz = (nM - fm) < WGM ? (nM - fm) : WGM;
        u.pm = pm0 + fm + ((wgid % nig) % gsz); u.pn = (wgid % nig) / gsz; return true;
    }
};
__device__ __forceinline__ unsigned cvt_pk_bf16(float lo, float hi) { unsigned r; asm volatile("v_cvt_pk_bf16_f32 %0, %1, %2" : "=v"(r) : "v"(lo), "v"(hi)); return r; }

template <class Epi, bool ALIGN_EPI>
__device__ __forceinline__ void gemm_phase(LAS unsigned char* lds, const Gemm g, const StaticOrder& S, const Epi& E, const int tid) {
    const int wid = __builtin_amdgcn_readfirstlane(tid >> 6), lane = tid & 63, wr = wid >> 2, wc = wid & 3, fr = lane & 15, fq = lane >> 4;
    const int K = g.K, nt = K / BK;
    unsigned voffA[2], voffB[2];
#pragma unroll
    for (int i = 0; i < 2; ++i) { int R, C; stage_rc(tid * 16 + i * 8192, R, C); const int Rb = (R & ~31) + perm32(R & 31);
        voffA[i] = (unsigned)(R * K + C) * 2u; voffB[i] = (unsigned)(Rb * K + C) * 2u; }
    const size_t kstep = (size_t)(BK * 2);
    const size_t hstep = (size_t)HALF * K * 2;
    const size_t tstep = 2 * hstep;
    const unsigned ldsw = (unsigned)wid * 1024u;
    const int aoff = lds_byte(wr * 64 + fr, fq * 8), boff = lds_byte(wc * 32 + fr, fq * 8);
#define PG8_SA(b, h) (((b) * 2 + (h)) * HTB)
#define PG8_SB(b, h) ((4 + (b) * 2 + (h)) * HTB)
#define PG8_STAGE(bufoff, gbase, voff) do { _Pragma("unroll") for (int _i = 0; _i < 2; ++_i) \
        __builtin_amdgcn_global_load_lds((const unsigned*)((const char*)(gbase) + (voff)[_i]), (LAS unsigned*)(lds + (bufoff) + ldsw + _i * 8192), 16, 0, 0); } while (0)
#define PG8_LDA(dst, b, h) do { _Pragma("unroll") for (int m = 0; m < 4; ++m) _Pragma("unroll") for (int k = 0; k < 2; ++k) dst[m][k] = *(const LAS bf16x8*)(lds + PG8_SA(b, h) + aoff + m * 2048 + k * 1024); } while (0)
#define PG8_LDB(dst, b, h) do { _Pragma("unroll") for (int n = 0; n < 2; ++n) _Pragma("unroll") for (int k = 0; k < 2; ++k) dst[n][k] = *(const LAS bf16x8*)(lds + PG8_SB(b, h) + boff + n * 2048 + k * 1024); } while (0)
#define PG8_MMA(ai, bj, At, Bt) do { __builtin_amdgcn_s_setprio(1); _Pragma("unroll") for (int m = 0; m < 4; ++m) _Pragma("unroll") for (int n = 0; n < 2; ++n) _Pragma("unroll") for (int k = 0; k < 2; ++k) \
        acc[ai][bj][m][n] = __builtin_amdgcn_mfma_f32_16x16x32_bf16(Bt[n][k], At[m][k], acc[ai][bj][m][n], 0, 0, 0); __builtin_amdgcn_s_setprio(0); } while (0)
#define PG8_WAIT_V(n) asm volatile("s_waitcnt vmcnt(" #n ")" ::: "memory")
#define PG8_WAIT_L(n) asm volatile("s_waitcnt lgkmcnt(" #n ")" ::: "memory")
#define PG8_BAR __builtin_amdgcn_s_barrier()
#define PG8_SCHED __builtin_amdgcn_sched_barrier(0)
    Unit cur, nxt; int ui = 0;
    if (!S.next(0, cur)) return;
    f32x4 acc[2][2][4][2];
#pragma unroll
    for (int a = 0; a < 2; ++a)
#pragma unroll
        for (int b = 0; b < 2; ++b)
#pragma unroll
            for (int m = 0; m < 4; ++m)
#pragma unroll
                for (int n = 0; n < 2; ++n) acc[a][b][m][n] = (f32x4){0.f, 0.f, 0.f, 0.f};
    bf16x8 At[4][2], B0[2][2], B1[2][2];
    const char* cA = (const char*)g.A + (size_t)cur.pm * tstep; const char* cB = (const char*)g.Bt + (size_t)cur.pn * tstep;
    PG8_STAGE(PG8_SB(0, 0), cB, voffB); PG8_STAGE(PG8_SB(0, 1), cB + hstep, voffB); PG8_STAGE(PG8_SA(0, 0), cA, voffA); PG8_STAGE(PG8_SA(0, 1), cA + hstep, voffA);
    if (wr == 1) PG8_BAR;
    PG8_WAIT_V(2); PG8_BAR;
    PG8_STAGE(PG8_SB(1, 0), cB + kstep, voffB); PG8_STAGE(PG8_SA(1, 0), cA + kstep, voffA); PG8_STAGE(PG8_SB(1, 1), cB + hstep + kstep, voffB);
    PG8_WAIT_V(6); PG8_BAR;
    for (;;) {
        const bool has_next = S.next(ui + 1, nxt);
        const char* nA = has_next ? (const char*)g.A + (size_t)nxt.pm * tstep : cA; const char* nB = has_next ? (const char*)g.Bt + (size_t)nxt.pn * tstep : cB;
        for (int t = 0; t < nt; t += 2) {
            const bool last = (t == nt - 2);
            const char* a1 = cA + (size_t)(t + 1) * kstep;
            const char* a2 = last ? nA : cA + (size_t)(t + 2) * kstep; const char* b2 = last ? nB : cB + (size_t)(t + 2) * kstep;
            const char* a3 = a2 + kstep; const char* b3 = b2 + kstep;
            PG8_LDB(B0, 0, 0); PG8_LDB(B1, 0, 1); PG8_SCHED; PG8_LDA(At, 0, 0); PG8_STAGE(PG8_SA(1, 1), a1 + hstep, voffA);
            PG8_WAIT_V(8); PG8_WAIT_L(0); PG8_BAR; PG8_MMA(0, 0, At, B0); PG8_MMA(0, 1, At, B1); PG8_BAR; PG8_SCHED;
            PG8_LDA(At, 0, 1); PG8_STAGE(PG8_SB(0, 0), b2, voffB); PG8_STAGE(PG8_SB(0, 1), b2 + hstep, voffB); PG8_STAGE(PG8_SA(0, 0), a2, voffA);
            PG8_WAIT_V(8); PG8_WAIT_L(0); PG8_BAR; PG8_MMA(1, 0, At, B0); PG8_MMA(1, 1, At, B1); PG8_BAR; PG8_SCHED;
            PG8_LDB(B0, 1, 0); PG8_LDB(B1, 1, 1); PG8_SCHED; PG8_LDA(At, 1, 0); PG8_STAGE(PG8_SA(0, 1), a2 + hstep, voffA);
            PG8_WAIT_V(8); PG8_WAIT_L(0); PG8_BAR; PG8_MMA(0, 0, At, B0); PG8_MMA(0, 1, At, B1); PG8_BAR; PG8_SCHED;
            PG8_LDA(At, 1, 1); PG8_STAGE(PG8_SB(1, 0), b3, voffB); PG8_STAGE(PG8_SB(1, 1), b3 + hstep, voffB); PG8_STAGE(PG8_SA(1, 0), a3, voffA);
            PG8_WAIT_V(8); PG8_WAIT_L(0); PG8_BAR; PG8_MMA(1, 0, At, B0); PG8_MMA(1, 1, At, B1); PG8_BAR; PG8_SCHED;
        }
        typename Epi::Pre pre; E.prefetch(pre, cur, wr, wc, fr, fq);
        if constexpr (ALIGN_EPI) { if (wr == 0) PG8_BAR; }
        E(acc, cur, wr, wc, fr, fq, pre);
        if (!has_next) break;
#pragma unroll
        for (int a = 0; a < 2; ++a)
#pragma unroll
            for (int b = 0; b < 2; ++b)
#pragma unroll
                for (int m = 0; m < 4; ++m)
#pragma unroll
                    for (int n = 0; n < 2; ++n) acc[a][b][m][n] = (f32x4){0.f, 0.f, 0.f, 0.f};
        cur = nxt; cA = nA; cB = nB; ++ui;
        if constexpr (ALIGN_EPI) { if (wr == 1) PG8_BAR; }
    }
    PG8_WAIT_V(0);
    if constexpr (!ALIGN_EPI) { if (wr == 0) PG8_BAR; }
    PG8_BAR;
#undef PG8_SA
#undef PG8_SB
#undef PG8_STAGE
#undef PG8_LDA
#undef PG8_LDB
#undef PG8_MMA
#undef PG8_WAIT_V
#undef PG8_WAIT_L
#undef PG8_BAR
#undef PG8_SCHED
}
}

using pg8::cvt_pk_bf16;
typedef f32x4 (&AccRef)[2][2][4][2];

__device__ __forceinline__ int cond_of_tile(int pm) { return pm < 32 ? 0 : 1 + ((pm - 32) >> 3); }
__device__ __forceinline__ float red_fq(float v) { v += __shfl_xor(v, 16); v += __shfl_xor(v, 32); return v; }
__device__ __forceinline__ float gelu_tanh(float x) { const float u = x + 0.044715f * x * x * x; return x * __builtin_amdgcn_rcpf(1.0f + __builtin_amdgcn_exp2f(-2.302208198f * u)); }
__device__ __forceinline__ float silu_f(float x) { return x * __builtin_amdgcn_rcpf(1.0f + __builtin_amdgcn_exp2f(-LOG2E * x)); }
__device__ __forceinline__ u32x4 pack8(const f32x4 a, const f32x4 b) { u32x4 w; w.x = cvt_pk_bf16(a[0], a[1]); w.y = cvt_pk_bf16(a[2], a[3]); w.z = cvt_pk_bf16(b[0], b[1]); w.w = cvt_pk_bf16(b[2], b[3]); return w; }
__device__ __forceinline__ float bf2f(unsigned short h) { return __uint_as_float((unsigned)h << 16); }

template <class T> __device__ __forceinline__ T ldg(const void* base, unsigned off) { return *(const T*)((const char*)base + off); }
template <class T> __device__ __forceinline__ void stg(void* base, unsigned off, T v) { *(T*)((char*)base + off) = v; }
__device__ __forceinline__ float ss4(const f32x4 v) { return (v[0] * v[0] + v[1] * v[1]) + (v[2] * v[2] + v[3] * v[3]); }

struct EpiRes {
    const float* xp; const float* xs; float* out; const float* gate; const float* nscale; bf16_t* An; float* ssn;
    struct Pre { f32x4 x[2][2][2]; };
    __device__ __forceinline__ void prefetch(Pre& p, const pg8::Unit& u, int wr, int wc, int fr, int fq) const {
        const unsigned colbase = u.pn * 256 + wc * 32 + 8 * fq;
        const bool ctx = u.pm < 32; const float* xb = ctx ? xp : xs; const unsigned rsub = ctx ? 0u : (unsigned)NCTX;
#pragma unroll
        for (int q = 0; q < 2; ++q) {
            const unsigned row = u.pm * 256 + wr * 64 + q * 16 + fr;
            const unsigned xoff = ((row - rsub) * DM + colbase) * 4u;
#pragma unroll
            for (int bj = 0; bj < 2; ++bj)
#pragma unroll
                for (int n = 0; n < 2; ++n) p.x[q][bj][n] = ldg<f32x4>(xb, xoff + bj * 512 + n * 16);
        }
    }
    __device__ __forceinline__ void operator()(AccRef acc, const pg8::Unit& u, int wr, int wc, int fr, int fq, const Pre& pre) const {
        const int cond = cond_of_tile(u.pm);
        const unsigned colbase = u.pn * 256 + wc * 32 + 8 * fq;
        const bool ctx = u.pm < 32;
        const float* xb = ctx ? xp : xs;
        const unsigned rsub = ctx ? 0u : (unsigned)NCTX;
        const unsigned moff = (cond * MODW + colbase) * 4u;
        f32x4 gt[2][2], sc[2][2];
#pragma unroll
        for (int bj = 0; bj < 2; ++bj)
#pragma unroll
            for (int n = 0; n < 2; ++n) {
                gt[bj][n] = ldg<f32x4>(gate, moff + bj * 512 + n * 16);
                sc[bj][n] = An ? ldg<f32x4>(nscale, moff + bj * 512 + n * 16) + 1.0f : (f32x4){1.f, 1.f, 1.f, 1.f};
            }
#pragma unroll
        for (int ai = 0; ai < 2; ++ai)
#pragma unroll
            for (int mp = 0; mp < 2; ++mp) {
                f32x4 xo[2][2][2];
#pragma unroll
                for (int q = 0; q < 2; ++q) {
                    const unsigned row = u.pm * 256 + ai * 128 + wr * 64 + (2 * mp + q) * 16 + fr;
                    const unsigned xoff = ((row - rsub) * DM + colbase) * 4u;
#pragma unroll
                    for (int bj = 0; bj < 2; ++bj)
#pragma unroll
                        for (int n = 0; n < 2; ++n) xo[q][bj][n] = (ai == 0 && mp == 0) ? pre.x[q][bj][n] : ldg<f32x4>(xb, xoff + bj * 512 + n * 16);
                }
#pragma unroll
                for (int q = 0; q < 2; ++q) {
                    const int m = 2 * mp + q;
                    const unsigned row = u.pm * 256 + ai * 128 + wr * 64 + m * 16 + fr;
                    const unsigned ooff = (row * DM + colbase) * 4u;
                    float ssum = 0.f;
#pragma unroll
                    for (int bj = 0; bj < 2; ++bj) {
                        f32x4 xn[2];
#pragma unroll
                        for (int n = 0; n < 2; ++n) {
                            xn[n] = xo[q][bj][n] + gt[bj][n] * acc[ai][bj][m][n];
                            stg<f32x4>(out, ooff + bj * 512 + n * 16, xn[n]);
                            ssum += ss4(xn[n]);
                        }
                        if (An) stg<u32x4>(An, (row * DM + colbase) * 2u + bj * 256, pack8(xn[0] * sc[bj][0], xn[1] * sc[bj][1]));
                    }
                    if (ssn) { ssum = red_fq(ssum); if (fq == 0) atomicAdd((float*)((char*)ssn + row * 4u), ssum); }
                }
                asm volatile("" ::: "memory");
            }
    }
};

template <bool EVEN>
struct EpiIn {
    unsigned char* wsb; float* outb;
    const float* qg; const float* kg;
    struct Pre {}; __device__ __forceinline__ void prefetch(Pre&, const pg8::Unit&, int, int, int, int) const {}
    __device__ __forceinline__ void operator()(AccRef acc, const pg8::Unit& u, int wr, int wc, int fr, int fq, const Pre&) const {
        constexpr unsigned N = EVEN ? EVEN_IN : ODD_IN, QW = EVEN ? 512 : 1024, KVH = EVEN ? 2 : 4, KW = KVH * 64;
        const float* ss = (const float*)(wsb + (EVEN ? WS_SS0 : WS_SS2));
        const float* bias = (const float*)(wsb + WS_BIAS) + (EVEN ? BIAS_INE : BIAS_INO);
        const float* rope = (const float*)(wsb + WS_ROPE);
        bf16_t* Q = (bf16_t*)(wsb + WS_Q); bf16_t* K = (bf16_t*)(wsb + (EVEN ? WS_KE : WS_KO)); bf16_t* Vt = (bf16_t*)(wsb + (EVEN ? WS_VTE : WS_VTO));
        bf16_t* MIX = (bf16_t*)(wsb + WS_MIX); bf16_t* VbT = (bf16_t*)(wsb + WS_VBT); float* ssv = (float*)(wsb + WS_SSV);
        float* outk = outb + (size_t)MTOK * DM + (EVEN ? 0 : NCTX * 256); float* outv = outk + NCTX * KW;
        const int cond = cond_of_tile(u.pm);
        int role; unsigned hidx;
        if (EVEN) { if (u.pn < 2) { role = 0; hidx = 4 * u.pn + wc; } else if (u.pn == 2) { role = wc < 2 ? 1 : 2; hidx = wc & 1; } else if (u.pn < 5) { role = 3; hidx = (u.pn - 3) * 4 + wc; } else { role = 4; hidx = (u.pn - 5) * 4 + wc; } }
        else { if (u.pn < 4) { role = 0; hidx = 4 * u.pn + wc; } else if (u.pn == 4) { role = 1; hidx = wc; } else { role = 2; hidx = wc; } }
        const unsigned boff = (cond * N + u.pn * 256 + wc * 32 + 8 * fq) * 4u;
        const bool lat = u.pm >= 32;
        const unsigned c8 = hidx * 64 + 8 * fq;
        const float* gp = role == 0 ? qg : kg;
        f32x4 bvh[2][2];
#pragma unroll
        for (int bj = 0; bj < 2; ++bj)
#pragma unroll
            for (int n = 0; n < 2; ++n) bvh[bj][n] = ldg<f32x4>(bias, boff + bj * 512 + n * 16);
        float rrs[8];
#pragma unroll
        for (int g8 = 0; g8 < 8; ++g8) rrs[g8] = ldg<float>(ss, (u.pm * 256 + (g8 >> 2) * 128 + wr * 64 + (g8 & 3) * 16 + fr) * 4u);
#pragma unroll
        for (int g8 = 0; g8 < 8; ++g8) rrs[g8] = __builtin_amdgcn_rsqf(rrs[g8] * (1.0f / DM) + EPS);
#pragma unroll
        for (int ai = 0; ai < 2; ++ai)
#pragma unroll
            for (int m = 0; m < 4; ++m) {
                const unsigned row = u.pm * 256 + ai * 128 + wr * 64 + m * 16 + fr;
                const float rr = rrs[ai * 4 + m];
                f32x4 z[2][2];
#pragma unroll
                for (int bj = 0; bj < 2; ++bj)
#pragma unroll
                    for (int n = 0; n < 2; ++n) z[bj][n] = acc[ai][bj][m][n] * rr + bvh[bj][n];
                if (role <= 1) {
                    float s2 = (ss4(z[0][0]) + ss4(z[0][1])) + (ss4(z[1][0]) + ss4(z[1][1]));
                    s2 = red_fq(s2);
                    const float rn = __builtin_amdgcn_rsqf(s2 * (1.0f / 64.0f) + EPS);
#pragma unroll
                    for (int bj = 0; bj < 2; ++bj)
#pragma unroll
                        for (int n = 0; n < 2; ++n) z[bj][n] = z[bj][n] * rn * ldg<f32x4>(gp, (8 * fq) * 4u + bj * 128 + n * 16);
                    if (role == 1 && !lat) {
#pragma unroll
                        for (int bj = 0; bj < 2; ++bj)
#pragma unroll
                            for (int n = 0; n < 2; ++n) stg<f32x4>(outk, (row * KW + c8) * 4u + bj * 128 + n * 16, z[bj][n]);
                    }
                    if (lat) {
                        const unsigned t = (row - NCTX) & 2047u;
#pragma unroll
                        for (int bj = 0; bj < 2; ++bj) {
                            const unsigned pos = bj == 0 ? (t >> 6) : (t & 63u);
#pragma unroll
                            for (int n = 0; n < 2; ++n) {
                                const f32x4 cs = ldg<f32x4>(rope, (pos * 16 + 4 * fq) * 8u + n * 16);
                                const f32x4 v = z[bj][n];
                                z[bj][n] = (f32x4){v[0] * cs[0] - v[1] * cs[1], v[0] * cs[1] + v[1] * cs[0], v[2] * cs[2] - v[3] * cs[3], v[2] * cs[3] + v[3] * cs[2]};
                            }
                        }
                    }
                    if (role == 0) {
#pragma unroll
                        for (int bj = 0; bj < 2; ++bj) stg<u32x4>(Q, (row * QW + c8) * 2u + bj * 64, pack8(z[bj][0] * (0.125f * LOG2E), z[bj][1] * (0.125f * LOG2E)));
                    } else {
#pragma unroll
                        for (int bj = 0; bj < 2; ++bj) stg<u32x4>(K, (row * KW + c8) * 2u + bj * 64, pack8(z[bj][0], z[bj][1]));
                    }
                } else if (role == 2) {
                    if (!lat) {
#pragma unroll
                        for (int bj = 0; bj < 2; ++bj)
#pragma unroll
                            for (int n = 0; n < 2; ++n) stg<f32x4>(outv, (row * KW + c8) * 4u + bj * 128 + n * 16, z[bj][n]);
                    }
                    unsigned vb, T;
                    if (!lat) { T = 256; vb = ((row >> 8) * KVH + hidx) * 64 * 256 + (row & 255u); }
                    else { T = 2048; vb = NCTX * KW + (((row - NCTX) >> 11) * KVH + hidx) * 64 * 2048 + ((row - NCTX) & 2047u); }
                    vb += 8 * fq * T;
#pragma unroll
                    for (int bj = 0; bj < 2; ++bj)
#pragma unroll
                        for (int n = 0; n < 2; ++n)
#pragma unroll
                            for (int i = 0; i < 4; ++i) stg<bf16_t>(Vt, (vb + (32 * bj + 4 * n + i) * T) * 2u, (bf16_t)(cvt_pk_bf16(z[bj][n][i], 0.f) & 0xffffu));
                } else if (EVEN && role == 3) {
#pragma unroll
                    for (int bj = 0; bj < 2; ++bj) {
                        f32x4 a = z[bj][0], b = z[bj][1];
#pragma unroll
                        for (int i = 0; i < 4; ++i) { a[i] = gelu_tanh(a[i]); b[i] = gelu_tanh(b[i]); }
                        stg<u32x4>(MIX, (row * DM + 512 + c8) * 2u + bj * 64, pack8(a, b));
                    }
                } else if (EVEN) {
                    float s2 = 0.f;
                    const unsigned cb = (row >> 7) * 512 * 128 + (row & 127u) + c8 * 128;
#pragma unroll
                    for (int bj = 0; bj < 2; ++bj)
#pragma unroll
                        for (int n = 0; n < 2; ++n)
#pragma unroll
                            for (int i = 0; i < 4; ++i) {
                                const float gv = gelu_tanh(z[bj][n][i]); s2 += gv * gv;
                                stg<bf16_t>(VbT, (cb + (32 * bj + 4 * n + i) * 128) * 2u, (bf16_t)(cvt_pk_bf16(gv, 0.f) & 0xffffu));
                            }
                    s2 = red_fq(s2);
                    if (fq == 0) atomicAdd((float*)((char*)ssv + row * 4u), s2);
                }
                asm volatile("" ::: "memory");
            }
    }
};

template <int CTRL> __device__ __forceinline__ float dpp_rot(float v) { return __builtin_bit_cast(float, __builtin_amdgcn_update_dpp(0, __builtin_bit_cast(int, v), CTRL, 0xf, 0xf, false)); }
__device__ __forceinline__ void conv_taps(f32x4& res, const f32x4 sp, const f32x4 sn, const f32x4 w0, const f32x4 w2) {
    float r0 = res[0], r1 = res[1], r2 = res[2], r3 = res[3];
    asm("s_nop 1\n\t"
        "v_fmac_f32_dpp %0, %4, %12 row_ror:1 row_mask:0xf bank_mask:0xf\n\t"
        "v_fmac_f32_dpp %1, %5, %13 row_ror:1 row_mask:0xf bank_mask:0xf\n\t"
        "v_fmac_f32_dpp %2, %6, %14 row_ror:1 row_mask:0xf bank_mask:0xf\n\t"
        "v_fmac_f32_dpp %3, %7, %15 row_ror:1 row_mask:0xf bank_mask:0xf\n\t"
        "v_fmac_f32_dpp %0, %8, %16 row_ror:15 row_mask:0xf bank_mask:0xf\n\t"
        "v_fmac_f32_dpp %1, %9, %17 row_ror:15 row_mask:0xf bank_mask:0xf\n\t"
        "v_fmac_f32_dpp %2, %10, %18 row_ror:15 row_mask:0xf bank_mask:0xf\n\t"
        "v_fmac_f32_dpp %3, %11, %19 row_ror:15 row_mask:0xf bank_mask:0xf"
        : "+v"(r0), "+v"(r1), "+v"(r2), "+v"(r3)
        : "v"(sp[0]), "v"(sp[1]), "v"(sp[2]), "v"(sp[3]), "v"(sn[0]), "v"(sn[1]), "v"(sn[2]), "v"(sn[3]),
          "v"(w0[0]), "v"(w0[1]), "v"(w0[2]), "v"(w0[3]), "v"(w2[0]), "v"(w2[1]), "v"(w2[2]), "v"(w2[3]));
    res = (f32x4){r0, r1, r2, r3};
}
struct EpiUp {
    unsigned char* wsb; unsigned ss_off, bias_off; const float* cw; const float* cbias;
    LAS float* xch;
    struct Pre { float ssr[8]; f32x4 bv[2][2]; };
    __device__ __forceinline__ void prefetch(Pre& p, const pg8::Unit& u, int wr, int wc, int fr, int fq) const {
        const float* ss_ = (const float*)(wsb + ss_off); const float* bias_ = (const float*)(wsb + WS_BIAS) + bias_off;
        const unsigned boff_ = (cond_of_tile(u.pm) * FF2 + u.pn * 256 + wc * 32 + 8 * fq) * 4u;
#pragma unroll
        for (int g8 = 0; g8 < 8; ++g8) p.ssr[g8] = ldg<float>(ss_, (u.pm * 256 + (g8 >> 2) * 128 + wr * 64 + (g8 & 3) * 16 + fr) * 4u);
#pragma unroll
        for (int bj = 0; bj < 2; ++bj)
#pragma unroll
            for (int n = 0; n < 2; ++n) p.bv[bj][n] = ldg<f32x4>(bias_, boff_ + bj * 512 + n * 16);
    }
    __device__ __forceinline__ void operator()(AccRef acc, const pg8::Unit& u, int wr, int wc, int fr, int fq, const Pre& pre) const {
        const float* ss = (const float*)(wsb + ss_off); const float* bias = (const float*)(wsb + WS_BIAS) + bias_off;
        float* ZB = (float*)(wsb + WS_ZB); bf16_t* ACT = (bf16_t*)(wsb + WS_ACT);
        const int cond = cond_of_tile(u.pm);
        const unsigned nb = u.pn * 256 + wc * 32 + 8 * fq;
        const unsigned boff = (cond * FF2 + nb) * 4u;
#pragma unroll
        for (int ai = 0; ai < 2; ++ai)
#pragma unroll
            for (int m = 0; m < 4; ++m) {
                const float rr = __builtin_amdgcn_rsqf(pre.ssr[ai * 4 + m] * (1.0f / DM) + EPS);
#pragma unroll
                for (int bj = 0; bj < 2; ++bj)
#pragma unroll
                    for (int n = 0; n < 2; ++n) acc[ai][bj][m][n] = acc[ai][bj][m][n] * rr + pre.bv[bj][n];
            }
        if (wr == 0 && fr < 2) {
            const unsigned zo = ((u.pm * 4 + fr) * FF2 + nb) * 4u;
#pragma unroll
            for (int bj = 0; bj < 2; ++bj)
#pragma unroll
                for (int n = 0; n < 2; ++n) stg<f32x4>(ZB, zo + bj * 512 + n * 16, acc[0][bj][0][n]);
        }
        if (wr == 1 && fr >= 14) {
            const unsigned zo = ((u.pm * 4 + 2 + (fr - 14)) * FF2 + nb) * 4u;
#pragma unroll
            for (int bj = 0; bj < 2; ++bj)
#pragma unroll
                for (int n = 0; n < 2; ++n) stg<f32x4>(ZB, zo + bj * 512 + n * 16, acc[1][bj][3][n]);
        }
        LAS float* my = xch + (wr * 4 + wc) * 256 + 8 * fq;
        if (fr == 0) {
#pragma unroll
            for (int ai = 0; ai < 2; ++ai)
#pragma unroll
                for (int bj = 0; bj < 2; ++bj)
#pragma unroll
                    for (int n = 0; n < 2; ++n) *(LAS f32x4*)(my + ai * 128 + bj * 32 + 4 * n) = acc[ai][bj][0][n];
        }
        if (fr == 15) {
#pragma unroll
            for (int ai = 0; ai < 2; ++ai)
#pragma unroll
                for (int bj = 0; bj < 2; ++bj)
#pragma unroll
                    for (int n = 0; n < 2; ++n) *(LAS f32x4*)(my + ai * 128 + 64 + bj * 32 + 4 * n) = acc[ai][bj][3][n];
        }
        asm volatile("s_waitcnt lgkmcnt(0)" ::: "memory"); __builtin_amdgcn_s_barrier(); asm volatile("" ::: "memory");
        const unsigned chb = u.pn * 128 + wc * 32 + 8 * fq;
        const float* cw1 = cw + FF2; const float* cw2 = cw + 2 * FF2;
#pragma unroll
        for (int n = 0; n < 2; ++n) {
            const unsigned cia = (chb + 4 * n) * 4u, cig = (FF + chb + 4 * n) * 4u;
            const f32x4 wa0 = ldg<f32x4>(cw, cia), wa1 = ldg<f32x4>(cw1, cia), wa2 = ldg<f32x4>(cw2, cia), cba = ldg<f32x4>(cbias, cia);
            const f32x4 wg0 = ldg<f32x4>(cw, cig), wg1 = ldg<f32x4>(cw1, cig), wg2 = ldg<f32x4>(cw2, cig), cbg = ldg<f32x4>(cbias, cig);
#pragma unroll
            for (int ai = 0; ai < 2; ++ai) {
                const bool hasp = !(ai == 0 && wr == 0), hasn = !(ai == 1 && wr == 1);
                const LAS float* pp = xch + ((wr == 1 ? 0 : 4) + wc) * 256 + (wr == 1 ? ai : 0) * 128 + 64 + 8 * fq;
                const LAS float* pn = xch + ((wr == 0 ? 4 : 0) + wc) * 256 + (wr == 0 ? ai : 1) * 128 + 8 * fq;
                const unsigned arow = ((u.pm * 256 + ai * 128 + wr * 64 + fr) * FF + chb) * 2u;
                f32x4 sg[4];
#pragma unroll
                for (int pass = 0; pass < 2; ++pass) {
                    const int bj = 1 - pass;
                    const f32x4 w0 = pass == 0 ? wg0 : wa0, w1 = pass == 0 ? wg1 : wa1, w2 = pass == 0 ? wg2 : wa2, cb = pass == 0 ? cbg : cba;
                    f32x4 hp = (f32x4){0.f, 0.f, 0.f, 0.f}, hn = (f32x4){0.f, 0.f, 0.f, 0.f};
                    if (hasp) hp = *(const LAS f32x4*)(pp + bj * 32 + 4 * n);
                    if (hasn) hn = *(const LAS f32x4*)(pn + bj * 32 + 4 * n);
                    f32x4 prevsrc = hp;
#pragma unroll
                    for (int m = 0; m < 4; ++m) {
                        const f32x4 zc = acc[ai][bj][m][n];
                        const f32x4 nsrc = m < 3 ? acc[ai][bj][m < 3 ? m + 1 : 3][n] : hn;
                        f32x4 sp, sn;
#pragma unroll
                        for (int i = 0; i < 4; ++i) { sp[i] = fr == 15 ? prevsrc[i] : zc[i]; sn[i] = fr == 0 ? nsrc[i] : zc[i]; }
                        f32x4 res = cb + w1 * zc;
                        conv_taps(res, sp, sn, w0, w2);
                        prevsrc = zc;
                        if (pass == 0) {
#pragma unroll
                            for (int i = 0; i < 4; ++i) res[i] = silu_f(res[i]);
                            sg[m] = res;
                        } else {
                            res = res * sg[m];
                            stg<u32x2>(ACT, arow + m * (16 * FF * 2) + n * 8, (u32x2){cvt_pk_bf16(res[0], res[1]), cvt_pk_bf16(res[2], res[3])});
                        }
                    }
                }
                asm volatile("" ::: "memory");
            }
        }
    }
};

__device__ __forceinline__ int crow(int r, int hi) { return (r & 3) + 8 * (r >> 2) + 4 * hi; }
__device__ __forceinline__ void attn_unit(LAS unsigned char* lds, const bf16_t* Q, int qstride, bf16_t* O, int ostride,
                                          const bf16_t* K0, int ks0, const bf16_t* V0, int vs0, int t0lo, int nt0,
                                          const bf16_t* K1, int ks1, const bf16_t* V1, int vs1, int nt1,
                                          float m_init, float l_init, int win_q0, const int tid) {
    const int lane = tid & 63, r32 = lane & 31, hi = lane >> 5, wid = __builtin_amdgcn_readfirstlane(tid >> 6);
    const int qrow = wid * 32 + r32;
    bf16x8 qf[4];
#pragma unroll
    for (int d0 = 0; d0 < 4; ++d0) qf[d0] = *(const bf16x8*)(Q + (size_t)qrow * qstride + d0 * 16 + hi * 8);
    float mrun = m_init;
    f32x16 o0 = {}, o1 = {}, lacc, negm;
#pragma unroll
    for (int r = 0; r < 16; ++r) { lacc[r] = l_init; negm[r] = -m_init; }
    const bf16x8 ones = {0x3F80, 0x3F80, 0x3F80, 0x3F80, 0x3F80, 0x3F80, 0x3F80, 0x3F80};
    const int NT = nt0 + nt1;
    const int lrow = 8 * wid + (lane >> 3), lch = (lane & 7) ^ ((lrow >> 1) & 7);
    auto dma = [&](int t) {
        const bf16_t* kp; const bf16_t* vp;
        if (t < nt0) { kp = K0 + (size_t)((t0lo + t) * 64 + lrow) * ks0 + lch * 8; vp = V0 + (size_t)lrow * vs0 + (t0lo + t) * 64 + lch * 8; }
        else { kp = K1 + (size_t)((t - nt0) * 64 + lrow) * ks1 + lch * 8; vp = V1 + (size_t)lrow * vs1 + (t - nt0) * 64 + lch * 8; }
        LAS unsigned char* dst = lds + (t % 6) * 16384 + wid * 1024;
        __builtin_amdgcn_global_load_lds((const unsigned*)kp, (LAS unsigned*)dst, 16, 0, 0);
        __builtin_amdgcn_global_load_lds((const unsigned*)vp, (LAS unsigned*)(dst + 8192), 16, 0, 0);
    };
    const int krow = (r32 & 0x13) | ((r32 & 4) << 1) | ((r32 & 8) >> 1);
    const int koff = krow * 128 + ((hi ^ ((krow >> 1) & 7)) << 4);
    const int voff = 8192 + r32 * 128 + ((hi ^ ((r32 >> 1) & 7)) << 4);
    dma(0); if (NT > 1) dma(1); if (NT > 2) dma(2); if (NT > 3) dma(3); if (NT > 4) dma(4);
    for (int t = 0; t < NT; ++t) {
        if (t + 4 < NT) asm volatile("s_waitcnt vmcnt(8)" ::: "memory");
        else if (t + 3 < NT) asm volatile("s_waitcnt vmcnt(6)" ::: "memory");
        else if (t + 2 < NT) asm volatile("s_waitcnt vmcnt(4)" ::: "memory");
        else if (t + 1 < NT) asm volatile("s_waitcnt vmcnt(2)" ::: "memory");
        else asm volatile("s_waitcnt vmcnt(0)" ::: "memory");
        __builtin_amdgcn_s_barrier(); asm volatile("" ::: "memory");
        if (t + 5 < NT) dma(t + 5);
        bool active = true;
        int key0 = 0;
        if (win_q0 >= 0 && t < nt0) {
            key0 = (t0lo + t) * 64;
            const int qw0 = win_q0 + wid * 32;
            active = !(key0 + 63 < qw0 - 128 || key0 > qw0 + 31 + 128);
        }
        if (active) {
            const LAS unsigned char* sb = lds + (t % 6) * 16384;
            f32x16 p0 = negm, p1 = negm;
#pragma unroll
            for (int d0 = 0; d0 < 4; ++d0) {
                const bf16x8 k0 = *(const LAS bf16x8*)(sb + (koff ^ (d0 << 5)));
                const bf16x8 k1 = *(const LAS bf16x8*)(sb + (koff ^ (d0 << 5)) + 32 * 128);
                p0 = __builtin_amdgcn_mfma_f32_32x32x16_bf16(k0, qf[d0], p0, 0, 0, 0);
                p1 = __builtin_amdgcn_mfma_f32_32x32x16_bf16(k1, qf[d0], p1, 0, 0, 0);
            }
            if (win_q0 >= 0 && t < nt0) {
                const int qw0 = win_q0 + wid * 32;
                const int bb = key0 + 8 * hi - (win_q0 + qrow);
                if (key0 < qw0 + 31 - 128) {
#pragma unroll
                    for (int r = 0; r < 16; ++r) { const int c = 16 * (r >> 3) + (r & 7); if (bb < -128 - c) p0[r] = -INFINITY; if (bb < -160 - c) p1[r] = -INFINITY; }
                }
                if (key0 + 63 > qw0 + 128) {
#pragma unroll
                    for (int r = 0; r < 16; ++r) { const int c = 16 * (r >> 3) + (r & 7); if (bb > 128 - c) p0[r] = -INFINITY; if (bb > 96 - c) p1[r] = -INFINITY; }
                }
            }
            float mx = __builtin_fmaxf(__builtin_fmaxf(p0[0], p1[0]), __builtin_fmaxf(p0[1], p1[1]));
#pragma unroll
            for (int r = 2; r < 16; r += 2) mx = __builtin_fmaxf(__builtin_fmaxf(mx, p0[r]), __builtin_fmaxf(p1[r], __builtin_fmaxf(p0[r + 1], p1[r + 1])));
            mx = __builtin_fmaxf(mx, __shfl_xor(mx, 32));
            if (__any(mx > 8.0f)) {
                const float dl = mx > 8.0f ? mx : 0.f;
                const float f = __builtin_amdgcn_exp2f(-dl);
                mrun += dl;
                p0 = p0 - dl; p1 = p1 - dl; negm = negm - dl;
#pragma unroll
                for (int r = 0; r < 16; ++r) { o0[r] *= f; o1[r] *= f; lacc[r] *= f; }
            }
#pragma unroll
            for (int r = 0; r < 16; ++r) { p0[r] = __builtin_amdgcn_exp2f(p0[r]); p1[r] = __builtin_amdgcn_exp2f(p1[r]); }
            bf16x8 pw[4];
#pragma unroll
            for (int ks = 0; ks < 4; ++ks) {
                u32x4 w;
                if (ks < 2) { w.x = cvt_pk_bf16(p0[8 * ks + 0], p0[8 * ks + 1]); w.y = cvt_pk_bf16(p0[8 * ks + 2], p0[8 * ks + 3]); w.z = cvt_pk_bf16(p0[8 * ks + 4], p0[8 * ks + 5]); w.w = cvt_pk_bf16(p0[8 * ks + 6], p0[8 * ks + 7]); }
                else { const int k2 = ks - 2; w.x = cvt_pk_bf16(p1[8 * k2 + 0], p1[8 * k2 + 1]); w.y = cvt_pk_bf16(p1[8 * k2 + 2], p1[8 * k2 + 3]); w.z = cvt_pk_bf16(p1[8 * k2 + 4], p1[8 * k2 + 5]); w.w = cvt_pk_bf16(p1[8 * k2 + 6], p1[8 * k2 + 7]); }
                pw[ks] = __builtin_bit_cast(bf16x8, w);
            }
#pragma unroll
            for (int ks = 0; ks < 4; ++ks) {
                const bf16x8 va = *(const LAS bf16x8*)(sb + (voff ^ (ks << 5)));
                const bf16x8 vbb = *(const LAS bf16x8*)(sb + (voff ^ (ks << 5)) + 32 * 128);
                o0 = __builtin_amdgcn_mfma_f32_32x32x16_bf16(va, pw[ks], o0, 0, 0, 0);
                o1 = __builtin_amdgcn_mfma_f32_32x32x16_bf16(vbb, pw[ks], o1, 0, 0, 0);
                lacc = __builtin_amdgcn_mfma_f32_32x32x16_bf16(ones, pw[ks], lacc, 0, 0, 0);
            }
        }
    }
    const float inv = 1.0f / lacc[0];
    bf16_t* orow = O + (size_t)qrow * ostride;
#pragma unroll
    for (int r4 = 0; r4 < 4; ++r4) {
        u32x2 w0, w1;
        w0.x = cvt_pk_bf16(o0[4 * r4 + 0] * inv, o0[4 * r4 + 1] * inv); w0.y = cvt_pk_bf16(o0[4 * r4 + 2] * inv, o0[4 * r4 + 3] * inv);
        w1.x = cvt_pk_bf16(o1[4 * r4 + 0] * inv, o1[4 * r4 + 1] * inv); w1.y = cvt_pk_bf16(o1[4 * r4 + 2] * inv, o1[4 * r4 + 3] * inv);
        *(u32x2*)(orow + 8 * r4 + 4 * hi) = w0;
        *(u32x2*)(orow + 32 + 8 * r4 + 4 * hi) = w1;
    }
    asm volatile("s_waitcnt vmcnt(0) lgkmcnt(0)" ::: "memory"); __builtin_amdgcn_s_barrier(); asm volatile("" ::: "memory");
}

__device__ __forceinline__ void spatial_unit(LAS unsigned char* lds, int chunk, int g, const float* w_s, const float* b_s, const float* v_gain, const float* ssv, const bf16_t* VbT, bf16_t* MIX, const int tid) {
    const int lane = tid & 63, r32 = lane & 31, hi = lane >> 5, wid = __builtin_amdgcn_readfirstlane(tid >> 6);
    const int pblk = wid & 3, chalf = wid >> 2;
    const int p = 32 * pblk + r32;
    bf16x8 yf[8];
#pragma unroll
    for (int ks = 0; ks < 8; ++ks) {
        const int q = 16 * ks + 8 * hi;
        const f32x4 w0 = *(const f32x4*)(w_s + ((size_t)g * 128 + p) * 128 + q), w1 = *(const f32x4*)(w_s + ((size_t)g * 128 + p) * 128 + q + 4);
        const f32x4 s0 = *(const f32x4*)(ssv + chunk * 128 + q), s1 = *(const f32x4*)(ssv + chunk * 128 + q + 4);
        f32x4 a, b;
#pragma unroll
        for (int i = 0; i < 4; ++i) { a[i] = w0[i] * __builtin_amdgcn_rsqf(s0[i] * (1.0f / 512.0f) + EPS); b[i] = w1[i] * __builtin_amdgcn_rsqf(s1[i] * (1.0f / 512.0f) + EPS); }
        yf[ks] = __builtin_bit_cast(bf16x8, pack8(a, b));
    }
    const float bs = b_s[g * 128 + p];
    LAS float* stg = (LAS float*)(lds + wid * 8704);
#pragma unroll
    for (int cbk = 0; cbk < 2; ++cbk) {
        const int cblk = 2 * chalf + cbk;
        const bf16_t* xr = VbT + ((size_t)chunk * 512 + 128 * g + 32 * cblk + r32) * 128 + 8 * hi;
        f32x16 acc = {};
#pragma unroll
        for (int ks = 0; ks < 8; ++ks) { const bf16x8 xf = *(const bf16x8*)(xr + 16 * ks); acc = __builtin_amdgcn_mfma_f32_32x32x16_bf16(xf, yf[ks], acc, 0, 0, 0); }
#pragma unroll
        for (int r4 = 0; r4 < 4; ++r4) {
            const int c4 = 32 * cbk + 8 * r4 + 4 * hi;
            const f32x4 gn = *(const f32x4*)(v_gain + 128 * g + 64 * chalf + c4);
            *(LAS f32x4*)(stg + r32 * 68 + c4) = (f32x4){gn[0] * acc[4 * r4 + 0] + bs, gn[1] * acc[4 * r4 + 1] + bs, gn[2] * acc[4 * r4 + 2] + bs, gn[3] * acc[4 * r4 + 3] + bs};
        }
    }
    asm volatile("s_waitcnt lgkmcnt(0)" ::: "memory");
#pragma unroll
    for (int i = 0; i < 4; ++i) {
        const int prow = i * 8 + (lane >> 3), ch8 = (lane & 7) * 8;
        const f32x4 m0 = *(const LAS f32x4*)(stg + prow * 68 + ch8), m1 = *(const LAS f32x4*)(stg + prow * 68 + ch8 + 4);
        bf16_t* up = MIX + (size_t)(chunk * 128 + 32 * pblk + prow) * DM + 512 + 128 * g + 64 * chalf + ch8;
        const u32x4 uu = *(const u32x4*)up;
        f32x4 a, b;
        a[0] = __uint_as_float(uu.x << 16) * m0[0]; a[1] = __uint_as_float(uu.x & 0xffff0000u) * m0[1]; a[2] = __uint_as_float(uu.y << 16) * m0[2]; a[3] = __uint_as_float(uu.y & 0xffff0000u) * m0[3];
        b[0] = __uint_as_float(uu.z << 16) * m1[0]; b[1] = __uint_as_float(uu.z & 0xffff0000u) * m1[1]; b[2] = __uint_as_float(uu.w << 16) * m1[2]; b[3] = __uint_as_float(uu.w & 0xffff0000u) * m1[3];
        *(u32x4*)up = pack8(a, b);
    }
    asm volatile("s_waitcnt lgkmcnt(0)" ::: "memory"); __builtin_amdgcn_s_barrier(); asm volatile("" ::: "memory");
}

__device__ __forceinline__ unsigned f2bf(float f) { unsigned u = __builtin_bit_cast(unsigned, f); return (u + 0x7fffu + ((u >> 16) & 1u)) >> 16; }
__device__ __forceinline__ unsigned pk2(float lo, float hi) { return f2bf(lo) | (f2bf(hi) << 16); }
__device__ __forceinline__ float wave_sum(float v) {
#pragma unroll
    for (int o = 1; o < 64; o <<= 1) v += __shfl_xor(v, o);
    return v;
}
__device__ __forceinline__ void transpose_item(const float* W, int K, int N, bf16_t* WT, int k0, int n0, int drow, LAS float* scr, int lane) {
    float tv[32];
#pragma unroll
    for (int i = 0; i < 32; ++i) tv[i] = W[(size_t)(k0 + 2 * i + (lane >> 5)) * N + n0 + (lane & 31)];
#pragma unroll
    for (int i = 0; i < 32; ++i) scr[(2 * i + (lane >> 5)) * 33 + (lane & 31)] = tv[i];
    asm volatile("s_waitcnt lgkmcnt(0)" ::: "memory");
    const int c = lane & 7;
#pragma unroll
    for (int j = 0; j < 4; ++j) { const int n = (lane >> 3) + 8 * j; const LAS float* s = scr + (8 * c) * 33 + n;
        u32x4 o; o.x = pk2(s[0 * 33], s[1 * 33]); o.y = pk2(s[2 * 33], s[3 * 33]); o.z = pk2(s[4 * 33], s[5 * 33]); o.w = pk2(s[6 * 33], s[7 * 33]);
        *(u32x4*)(WT + (size_t)(drow + n) * K + k0 + 8 * c) = o; }
    asm volatile("s_waitcnt lgkmcnt(0)" ::: "memory");
}
__device__ __forceinline__ int perm_in(int n0) { const int pn = n0 >> 8, rem = n0 & 255; return pn * 256 + ((rem & 63) >> 5) * 128 + (rem >> 6) * 32; }
__device__ __forceinline__ int perm_up(int n0) { const int half = n0 / FF, ch = n0 % FF; return (ch >> 7) * 256 + half * 128 + (ch & 127); }


#define XB_TMO      128
#define XB_XCNT(j)  (256  + 64 * (j))
#define XB_XSUB(j)  (1280 + 64 * (j))
#define XB_XGEN(j)  (2304 + 64 * (j))
#define XB_TOP      3328
#define XB_TOPGEN   3392
#define XCD_BAR_WORDS 3456
#define XB_SPIN_CAP (1u << 18)
__device__ __forceinline__ unsigned xb_ld(unsigned* p)              { return __hip_atomic_load(p, __ATOMIC_RELAXED, __HIP_MEMORY_SCOPE_AGENT); }
__device__ __forceinline__ unsigned xb_add(unsigned* p, unsigned v) { return __hip_atomic_fetch_add(p, v, __ATOMIC_RELAXED, __HIP_MEMORY_SCOPE_AGENT); }
__device__ __forceinline__ unsigned xb_xcc_id() { return (unsigned)__builtin_amdgcn_s_getreg((3 << 11) | 20) & 0xFu; }
#define XB_SPIN(cond, bar) do { unsigned _sp = 0; while (cond) { __builtin_amdgcn_s_sleep(1); \
    if ((++_sp & 255u) == 0u) { if (xb_ld(&(bar)[XB_TMO])) break; if (_sp > XB_SPIN_CAP) { atomicAdd(&(bar)[XB_TMO], 1u); break; } } } } while (0)
struct XcdBarrier { unsigned* bar; unsigned x; volatile LAS unsigned* st; };
__device__ __forceinline__ XcdBarrier xcd_barrier_post(unsigned* bar, volatile LAS unsigned* st) {
    XcdBarrier b; b.bar = bar; b.x = xb_xcc_id(); b.st = st;
    if (threadIdx.x == 0) (void)xb_add(&bar[XB_XCNT(b.x)], 1u);
    return b;
}
__device__ __forceinline__ void xcd_barrier_complete(unsigned* bar, unsigned x, unsigned& nloc, unsigned& nx) {
    const unsigned G = gridDim.x * gridDim.y * gridDim.z;
    unsigned sum, cnt, mine, sp = 0u;
    for (;;) {
        sum = 0u; cnt = 0u; mine = 0u;
#pragma unroll
        for (unsigned j = 0; j < 16; ++j) { const unsigned c = xb_ld(&bar[XB_XCNT(j)]); sum += c; cnt += (c > 0u) ? 1u : 0u; mine = (j == x) ? c : mine; }
        if (sum == G) break;
        __builtin_amdgcn_s_sleep(1);
        if ((++sp & 255u) == 0u) { if (xb_ld(&bar[XB_TMO])) break; if (sp > XB_SPIN_CAP) { atomicAdd(&bar[XB_TMO], 1u); break; } }
    }
    nloc = mine > 0u ? mine : 1u; nx = cnt > 0u ? cnt : 1u;
}
__device__ __forceinline__ void xcd_barrier(const XcdBarrier& b) {
    asm volatile("s_waitcnt vmcnt(0)" ::: "memory");
    __syncthreads();
    if (threadIdx.x == 0) {
        unsigned* bar = b.bar;
        __builtin_amdgcn_s_waitcnt(0);
        unsigned nloc = b.st[0], nx = b.st[1];
        if (nloc == 0u) { xcd_barrier_complete(bar, b.x, nloc, nx); b.st[0] = nloc; b.st[1] = nx; }
        const unsigned old = xb_add(&bar[XB_XSUB(b.x)], 1u);
        const unsigned gen = old / nloc;
        if (old + 1u == (gen + 1u) * nloc) {
            __builtin_amdgcn_fence(__ATOMIC_RELEASE, "agent");
            asm volatile("s_waitcnt vmcnt(0)" ::: "memory");
            const unsigned og = xb_add(&bar[XB_TOP], 1u);
            const unsigned tg = og / nx;
            if (og + 1u == (tg + 1u) * nx) xb_add(&bar[XB_TOPGEN], 1u);
            else XB_SPIN(xb_ld(&bar[XB_TOPGEN]) == tg, bar);
            __builtin_amdgcn_fence(__ATOMIC_ACQUIRE, "agent");
            xb_add(&bar[XB_XGEN(b.x)], 1u);
            asm volatile("s_waitcnt vmcnt(0)" ::: "memory");
        } else {
            XB_SPIN(xb_ld(&bar[XB_XGEN(b.x)]) == gen, bar);
            __builtin_amdgcn_fence(__ATOMIC_ACQUIRE, "agent");
            asm volatile("s_waitcnt vmcnt(0)" ::: "memory");
        }
    }
    __syncthreads();
}

template <bool COOP>
__global__ void __launch_bounds__(512, 2) mk_fwd(Params P) {
    extern __shared__ __attribute__((aligned(16))) unsigned char lds_raw[];
    LAS unsigned char* lds = (LAS unsigned char*)lds_raw;
    const int tid = threadIdx.x, lane = tid & 63, wave = __builtin_amdgcn_readfirstlane(tid >> 6);
    const int G = gridDim.x, bx = blockIdx.x;
    const int gw = bx * 8 + wave, NGW = G * 8;
    unsigned char* ws = P.ws;
    float* out = P.out;
    typedef const float* cfp_t; typedef __attribute__((address_space(4))) const cfp_t* kargp_t;
#define INP(i) ({ kargp_t kp_ = (kargp_t)__builtin_amdgcn_kernarg_segment_ptr(); asm volatile("" : "+s"(kp_)); kp_[i]; })
#define out_ka (out + (size_t)MTOK * DM)
#define out_va (out + (size_t)MTOK * DM + NCTX * 128)
#define out_kc (out + (size_t)MTOK * DM + NCTX * 256)
#define out_vc (out + (size_t)MTOK * DM + NCTX * 512)
#define mod ((float*)(ws + WS_MOD))
#define ss0 ((float*)(ws + WS_SS0))
#define ss1 ((float*)(ws + WS_SS1))
#define ss2 ((float*)(ws + WS_SS2))
#define ss3 ((float*)(ws + WS_SS3))
#define ssv ((float*)(ws + WS_SSV))
#define rope ((float*)(ws + WS_ROPE))
#define biasw ((float*)(ws + WS_BIAS))
#define ZB ((float*)(ws + WS_ZB))
#define CK_A ((bf16_t*)(ws + WS_CK_A))
#define CVT_A ((bf16_t*)(ws + WS_CVT_A))
#define CK_C ((bf16_t*)(ws + WS_CK_C))
#define CVT_C ((bf16_t*)(ws + WS_CVT_C))
#define W_INE ((bf16_t*)(ws + WS_W_INE))
#define W_OUTE ((bf16_t*)(ws + WS_W_OUTE))
#define W_INO ((bf16_t*)(ws + WS_W_INO))
#define W_OUTO ((bf16_t*)(ws + WS_W_OUTO))
#define W_UP ((bf16_t*)(ws + WS_W_UP))
#define W_DN ((bf16_t*)(ws + WS_W_DN))
#define Abuf ((bf16_t*)(ws + WS_A))
#define ACT ((bf16_t*)(ws + WS_ACT))
#define MIX ((bf16_t*)(ws + WS_MIX))
#define Qb ((bf16_t*)(ws + WS_Q))
#define KE ((bf16_t*)(ws + WS_KE))
#define VTE ((bf16_t*)(ws + WS_VTE))
#define VBT ((bf16_t*)(ws + WS_VBT))
#define KO ((bf16_t*)(ws + WS_KO))
#define VTO ((bf16_t*)(ws + WS_VTO))
    LAS float* spare = (LAS float*)(lds + LDS_SPARE);

    const int lo = P.ph_lo, hi = P.ph_hi;
#define TSTAMP(k) do { if (MK_TP_LO >= 0 && blockIdx.x == 0 && threadIdx.x == 0) { if ((k) == MK_TP_LO) ((unsigned long long*)(P.ws + WS_TS))[0] = __builtin_amdgcn_s_memrealtime(); if ((k) == MK_TP_HI + 1) ((unsigned long long*)(P.ws + WS_TS))[1] = __builtin_amdgcn_s_memrealtime(); } } while (0)
    XcdBarrier xbar; xbar.bar = (unsigned*)(ws + WS_BAR); xbar.x = 0; xbar.st = (volatile LAS unsigned*)(lds + LDS_SPARE + 12288);
    if constexpr (COOP) {
        if (tid < 2) ((LAS unsigned*)(lds + LDS_SPARE + 12288))[tid] = 0u;
        __syncthreads();
        xbar = xcd_barrier_post((unsigned*)(ws + WS_BAR), (volatile LAS unsigned*)(lds + LDS_SPARE + 12288));
        if (P.ph_lo < 0) cg::this_grid().sync();
    }
#ifndef MK_PHMASK
#define MK_PHMASK 0x7fff
#endif
#define IN(k) ((((MK_PHMASK) >> (k)) & 1) && lo <= (k) && (k) < hi)
#define SEAM(k) do { if constexpr (COOP) { if (IN(k) && IN((k) + 1)) { xcd_barrier(xbar); } } } while (0)

    if constexpr (!COOP) { TSTAMP(lo); }
    if (IN(0)) {
        const float* c_in = INP(6); const float* c_ctx = INP(7); const float* w_mod = INP(8); const float* b_mod = INP(9);
        for (int it = bx; it < 2 * 24 * 16; it += G) {
            const int l = it / 384, cbk = (it % 384) / 16, ksp = it % 16;
            __syncthreads();
            for (int i = tid; i < NCOND * 64; i += 512) { const int cd = i >> 6, k = ksp * 64 + (i & 63); const float v = cd == 0 ? c_ctx[k] : c_in[(cd - 1) * DM + k]; spare[i] = v / (1.0f + __expf(-v)); }
            __syncthreads();
            const int col = cbk * 256 + (tid & 255), kh = tid >> 8;
            float a[NCOND];
#pragma unroll
            for (int cd = 0; cd < NCOND; ++cd) a[cd] = 0.f;
            const float* wp = w_mod + ((size_t)l * DM + ksp * 64 + kh * 32) * MODW + col;
#pragma unroll 1
            for (int k0 = 0; k0 < 32; k0 += 8) {
                float wv[8];
#pragma unroll
                for (int k = 0; k < 8; ++k) wv[k] = wp[(size_t)(k0 + k) * MODW];
#pragma unroll
                for (int k = 0; k < 8; ++k) {
#pragma unroll
                    for (int cd = 0; cd < NCOND; ++cd) a[cd] += spare[cd * 64 + kh * 32 + k0 + k] * wv[k]; }
            }
            const float bm = (ksp == 0 && kh == 0) ? b_mod[l * MODW + col] : 0.f;
#pragma unroll
            for (int cd = 0; cd < NCOND; ++cd) atomicAdd(mod + ((size_t)l * NCOND + cd) * MODW + col, a[cd] + bm);
        }
        __syncthreads();
        {
            const float* w_in_even = INP(10); const float* w_out_even = INP(16); const float* w_in_odd = INP(17); const float* w_out_odd = INP(21); const float* w_up = INP(22); const float* w_down = INP(25);
            LAS float* scr = (LAS float*)(lds + wave * 16384);
            constexpr int I_INE = 16 * 56, I_OUT = 16 * 32, I_INO = 16 * 48, I_UP = 16 * 176, I_DN = 44 * 32;
            constexpr int NIT = I_INE + 2 * I_OUT + I_INO + 2 * I_UP + 2 * I_DN;
            for (int it = gw; it < NIT; it += NGW) {
                int r = it;
                if (r < I_INE) { const int kb = r / 56, nb = r % 56; transpose_item(w_in_even, DM, EVEN_IN, W_INE, 64 * kb, 32 * nb, perm_in(32 * nb), scr, lane); continue; } r -= I_INE;
                if (r < I_OUT) { const int kb = r / 32, nb = r % 32; transpose_item(w_out_even, DM, DM, W_OUTE, 64 * kb, 32 * nb, 32 * nb, scr, lane); continue; } r -= I_OUT;
                if (r < I_INO) { const int kb = r / 48, nb = r % 48; transpose_item(w_in_odd, DM, ODD_IN, W_INO, 64 * kb, 32 * nb, perm_in(32 * nb), scr, lane); continue; } r -= I_INO;
                if (r < I_OUT) { const int kb = r / 32, nb = r % 32; transpose_item(w_out_odd, DM, DM, W_OUTO, 64 * kb, 32 * nb, 32 * nb, scr, lane); continue; } r -= I_OUT;
                if (r < 2 * I_UP) { const int l = r / I_UP, q = r % I_UP, kb = q / 176, nb = q % 176; transpose_item(w_up + (size_t)l * DM * FF2, DM, FF2, W_UP + (size_t)l * FF2 * DM, 64 * kb, 32 * nb, perm_up(32 * nb), scr, lane); continue; } r -= 2 * I_UP;
                { const int l = r / I_DN, q = r % I_DN, kb = q / 32, nb = q % 32; transpose_item(w_down + (size_t)l * FF * DM, FF, DM, W_DN + (size_t)l * DM * FF, 64 * kb, 32 * nb, 32 * nb, scr, lane); }
            }
        }
        {
            const float* cache_k_attn = INP(2); const float* cache_v_attn = INP(3); const float* cache_k_swa = INP(4); const float* cache_v_swa = INP(5);
            const int gt = bx * 512 + tid, NT_ = G * 512;
            for (int i = gt; i < 8 * 512 * 128 / 4; i += NT_) { const f32x4 v = *(const f32x4*)(cache_k_attn + (size_t)i * 4); *(u32x2*)(CK_A + (size_t)i * 4) = (u32x2){pk2(v[0], v[1]), pk2(v[2], v[3])}; }
            for (int i = gt; i < 8 * 512 * 256 / 4; i += NT_) { const f32x4 v = *(const f32x4*)(cache_k_swa + (size_t)i * 4); *(u32x2*)(CK_C + (size_t)i * 4) = (u32x2){pk2(v[0], v[1]), pk2(v[2], v[3])}; }
            for (int i = gt; i < 8 * 64 * 128; i += NT_) { const int cd = i & 127, pc = (i >> 7) & 63, b = i >> 13; const float* s = cache_v_attn + ((size_t)b * 512 + pc * 8) * 128 + cd;
                u32x4 o; o.x = pk2(s[0], s[128]); o.y = pk2(s[256], s[384]); o.z = pk2(s[512], s[640]); o.w = pk2(s[768], s[896]);
                *(u32x4*)(CVT_A + ((size_t)b * 128 + cd) * 512 + pc * 8) = o; }
            for (int i = gt; i < 8 * 64 * 256; i += NT_) { const int cd = i & 255, pc = (i >> 8) & 63, b = i >> 14; const float* s = cache_v_swa + ((size_t)b * 512 + pc * 8) * 256 + cd;
                u32x4 o; o.x = pk2(s[0], s[256]); o.y = pk2(s[512], s[768]); o.z = pk2(s[1024], s[1280]); o.w = pk2(s[1536], s[1792]);
                *(u32x4*)(CVT_C + ((size_t)b * 256 + cd) * 512 + pc * 8) = o; }
            if (gt < 1024) { const int pos = gt >> 4, f = gt & 15; const float inv = exp2f(-(float)f * (13.287712379549449f / 16.0f)); const float ang = (float)pos * inv;
                rope[gt * 2] = cosf(ang); rope[gt * 2 + 1] = sinf(ang); }
        }
    }
    SEAM(0);
    if (IN(1)) {
        const float* x_prompt = INP(0); const float* x_sample = INP(1);
        for (int row0 = gw; row0 < MTOK; row0 += 2 * NGW) {
            f32x4 v[2][4]; float sq[2];
#pragma unroll
            for (int u = 0; u < 2; ++u) {
                const int row = row0 + u * NGW; sq[u] = 0.f;
                if (row < MTOK) {
                    const float* xr = row < NCTX ? x_prompt + (size_t)row * DM : x_sample + (size_t)(row - NCTX) * DM;
#pragma unroll
                    for (int j = 0; j < 4; ++j) v[u][j] = *(const f32x4*)(xr + 256 * j + 4 * lane);
                }
            }
#pragma unroll
            for (int u = 0; u < 2; ++u) {
                if (row0 + u * NGW < MTOK) {
#pragma unroll
                    for (int j = 0; j < 4; ++j) sq[u] += (v[u][j][0] * v[u][j][0] + v[u][j][1] * v[u][j][1]) + (v[u][j][2] * v[u][j][2] + v[u][j][3] * v[u][j][3]);
                }
            }
#pragma unroll
            for (int o = 1; o < 64; o <<= 1) { sq[0] += __shfl_xor(sq[0], o); sq[1] += __shfl_xor(sq[1], o); }
#pragma unroll
            for (int u = 0; u < 2; ++u) {
                const int row = row0 + u * NGW;
                if (row < MTOK) {
                    const int cond = row < NCTX ? 0 : 1 + ((row - NCTX) >> 11);
                    const float* sc = mod + (size_t)cond * MODW + 1024;
                    if (lane == 0) ss0[row] = sq[u];
#pragma unroll
                    for (int j = 0; j < 4; ++j) { const f32x4 s4 = *(const f32x4*)(sc + 256 * j + 4 * lane); const f32x4 h = v[u][j] * (s4 + 1.0f);
                        *(u32x2*)(Abuf + (size_t)row * DM + 256 * j + 4 * lane) = (u32x2){cvt_pk_bf16(h[0], h[1]), cvt_pk_bf16(h[2], h[3])}; }
                }
            }
        }
        constexpr int NB0 = 1792 / 16, NB1 = 5632 / 16, NB2 = 1536 / 16, NBT = NB0 + 2 * NB1 + NB2;
        for (int it = gw; it < NCOND * NBT; it += NGW) {
            const int cond = it / NBT; int r = it % NBT;
            const bf16_t* Wt; const float* sh; float* dst; int N;
            if (r < NB0) { Wt = W_INE; sh = mod + (size_t)cond * MODW; dst = biasw + BIAS_INE; N = 1792; }
            else if ((r -= NB0) < NB1) { Wt = W_UP; sh = mod + (size_t)cond * MODW + 3072; dst = biasw + BIAS_UP0; N = 5632; }
            else if ((r -= NB1) < NB2) { Wt = W_INO; sh = mod + (size_t)(NCOND + cond) * MODW; dst = biasw + BIAS_INO; N = 1536; }
            else { r -= NB2; Wt = W_UP + (size_t)FF2 * DM; sh = mod + (size_t)(NCOND + cond) * MODW + 3072; dst = biasw + BIAS_UP1; N = 5632; }
            float sv[16];
#pragma unroll
            for (int j = 0; j < 4; ++j) { const f32x4 t4 = *(const f32x4*)(sh + 16 * lane + 4 * j); sv[4 * j] = t4[0]; sv[4 * j + 1] = t4[1]; sv[4 * j + 2] = t4[2]; sv[4 * j + 3] = t4[3]; }
            for (int n = 0; n < 16; n += 8) {
                float d[8];
#pragma unroll
                for (int q = 0; q < 8; ++q) {
                    const bf16_t* wr_ = Wt + (size_t)(r * 16 + n + q) * DM + 16 * lane;
                    const u32x4 w0 = *(const u32x4*)wr_, w1 = *(const u32x4*)(wr_ + 8);
                    float dd = 0.f;
#pragma unroll
                    for (int j = 0; j < 4; ++j) { dd += sv[2 * j] * __uint_as_float(w0[j] << 16) + sv[2 * j + 1] * __uint_as_float(w0[j] & 0xffff0000u); dd += sv[8 + 2 * j] * __uint_as_float(w1[j] << 16) + sv[8 + 2 * j + 1] * __uint_as_float(w1[j] & 0xffff0000u); }
                    d[q] = dd;
                }
#pragma unroll
                for (int o = 1; o < 64; o <<= 1) {
#pragma unroll
                    for (int q = 0; q < 8; ++q) d[q] += __shfl_xor(d[q], o);
                }
                if (lane == 0) {
#pragma unroll
                    for (int q = 0; q < 8; ++q) dst[(size_t)cond * N + r * 16 + n + q] = d[q];
                }
            }
        }
    }
    SEAM(1);
    pg8::StaticOrder S;
    for (int ph = (lo > 2 ? lo : 2); ph < hi; ++ph) {
        if (((MK_PHMASK >> ph) & 1) != 0) {
#pragma unroll 1
        for (int slot_ = 0; slot_ < 3; ++slot_) {
            const int slot = ((ph == 4 || ph == 10) && (bx & 1) && slot_ < 2) ? 1 - slot_ : slot_;
            int st = -1, pm0 = 32, nM = 64, c0 = 0, nc = G;
            const bool g256 = (G == 256);
            switch (ph * 4 + slot) {
                case 2 * 4 + 0: st = 0; break;
                case 2 * 4 + 1: st = 0; pm0 = 0; nM = 9; if (g256) { c0 = 192; nc = 64; } break;
                case 3 * 4 + 0: st = 1; break;
                case 3 * 4 + 1: st = 0; pm0 = 9; nM = 23; if (g256) nc = 168; break;
                case 4 * 4 + 0: st = 2; break;
                case 4 * 4 + 1: st = 1; pm0 = 0; nM = 32; break;
                case 5 * 4 + 0: st = 3; break;
                case 5 * 4 + 1: st = 2; pm0 = 0; nM = 32; if (g256) { c0 = 128; nc = 128; } break;
                case 6 * 4 + 0: st = 4; break;
                case 7 * 4 + 0: st = 5; break;
                case 7 * 4 + 1: st = 3; pm0 = 0; nM = 32; break;
                case 8 * 4 + 0: st = 6; if (g256) { c0 = 128; nc = 128; } break;
                case 8 * 4 + 1: st = 5; pm0 = 0; nM = 32; if (g256) nc = 128; break;
                case 9 * 4 + 0: st = 7; break;
                case 9 * 4 + 1: st = 6; pm0 = 0; nM = 32; if (g256) nc = 192; break;
                case 10 * 4 + 0: st = 8; break;
                case 10 * 4 + 1: st = 7; pm0 = 0; nM = 32; break;
                case 11 * 4 + 0: st = 9; break;
                case 11 * 4 + 1: st = 8; pm0 = 0; nM = 32; if (g256) { c0 = 128; nc = 128; } break;
                case 12 * 4 + 0: st = 10; break;
                case 13 * 4 + 0: st = 11; pm0 = 32; nM = 32; if (g256) { c0 = 128; nc = 128; } break;
                case 13 * 4 + 1: st = 9; pm0 = 0; nM = 23; if (g256) nc = 128; break;
                case 13 * 4 + 2: st = 9; pm0 = 23; nM = 9; if (g256) { c0 = 128; nc = 128; } break;
                case 14 * 4 + 0: st = 11; pm0 = 64; nM = 32; if (g256) { c0 = 128; nc = 128; } break;
                case 14 * 4 + 1: st = 11; pm0 = 0; nM = 32; if (g256) nc = 128; break;
                default: break;
            }
            const bool lat = pm0 >= 32;
            if (st < 0) continue;
            unsigned char* ws = P.ws; asm volatile("" : "+s"(ws));
            float* out = P.out; asm volatile("" : "+s"(out));
            int tid = threadIdx.x; asm volatile("" : "+v"(tid));
            LAS unsigned char* lds = (LAS unsigned char*)lds_raw; { unsigned l_ = (unsigned)(uintptr_t)lds; asm volatile("" : "+s"(l_)); lds = (LAS unsigned char*)(uintptr_t)l_; }
            LAS float* spare = (LAS float*)(lds + LDS_SPARE);
            const int rel = (bx - c0 + G) % G;
            const int L = st >= 6 ? 1 : 0;
            float* modL = mod + (size_t)L * NCOND * MODW;
            if (st == 0) {
                pg8::Gemm g{Abuf, W_INE, MTOK, EVEN_IN, DM}; S.init(pm0, nM, EVEN_IN, G, bx, c0, nc);
                EpiIn<true> E{ws, out, INP(11), INP(12)};
                pg8::gemm_phase<EpiIn<true>, true>(lds, g, S, E, tid);
            } else if (st == 6) {
                pg8::Gemm g{Abuf, W_INO, MTOK, ODD_IN, DM}; S.init(pm0, nM, ODD_IN, G, bx, c0, nc);
                EpiIn<false> E{ws, out, INP(18), INP(19)};
                pg8::gemm_phase<EpiIn<false>, true>(lds, g, S, E, tid);
            } else if (st == 2 || st == 5 || st == 8 || st == 11) {
                const bool dn = (st == 5 || st == 11);
                pg8::Gemm g{dn ? ACT : MIX, dn ? W_DN + (size_t)L * DM * FF : (L ? W_OUTO : W_OUTE), MTOK, DM, dn ? FF : DM}; S.init(pm0, nM, DM, G, bx, c0, nc);
                EpiRes E;
                if (st == 2) { E.xp = INP(0); E.xs = INP(1); } else { E.xp = out; E.xs = out + (size_t)NCTX * DM; }
                E.out = out; E.gate = modL + (dn ? 5120 : 2048);
                E.nscale = st == 11 ? nullptr : (dn ? mod + (size_t)NCOND * MODW + 1024 : modL + 4096);
                E.An = st == 11 ? nullptr : Abuf;
                E.ssn = st == 2 ? ss1 : st == 5 ? ss2 : st == 8 ? ss3 : nullptr;
                pg8::gemm_phase<EpiRes, true>(lds, g, S, E, tid);
            } else if (st == 3 || st == 9) {
                pg8::Gemm g{Abuf, W_UP + (size_t)L * FF2 * DM, MTOK, FF2, DM}; S.init(pm0, nM, FF2, G, bx, c0, nc);
                EpiUp E{ws, (unsigned)(L ? WS_SS3 : WS_SS1), (unsigned)(L ? BIAS_UP1 : BIAS_UP0), INP(23) + (size_t)L * 3 * FF2, INP(24) + (size_t)L * FF2, spare};
                pg8::gemm_phase<EpiUp, true>(lds, g, S, E, tid);
            } else if (st == 4 || st == 10) {
                if (lat) {
                    const float* cw = INP(23) + (size_t)L * 3 * FF2; const float* cb = INP(24) + (size_t)L * FF2;
                    for (int i = bx * 512 + tid; i < 8 * 7 * 2 * FF; i += G * 512) {
                        const int ch = i % FF, rs = i / FF, which = rs & 1, sm = (rs >> 1) % 7, b = rs / 14;
                        const int pmA = 32 + b * 8 + sm;
                        const int zc = (ch >> 7) * 256 + (ch & 127);
                        const float* zA = ZB + (size_t)pmA * 4 * FF2; const float* zB = ZB + (size_t)(pmA + 1) * 4 * FF2;
                        float ra, rg;
                        if (which == 0) {
                            ra = cb[ch] + cw[ch] * zA[2 * FF2 + zc] + cw[FF2 + ch] * zA[3 * FF2 + zc] + cw[2 * FF2 + ch] * zB[zc];
                            rg = cb[FF + ch] + cw[FF + ch] * zA[2 * FF2 + zc + 128] + cw[FF2 + FF + ch] * zA[3 * FF2 + zc + 128] + cw[2 * FF2 + FF + ch] * zB[zc + 128];
                        } else {
                            ra = cb[ch] + cw[ch] * zA[3 * FF2 + zc] + cw[FF2 + ch] * zB[zc] + cw[2 * FF2 + ch] * zB[FF2 + zc];
                            rg = cb[FF + ch] + cw[FF + ch] * zA[3 * FF2 + zc + 128] + cw[FF2 + FF + ch] * zB[zc + 128] + cw[2 * FF2 + FF + ch] * zB[FF2 + zc + 128];
                        }
                        const int row = pmA * 256 + 255 + which;
                        ACT[(size_t)row * FF + ch] = (bf16_t)(cvt_pk_bf16(ra * silu_f(rg), 0.f) & 0xffffu);
                    }
                }
            } else if (st == 1) {
                const float* w_spatial = INP(14); const float* b_spatial = INP(15); const float* v_norm_b = INP(13);
                if (lat) {
                    for (int it = rel; it < 512; it += nc) {
                        const int b = it >> 6, h = (it >> 3) & 7, qb = it & 7, kvh = h >> 2;
                        const size_t row0 = NCTX + (size_t)b * 2048 + qb * 256;
                        attn_unit(lds, Qb + row0 * 512 + h * 64, 512, MIX + row0 * DM + h * 64, DM,
                                  KE + ((size_t)NCTX + (size_t)b * 2048) * 128 + kvh * 64, 128, VTE + (size_t)NCTX * 128 + (size_t)(b * 2 + kvh) * 64 * 2048, 2048, 0, 32,
                                  CK_A + (size_t)b * 512 * 128 + kvh * 64, 128, CVT_A + (size_t)(b * 2 + kvh) * 64 * 512, 512, 8, 0.f, 0.f, -1, tid);
                    }
                    if (G == 256) {
                        if (bx >= 168) { for (int j = 0; j < 4; ++j) { const int e = (bx - 168) * 4 + j; spatial_unit(lds, 64 + (e >> 2), e & 3, w_spatial, b_spatial, v_norm_b, ssv, VBT, MIX, tid); } }
                        else if (bx < 160) { const int e = 352 + bx; spatial_unit(lds, 64 + (e >> 2), e & 3, w_spatial, b_spatial, v_norm_b, ssv, VBT, MIX, tid); }
                    } else {
                        for (int e = rel; e < 512; e += nc) spatial_unit(lds, 64 + (e >> 2), e & 3, w_spatial, b_spatial, v_norm_b, ssv, VBT, MIX, tid);
                    }
                } else {
                    for (int it = rel; it < 256 + 256; it += nc) {
                        if (it < 256) {
                            const int b = it >> 3, h = it & 7, kvh = h >> 2;
                            const size_t row0 = (size_t)b * 256;
                            attn_unit(lds, Qb + row0 * 512 + h * 64, 512, MIX + row0 * DM + h * 64, DM,
                                      KE + row0 * 128 + kvh * 64, 128, VTE + (size_t)(b * 2 + kvh) * 64 * 256, 256, 0, 4,
                                      nullptr, 0, nullptr, 0, 0, 0.f, 0.f, -1, tid);
                        } else { const int e = it - 256; spatial_unit(lds, e >> 2, e & 3, w_spatial, b_spatial, v_norm_b, ssv, VBT, MIX, tid); }
                    }
                }
            } else if (st == 7) {
                const float* sink_c = INP(20);
                if (lat) {
                    for (int it = rel; it < 1024; it += nc) {
                        const int b = it >> 7, h = (it >> 3) & 15, qb = it & 7, kvh = h >> 2;
                        const size_t row0 = NCTX + (size_t)b * 2048 + qb * 256;
                        const int q0 = qb * 256; int klo = q0 - 128; if (klo < 0) klo = 0; int khi = q0 + 384; if (khi > 2048) khi = 2048;
                        attn_unit(lds, Qb + row0 * 1024 + h * 64, 1024, MIX + row0 * DM + h * 64, DM,
                                  KO + ((size_t)NCTX + (size_t)b * 2048) * 256 + kvh * 64, 256, VTO + (size_t)NCTX * 256 + (size_t)(b * 4 + kvh) * 64 * 2048, 2048, klo >> 6, (khi - klo) >> 6,
                                  CK_C + (size_t)b * 512 * 256 + kvh * 64, 256, CVT_C + (size_t)(b * 4 + kvh) * 64 * 512, 512, 8, sink_c[h] * LOG2E, 1.0f, q0, tid);
                    }
                } else {
                    for (int it = rel; it < 512; it += nc) {
                        const int b = it >> 4, h = it & 15, kvh = h >> 2;
                        const size_t row0 = (size_t)b * 256;
                        attn_unit(lds, Qb + row0 * 1024 + h * 64, 1024, MIX + row0 * DM + h * 64, DM,
                                  KO + row0 * 256 + kvh * 64, 256, VTO + (size_t)(b * 4 + kvh) * 64 * 256, 256, 0, 4,
                                  nullptr, 0, nullptr, 0, 0, sink_c[h] * LOG2E, 1.0f, -1, tid);
                    }
                }
            }
        }
        }
        if constexpr (COOP) {
            if (ph + 1 < hi) { XcdBarrier xb = xbar; asm volatile("" : "+s"(xb.bar), "+s"(xb.x)); xcd_barrier(xb); }
        }
    }
    if (!COOP && MK_TP_LO >= 0 && lo == 14 && blockIdx.x == 0 && threadIdx.x == 0) {
        const unsigned long long* ts = (const unsigned long long*)(P.ws + WS_TS);
        float* o = P.out + (size_t)MTOK * DM;
        o[0] += (float)(ts[1] - ts[0]) * 1e-4f;
    }
#undef IN
#undef SEAM
}

constexpr int N_PHASES = 15;

extern "C" void kernel_launch(void* const* d_in, const int* in_sizes, int n_in, void* d_out, int out_size, void* d_ws, size_t ws_size, hipStream_t stream) {
    static int grid = 0;
    if (grid == 0) {
        int dev = 0, cus = 0;
        hipGetDevice(&dev);
        hipDeviceGetAttribute(&cus, hipDeviceAttributeMultiprocessorCount, dev);
        hipFuncSetAttribute((const void*)mk_fwd<true>, hipFuncAttributeMaxDynamicSharedMemorySize, LDS_BYTES);
        hipFuncSetAttribute((const void*)mk_fwd<false>, hipFuncAttributeMaxDynamicSharedMemorySize, LDS_BYTES);
        int per_cu = 0;
        hipOccupancyMaxActiveBlocksPerMultiprocessor(&per_cu, (const void*)mk_fwd<true>, 512, LDS_BYTES);
        (void)hipGetLastError();
        if (per_cu < 1) fprintf(stderr, "kernel_launch: occupancy query says %d blocks/CU\n", per_cu);
        grid = cus > 0 ? cus : 256;
        if (n_in != 26 || ws_size < WS_END) { fprintf(stderr, "kernel_launch: unexpected n_in %d / ws %zu\n", n_in, ws_size); }
    }
    hipMemsetAsync((char*)d_ws, 0, WS_ZERO_BYTES, stream);
    Params p{};
    for (int i = 0; i < 26; ++i) p.in[i] = (const float*)d_in[i];
    p.out = (float*)d_out; p.ws = (unsigned char*)d_ws;
#if MK_COOP
    p.ph_lo = 0; p.ph_hi = N_PHASES;
    void* args[] = {&p};
    hipError_t e = hipLaunchCooperativeKernel((const void*)mk_fwd<true>, dim3(grid), dim3(512), args, LDS_BYTES, stream);
    if (e != hipSuccess) fprintf(stderr, "cooperative launch failed: %s (grid %d)\n", hipGetErrorString(e), grid);
#else
    for (int ph = 0; ph < N_PHASES; ++ph) {
        p.ph_lo = ph; p.ph_hi = ph + 1;
        hipLaunchKernelGGL(mk_fwd<false>, dim3(grid), dim3(512), LDS_BYTES, stream, p);
        if (ph == MK_DUP) hipLaunchKernelGGL(mk_fwd<false>, dim3(grid), dim3(512), LDS_BYTES, stream, p);
    }
#endif
}
```

```cpp
#include <hip/hip_runtime.h>
#include <hip/hip_cooperative_groups.h>
#include <cstdio>
#include <cstdint>
namespace cg = cooperative_groups;

#ifndef MK_COOP
#define MK_COOP 1
#endif

#ifndef MK_DUP
#define MK_DUP -1
#endif
#ifndef MK_TP_LO
#define MK_TP_LO -1
#define MK_TP_HI -1
#endif
#define LAS __attribute__((address_space(3)))
typedef unsigned short bf16_t;
typedef short bf16x8 __attribute__((ext_vector_type(8)));
typedef short s16x4 __attribute__((ext_vector_type(4)));
typedef float f32x4 __attribute__((ext_vector_type(4)));
typedef float f32x2 __attribute__((ext_vector_type(2)));
typedef float f32x16 __attribute__((ext_vector_type(16)));
typedef unsigned u32x4 __attribute__((ext_vector_type(4)));
typedef unsigned u32x2 __attribute__((ext_vector_type(2)));

constexpr int DM = 1024, NCTX = 8192, NLAT = 16384, MTOK = 24576;
constexpr int EVEN_IN = 1792, ODD_IN = 1536, FF = 2816, FF2 = 5632;
constexpr int NCOND = 9, MODW = 6144;
constexpr float EPS = 1e-6f;
constexpr float LOG2E = 1.4426950408889634f;

constexpr size_t MiB = 1u << 20;
constexpr size_t WS_MOD = 0;
constexpr size_t WS_SS1 = 442368, WS_SS2 = WS_SS1 + 98304, WS_SS3 = WS_SS2 + 98304, WS_SSV = WS_SS3 + 98304;
constexpr size_t WS_BAR = 900 * 1024;
constexpr size_t WS_ZERO_BYTES = 1 * MiB;
constexpr size_t WS_SS0 = 1 * MiB;
constexpr size_t WS_ROPE = 1 * MiB + 128 * 1024;
constexpr size_t WS_TS = 1 * MiB + 192 * 1024;
constexpr size_t WS_BIAS = 1 * MiB + 256 * 1024;
constexpr size_t WS_ZB = 2 * MiB;
constexpr size_t WS_CK_A = 11 * MiB, WS_CVT_A = 12 * MiB, WS_CK_C = 13 * MiB, WS_CVT_C = 15 * MiB;
constexpr size_t WS_W_INE = 18 * MiB, WS_W_OUTE = 22 * MiB, WS_W_INO = 24 * MiB, WS_W_OUTO = 27 * MiB, WS_W_UP = 29 * MiB, WS_W_DN = 51 * MiB;
constexpr size_t WS_A = 62 * MiB;
constexpr size_t WS_BIG = 110 * MiB;
constexpr size_t WS_ACT = WS_BIG;
constexpr size_t WS_MIX = WS_BIG;
constexpr size_t WS_Q = WS_BIG + 48 * MiB;
constexpr size_t WS_KE = WS_Q + 24 * MiB, WS_VTE = WS_KE + 6 * MiB, WS_VBT = WS_VTE + 6 * MiB;
constexpr size_t WS_KO = WS_Q + 48 * MiB, WS_VTO = WS_KO + 12 * MiB;
constexpr size_t WS_END = 256 * MiB;
static_assert(WS_VBT + 24 * MiB <= WS_END && WS_VTO + 12 * MiB <= WS_END && WS_ACT + 132 * MiB <= WS_END, "ws map");
constexpr size_t BIAS_INE = 0, BIAS_UP0 = 9 * 1792, BIAS_INO = BIAS_UP0 + 9 * 5632, BIAS_UP1 = BIAS_INO + 9 * 1536;

constexpr int LDS_BYTES = 147456;
constexpr int LDS_SPARE = 131072;

struct Params {
    const float* in[26];
    float* out;
    unsigned char* ws;
    int ph_lo, ph_hi;
};

namespace pg8 {
constexpr int BM = 256, BK = 64, HALF = 128, HTB = HALF * BK * 2, STAGE_BYTES = 8 * HTB, NXCD = 8, WGM = 8;
__host__ __device__ __forceinline__ int lds_byte(int r, int c) { const int st = (r >> 4) * 2 + (c >> 5), rr = r & 15, cc = c & 31, ob = rr * 64 + cc * 2; return st * 1024 + (ob ^ (((ob >> 9) & 1) << 5)); }
__host__ __device__ __forceinline__ void stage_rc(int b, int& R, int& C) { const int st = b / 1024, sb = b % 1024, swz = sb ^ (((sb >> 9) & 1) << 5); R = (st >> 1) * 16 + swz / 64; C = (st & 1) * 32 + (swz % 64) / 2; }
__host__ __device__ __forceinline__ int perm32(int rho) { const int n = rho >> 4, i = rho & 15; return 8 * (i >> 2) + 4 * n + (i & 3); }
struct Unit { int pm, pn; };
struct Gemm { const bf16_t* A; const bf16_t* Bt; int M, N, K; };
struct StaticOrder {
    int nM, nN, nwg, nc, rel, pm0;
    __device__ __forceinline__ void init(int pm0_, int nM_, int N, int G, int c, int c0, int nc_) { pm0 = pm0_; nM = nM_; nN = N / BM; nwg = nM * nN; nc = nc_; rel = (c - c0 + G) % G; }
    __device__ __forceinline__ bool next(int i, Unit& u) const {
        if (rel >= nc) return false;
        const long L = (long)i * nc + rel; if (L >= nwg) return false;
        int wgid = (int)L; { const int q = nwg / NXCD, r = nwg % NXCD, xcd = wgid % NXCD, off = wgid / NXCD; wgid = (xcd < r ? xcd * (q + 1) : r * (q + 1) + (xcd - r) * q) + off; }
        const int nig = WGM * nN, gid = wgid / nig, fm = gid * WGM, gsz = (nM - fm) < WGM ? (nM - fm) : WGM;
        u.pm = pm0 + fm + ((wgid % nig) % gsz); u.pn = (wgid % nig) / gsz; return true;
    }
};
__device__ __forceinline__ unsigned cvt_pk_bf16(float lo, float hi) { unsigned r; asm volatile("v_cvt_pk_bf16_f32 %0, %1, %2" : "=v"(r) : "v"(lo), "v"(hi)); return r; }

template <class Epi, bool ALIGN_EPI>
__device__ __forceinline__ void gemm_phase(LAS unsigned char* lds, const Gemm g, const StaticOrder& S, const Epi& E, const int tid) {
    const int wid = __builtin_amdgcn_readfirstlane(tid >> 6), lane = tid & 63, wr = wid >> 2, wc = wid & 3, fr = lane & 15, fq = lane >> 4;
    const int K = g.K, nt = K / BK;
    unsigned voffA[2], voffB[2];
#pragma unroll
    for (int i = 0; i < 2; ++i) { int R, C; stage_rc(tid * 16 + i * 8192, R, C); const int Rb = (R & ~31) + perm32(R & 31);
        voffA[i] = (unsigned)(R * K + C) * 2u; voffB[i] = (unsigned)(Rb * K + C) * 2u; }
    const size_t kstep = (size_t)(BK * 2);
    const size_t hstep = (size_t)HALF * K * 2;
    const size_t tstep = 2 * hstep;
    const unsigned ldsw = (unsigned)wid * 1024u;
    const int aoff = lds_byte(wr * 64 + fr, fq * 8), boff = lds_byte(wc * 32 + fr, fq * 8);
#define PG8_SA(b, h) (((b) * 2 + (h)) * HTB)
#define PG8_SB(b, h) ((4 + (b) * 2 + (h)) * HTB)
#define PG8_STAGE(bufoff, gbase, voff) do { _Pragma("unroll") for (int _i = 0; _i < 2; ++_i) \
        __builtin_amdgcn_global_load_lds((const unsigned*)((const char*)(gbase) + (voff)[_i]), (LAS unsigned*)(lds + (bufoff) + ldsw + _i * 8192), 16, 0, 0); } while (0)
#define PG8_LDA(dst, b, h) do { _Pragma("unroll") for (int m = 0; m < 4; ++m) _Pragma("unroll") for (int k = 0; k < 2; ++k) dst[m][k] = *(const LAS bf16x8*)(lds + PG8_SA(b, h) + aoff + m * 2048 + k * 1024); } while (0)
#define PG8_LDB(dst, b, h) do { _Pragma("unroll") for (int n = 0; n < 2; ++n) _Pragma("unroll") for (int k = 0; k < 2; ++k) dst[n][k] = *(const LAS bf16x8*)(lds + PG8_SB(b, h) + boff + n * 2048 + k * 1024); } while (0)
#define PG8_MMA(ai, bj, At, Bt) do { __builtin_amdgcn_s_setprio(1); _Pragma("unroll") for (int m = 0; m < 4; ++m) _Pragma("unroll") for (int n = 0; n < 2; ++n) _Pragma("unroll") for (int k = 0; k < 2; ++k) \
        acc[ai][bj][m][n] = __builtin_amdgcn_mfma_f32_16x16x32_bf16(Bt[n][k], At[m][k], acc[ai][bj][m][n], 0, 0, 0); __builtin_amdgcn_s_setprio(0); } while (0)
#define PG8_WAIT_V(n) asm volatile("s_waitcnt vmcnt(" #n ")" ::: "memory")
#define PG8_WAIT_L(n) asm volatile("s_waitcnt lgkmcnt(" #n ")" ::: "memory")
#define PG8_BAR __builtin_amdgcn_s_barrier()
#define PG8_SCHED __builtin_amdgcn_sched_barrier(0)
    Unit cur, nxt; int ui = 0;
    if (!S.next(0, cur)) return;
    f32x4 acc[2][2][4][2];
#pragma unroll
    for (int a = 0; a < 2; ++a)
#pragma unroll
        for (int b = 0; b < 2; ++b)
#pragma unroll
            for (int m = 0; m < 4; ++m)
#pragma unroll
                for (int n = 0; n < 2; ++n) acc[a][b][m][n] = (f32x4){0.f, 0.f, 0.f, 0.f};
    bf16x8 At[4][2], B0[2][2], B1[2][2];
    const char* cA = (const char*)g.A + (size_t)cur.pm * tstep; const char* cB = (const char*)g.Bt + (size_t)cur.pn * tstep;
    PG8_STAGE(PG8_SB(0, 0), cB, voffB); PG8_STAGE(PG8_SB(0, 1), cB + hstep, voffB); PG8_STAGE(PG8_SA(0, 0), cA, voffA); PG8_STAGE(PG8_SA(0, 1), cA + hstep, voffA);
    if (wr == 1) PG8_BAR;
    PG8_WAIT_V(2); PG8_BAR;
    PG8_STAGE(PG8_SB(1, 0), cB + kstep, voffB); PG8_STAGE(PG8_SA(1, 0), cA + kstep, voffA); PG8_STAGE(PG8_SB(1, 1), cB + hstep + kstep, voffB);
    PG8_WAIT_V(6); PG8_BAR;
    for (;;) {
        const bool has_next = S.next(ui + 1, nxt);
        const char* nA = has_next ? (const char*)g.A + (size_t)nxt.pm * tstep : cA; const char* nB = has_next ? (const char*)g.Bt + (size_t)nxt.pn * tstep : cB;
        for (int t = 0; t < nt; t += 2) {
            const bool last = (t == nt - 2);
            const char* a1 = cA + (size_t)(t + 1) * kstep;
            const char* a2 = last ? nA : cA + (size_t)(t + 2) * kstep; const char* b2 = last ? nB : cB + (size_t)(t + 2) * kstep;
            const char* a3 = a2 + kstep; const char* b3 = b2 + kstep;
            PG8_LDB(B0, 0, 0); PG8_LDB(B1, 0, 1); PG8_SCHED; PG8_LDA(At, 0, 0); PG8_STAGE(PG8_SA(1, 1), a1 + hstep, voffA);
            PG8_WAIT_V(8); PG8_WAIT_L(0); PG8_BAR; PG8_MMA(0, 0, At, B0); PG8_MMA(0, 1, At, B1); PG8_BAR; PG8_SCHED;
            PG8_LDA(At, 0, 1); PG8_STAGE(PG8_SB(0, 0), b2, voffB); PG8_STAGE(PG8_SB(0, 1), b2 + hstep, voffB); PG8_STAGE(PG8_SA(0, 0), a2, voffA);
            PG8_WAIT_V(8); PG8_WAIT_L(0); PG8_BAR; PG8_MMA(1, 0, At, B0); PG8_MMA(1, 1, At, B1); PG8_BAR; PG8_SCHED;
            PG8_LDB(B0, 1, 0); PG8_LDB(B1, 1, 1); PG8_SCHED; PG8_LDA(At, 1, 0); PG8_STAGE(PG8_SA(0, 1), a2 + hstep, voffA);
            PG8_WAIT_V(8); PG8_WAIT_L(0); PG8_BAR; PG8_MMA(0, 0, At, B0); PG8_MMA(0, 1, At, B1); PG8_BAR; PG8_SCHED;
            PG8_LDA(At, 1, 1); PG8_STAGE(PG8_SB(1, 0), b3, voffB); PG8_STAGE(PG8_SB(1, 1), b3 + hstep, voffB); PG8_STAGE(PG8_SA(1, 0), a3, voffA);
            PG8_WAIT_V(8); PG8_WAIT_L(0); PG8_BAR; PG8_MMA(1, 0, At, B0); PG8_MMA(1, 1, At, B1); PG8_BAR; PG8_SCHED;
        }
        typename Epi::Pre pre; E.prefetch(pre, cur, wr, wc, fr, fq);
        if constexpr (ALIGN_EPI) { if (wr == 0) PG8_BAR; }
        E(acc, cur, wr, wc, fr, fq, pre);
        if (!has_next) break;
#pragma unroll
        for (int a = 0; a < 2; ++a)
#pragma unroll
            for (int b = 0; b < 2; ++b)
#pragma unroll
                for (int m = 0; m < 4; ++m)
#pragma unroll
                    for (int n = 0; n < 2; ++n) acc[a][b][m][n] = (f32x4){0.f, 0.f, 0.f, 0.f};
        cur = nxt; cA = nA; cB = nB; ++ui;
        if constexpr (ALIGN_EPI) { if (wr == 1) PG8_BAR; }
    }
    PG8_WAIT_V(0);
    if constexpr (!ALIGN_EPI) { if (wr == 0) PG8_BAR; }
    PG8_BAR;
#undef PG8_SA
#undef PG8_SB
#undef PG8_STAGE
#undef PG8_LDA
#undef PG8_LDB
#undef PG8_MMA
#undef PG8_WAIT_V
#undef PG8_WAIT_L
#undef PG8_BAR
#undef PG8_SCHED
}
}

using pg8::cvt_pk_bf16;
typedef f32x4 (&AccRef)[2][2][4][2];

__device__ __forceinline__ int cond_of_tile(int pm) { return pm < 32 ? 0 : 1 + ((pm - 32) >> 3); }
__device__ __forceinline__ float red_fq(float v) { v += __shfl_xor(v, 16); v += __shfl_xor(v, 32); return v; }
__device__ __forceinline__ float gelu_tanh(float x) { const float u = x + 0.044715f * x * x * x; return x * __builtin_amdgcn_rcpf(1.0f + __builtin_amdgcn_exp2f(-2.302208198f * u)); }
__device__ __forceinline__ float silu_f(float x) { return x * __builtin_amdgcn_rcpf(1.0f + __builtin_amdgcn_exp2f(-LOG2E * x)); }
__device__ __forceinline__ u32x4 pack8(const f32x4 a, const f32x4 b) { u32x4 w; w.x = cvt_pk_bf16(a[0], a[1]); w.y = cvt_pk_bf16(a[2], a[3]); w.z = cvt_pk_bf16(b[0], b[1]); w.w = cvt_pk_bf16(b[2], b[3]); return w; }
__device__ __forceinline__ float bf2f(unsigned short h) { return __uint_as_float((unsigned)h << 16); }

template <class T> __device__ __forceinline__ T ldg(const void* base, unsigned off) { return *(const T*)((const char*)base + off); }
template <class T> __device__ __forceinline__ void stg(void* base, unsigned off, T v) { *(T*)((char*)base + off) = v; }
__device__ __forceinline__ float ss4(const f32x4 v) { return (v[0] * v[0] + v[1] * v[1]) + (v[2] * v[2] + v[3] * v[3]); }

struct EpiRes {
    const float* xp; const float* xs; float* out; const float* gate; const float* nscale; bf16_t* An; float* ssn;
    struct Pre { f32x4 x[2][2][2]; };
    __device__ __forceinline__ void prefetch(Pre& p, const pg8::Unit& u, int wr, int wc, int fr, int fq) const {
        const unsigned colbase = u.pn * 256 + wc * 32 + 8 * fq;
        const bool ctx = u.pm < 32; const float* xb = ctx ? xp : xs; const unsigned rsub = ctx ? 0u : (unsigned)NCTX;
#pragma unroll
        for (int q = 0; q < 2; ++q) {
            const unsigned row = u.pm * 256 + wr * 64 + q * 16 + fr;
            const unsigned xoff = ((row - rsub) * DM + colbase) * 4u;
#pragma unroll
            for (int bj = 0; bj < 2; ++bj)
#pragma unroll
                for (int n = 0; n < 2; ++n) p.x[q][bj][n] = ldg<f32x4>(xb, xoff + bj * 512 + n * 16);
        }
    }
    __device__ __forceinline__ void operator()(AccRef acc, const pg8::Unit& u, int wr, int wc, int fr, int fq, const Pre& pre) const {
        const int cond = cond_of_tile(u.pm);
        const unsigned colbase = u.pn * 256 + wc * 32 + 8 * fq;
        const bool ctx = u.pm < 32;
        const float* xb = ctx ? xp : xs;
        const unsigned rsub = ctx ? 0u : (unsigned)NCTX;
        const unsigned moff = (cond * MODW + colbase) * 4u;
        f32x4 gt[2][2], sc[2][2];
#pragma unroll
        for (int bj = 0; bj < 2; ++bj)
#pragma unroll
            for (int n = 0; n < 2; ++n) {
                gt[bj][n] = ldg<f32x4>(gate, moff + bj * 512 + n * 16);
                sc[bj][n] = An ? ldg<f32x4>(nscale, moff + bj * 512 + n * 16) + 1.0f : (f32x4){1.f, 1.f, 1.f, 1.f};
            }
#pragma unroll
        for (int ai = 0; ai < 2; ++ai)
#pragma unroll
            for (int mp = 0; mp < 2; ++mp) {
                f32x4 xo[2][2][2];
#pragma unroll
                for (int q = 0; q < 2; ++q) {
                    const unsigned row = u.pm * 256 + ai * 128 + wr * 64 + (2 * mp + q) * 16 + fr;
                    const unsigned xoff = ((row - rsub) * DM + colbase) * 4u;
#pragma unroll
                    for (int bj = 0; bj < 2; ++bj)
#pragma unroll
                        for (int n = 0; n < 2; ++n) xo[q][bj][n] = (ai == 0 && mp == 0) ? pre.x[q][bj][n] : ldg<f32x4>(xb, xoff + bj * 512 + n * 16);
                }
#pragma unroll
                for (int q = 0; q < 2; ++q) {
                    const int m = 2 * mp + q;
                    const unsigned row = u.pm * 256 + ai * 128 + wr * 64 + m * 16 + fr;
                    const unsigned ooff = (row * DM + colbase) * 4u;
                    float ssum = 0.f;
#pragma unroll
                    for (int bj = 0; bj < 2; ++bj) {
                        f32x4 xn[2];
#pragma unroll
                        for (int n = 0; n < 2; ++n) {
                            xn[n] = xo[q][bj][n] + gt[bj][n] * acc[ai][bj][m][n];
                            stg<f32x4>(out, ooff + bj * 512 + n * 16, xn[n]);
                            ssum += ss4(xn[n]);
                        }
                        if (An) stg<u32x4>(An, (row * DM + colbase) * 2u + bj * 256, pack8(xn[0] * sc[bj][0], xn[1] * sc[bj][1]));
                    }
                    if (ssn) { ssum = red_fq(ssum); if (fq == 0) atomicAdd((float*)((char*)ssn + row * 4u), ssum); }
                }
                asm volatile("" ::: "memory");
            }
    }
};

template <bool EVEN>
struct EpiIn {
    unsigned char* wsb; float* outb;
    const float* qg; const float* kg;
    struct Pre { float ssr[8]; f32x4 bv[2][2]; };
    __device__ __forceinline__ void prefetch(Pre& p, const pg8::Unit& u, int wr, int wc, int fr, int fq) const {
        const float* ss_ = (const float*)(wsb + (EVEN ? WS_SS0 : WS_SS2));
        const float* bias_ = (const float*)(wsb + WS_BIAS) + (EVEN ? BIAS_INE : BIAS_INO);
        const unsigned boff_ = (cond_of_tile(u.pm) * (EVEN ? EVEN_IN : ODD_IN) + u.pn * 256 + wc * 32 + 8 * fq) * 4u;
#pragma unroll
        for (int g8 = 0; g8 < 8; ++g8) p.ssr[g8] = ldg<float>(ss_, (u.pm * 256 + (g8 >> 2) * 128 + wr * 64 + (g8 & 3) * 16 + fr) * 4u);
#pragma unroll
        for (int bj = 0; bj < 2; ++bj)
#pragma unroll
            for (int n = 0; n < 2; ++n) p.bv[bj][n] = ldg<f32x4>(bias_, boff_ + bj * 512 + n * 16);
    }
    __device__ __forceinline__ void operator()(AccRef acc, const pg8::Unit& u, int wr, int wc, int fr, int fq, const Pre& pre) const {
        constexpr unsigned N = EVEN ? EVEN_IN : ODD_IN, QW = EVEN ? 512 : 1024, KVH = EVEN ? 2 : 4, KW = KVH * 64;
        const float* ss = (const float*)(wsb + (EVEN ? WS_SS0 : WS_SS2));
        const float* bias = (const float*)(wsb + WS_BIAS) + (EVEN ? BIAS_INE : BIAS_INO);
        const float* rope = (const float*)(wsb + WS_ROPE);
        bf16_t* Q = (bf16_t*)(wsb + WS_Q); bf16_t* K = (bf16_t*)(wsb + (EVEN ? WS_KE : WS_KO)); bf16_t* Vt = (bf16_t*)(wsb + (EVEN ? WS_VTE : WS_VTO));
        bf16_t* MIX = (bf16_t*)(wsb + WS_MIX); bf16_t* VbT = (bf16_t*)(wsb + WS_VBT); float* ssv = (float*)(wsb + WS_SSV);
        float* outk = outb + (size_t)MTOK * DM + (EVEN ? 0 : NCTX * 256); float* outv = outk + NCTX * KW;
        const int cond = cond_of_tile(u.pm);
        int role; unsigned hidx;
        if (EVEN) { if (u.pn < 2) { role = 0; hidx = 4 * u.pn + wc; } else if (u.pn == 2) { role = wc < 2 ? 1 : 2; hidx = wc & 1; } else if (u.pn < 5) { role = 3; hidx = (u.pn - 3) * 4 + wc; } else { role = 4; hidx = (u.pn - 5) * 4 + wc; } }
        else { if (u.pn < 4) { role = 0; hidx = 4 * u.pn + wc; } else if (u.pn == 4) { role = 1; hidx = wc; } else { role = 2; hidx = wc; } }
        const unsigned boff = (cond * N + u.pn * 256 + wc * 32 + 8 * fq) * 4u;
        const bool lat = u.pm >= 32;
        const unsigned c8 = hidx * 64 + 8 * fq;
        const float* gp = role == 0 ? qg : kg;
        f32x4 bvh[2][2];
#pragma unroll
        for (int bj = 0; bj < 2; ++bj)
#pragma unroll
            for (int n = 0; n < 2; ++n) bvh[bj][n] = pre.bv[bj][n];
        float rrs[8];
#pragma unroll
        for (int g8 = 0; g8 < 8; ++g8) rrs[g8] = __builtin_amdgcn_rsqf(pre.ssr[g8] * (1.0f / DM) + EPS);
#pragma unroll
        for (int ai = 0; ai < 2; ++ai)
#pragma unroll
            for (int m = 0; m < 4; ++m) {
                const unsigned row = u.pm * 256 + ai * 128 + wr * 64 + m * 16 + fr;
                const float rr = rrs[ai * 4 + m];
                f32x4 z[2][2];
#pragma unroll
                for (int bj = 0; bj < 2; ++bj)
#pragma unroll
                    for (int n = 0; n < 2; ++n) z[bj][n] = acc[ai][bj][m][n] * rr + bvh[bj][n];
                if (role <= 1) {
                    float s2 = (ss4(z[0][0]) + ss4(z[0][1])) + (ss4(z[1][0]) + ss4(z[1][1]));
                    s2 = red_fq(s2);
                    const float rn = __builtin_amdgcn_rsqf(s2 * (1.0f / 64.0f) + EPS);
#pragma unroll
                    for (int bj = 0; bj < 2; ++bj)
#pragma unroll
                        for (int n = 0; n < 2; ++n) z[bj][n] = z[bj][n] * rn * ldg<f32x4>(gp, (8 * fq) * 4u + bj * 128 + n * 16);
                    if (role == 1 && !lat) {
#pragma unroll
                        for (int bj = 0; bj < 2; ++bj)
#pragma unroll
                            for (int n = 0; n < 2; ++n) stg<f32x4>(outk, (row * KW + c8) * 4u + bj * 128 + n * 16, z[bj][n]);
                    }
                    if (lat) {
                        const unsigned t = (row - NCTX) & 2047u;
#pragma unroll
                        for (int bj = 0; bj < 2; ++bj) {
                            const unsigned pos = bj == 0 ? (t >> 6) : (t & 63u);
#pragma unroll
                            for (int n = 0; n < 2; ++n) {
                                const f32x4 cs = ldg<f32x4>(rope, (pos * 16 + 4 * fq) * 8u + n * 16);
                                const f32x4 v = z[bj][n];
                                z[bj][n] = (f32x4){v[0] * cs[0] - v[1] * cs[1], v[0] * cs[1] + v[1] * cs[0], v[2] * cs[2] - v[3] * cs[3], v[2] * cs[3] + v[3] * cs[2]};
                            }
                        }
                    }
                    if (role == 0) {
#pragma unroll
                        for (int bj = 0; bj < 2; ++bj) stg<u32x4>(Q, (row * QW + c8) * 2u + bj * 64, pack8(z[bj][0] * (0.125f * LOG2E), z[bj][1] * (0.125f * LOG2E)));
                    } else {
#pragma unroll
                        for (int bj = 0; bj < 2; ++bj) stg<u32x4>(K, (row * KW + c8) * 2u + bj * 64, pack8(z[bj][0], z[bj][1]));
                    }
                } else if (role == 2) {
                    if (!lat) {
#pragma unroll
                        for (int bj = 0; bj < 2; ++bj)
#pragma unroll
                            for (int n = 0; n < 2; ++n) stg<f32x4>(outv, (row * KW + c8) * 4u + bj * 128 + n * 16, z[bj][n]);
                    }
                    unsigned vb, T;
                    if (!lat) { T = 256; vb = ((row >> 8) * KVH + hidx) * 64 * 256 + (row & 255u); }
                    else { T = 2048; vb = NCTX * KW + (((row - NCTX) >> 11) * KVH + hidx) * 64 * 2048 + ((row - NCTX) & 2047u); }
                    vb += 8 * fq * T;
#pragma unroll
                    for (int bj = 0; bj < 2; ++bj)
#pragma unroll
                        for (int n = 0; n < 2; ++n)
#pragma unroll
                            for (int i = 0; i < 4; ++i) stg<bf16_t>(Vt, (vb + (32 * bj + 4 * n + i) * T) * 2u, (bf16_t)(cvt_pk_bf16(z[bj][n][i], 0.f) & 0xffffu));
                } else if (EVEN && role == 3) {
#pragma unroll
                    for (int bj = 0; bj < 2; ++bj) {
                        f32x4 a = z[bj][0], b = z[bj][1];
#pragma unroll
                        for (int i = 0; i < 4; ++i) { a[i] = gelu_tanh(a[i]); b[i] = gelu_tanh(b[i]); }
                        stg<u32x4>(MIX, (row * DM + 512 + c8) * 2u + bj * 64, pack8(a, b));
                    }
                } else if (EVEN) {
                    float s2 = 0.f;
                    const unsigned cb = (row >> 7) * 512 * 128 + (row & 127u) + c8 * 128;
#pragma unroll
                    for (int bj = 0; bj < 2; ++bj)
#pragma unroll
                        for (int n = 0; n < 2; ++n)
#pragma unroll
                            for (int i = 0; i < 4; ++i) {
                                const float gv = gelu_tanh(z[bj][n][i]); s2 += gv * gv;
                                stg<bf16_t>(VbT, (cb + (32 * bj + 4 * n + i) * 128) * 2u, (bf16_t)(cvt_pk_bf16(gv, 0.f) & 0xffffu));
                            }
                    s2 = red_fq(s2);
                    if (fq == 0) atomicAdd((float*)((char*)ssv + row * 4u), s2);
                }
                asm volatile("" ::: "memory");
            }
    }
};

template <int CTRL> __device__ __forceinline__ float dpp_rot(float v) { return __builtin_bit_cast(float, __builtin_amdgcn_update_dpp(0, __builtin_bit_cast(int, v), CTRL, 0xf, 0xf, false)); }
__device__ __forceinline__ void conv_taps(f32x4& res, const f32x4 sp, const f32x4 sn, const f32x4 w0, const f32x4 w2) {
    float r0 = res[0], r1 = res[1], r2 = res[2], r3 = res[3];
    asm("s_nop 1\n\t"
        "v_fmac_f32_dpp %0, %4, %12 row_ror:1 row_mask:0xf bank_mask:0xf\n\t"
        "v_fmac_f32_dpp %1, %5, %13 row_ror:1 row_mask:0xf bank_mask:0xf\n\t"
        "v_fmac_f32_dpp %2, %6, %14 row_ror:1 row_mask:0xf bank_mask:0xf\n\t"
        "v_fmac_f32_dpp %3, %7, %15 row_ror:1 row_mask:0xf bank_mask:0xf\n\t"
        "v_fmac_f32_dpp %0, %8, %16 row_ror:15 row_mask:0xf bank_mask:0xf\n\t"
        "v_fmac_f32_dpp %1, %9, %17 row_ror:15 row_mask:0xf bank_mask:0xf\n\t"
        "v_fmac_f32_dpp %2, %10, %18 row_ror:15 row_mask:0xf bank_mask:0xf\n\t"
        "v_fmac_f32_dpp %3, %11, %19 row_ror:15 row_mask:0xf bank_mask:0xf"
        : "+v"(r0), "+v"(r1), "+v"(r2), "+v"(r3)
        : "v"(sp[0]), "v"(sp[1]), "v"(sp[2]), "v"(sp[3]), "v"(sn[0]), "v"(sn[1]), "v"(sn[2]), "v"(sn[3]),
          "v"(w0[0]), "v"(w0[1]), "v"(w0[2]), "v"(w0[3]), "v"(w2[0]), "v"(w2[1]), "v"(w2[2]), "v"(w2[3]));
    res = (f32x4){r0, r1, r2, r3};
}
struct EpiUp {
    unsigned char* wsb; unsigned ss_off, bias_off; const float* cw; const float* cbias;
    LAS float* xch;
    struct Pre { float ssr[8]; f32x4 bv[2][2]; };
    __device__ __forceinline__ void prefetch(Pre& p, const pg8::Unit& u, int wr, int wc, int fr, int fq) const {
        const float* ss_ = (const float*)(wsb + ss_off); const float* bias_ = (const float*)(wsb + WS_BIAS) + bias_off;
        const unsigned boff_ = (cond_of_tile(u.pm) * FF2 + u.pn * 256 + wc * 32 + 8 * fq) * 4u;
#pragma unroll
        for (int g8 = 0; g8 < 8; ++g8) p.ssr[g8] = ldg<float>(ss_, (u.pm * 256 + (g8 >> 2) * 128 + wr * 64 + (g8 & 3) * 16 + fr) * 4u);
#pragma unroll
        for (int bj = 0; bj < 2; ++bj)
#pragma unroll
            for (int n = 0; n < 2; ++n) p.bv[bj][n] = ldg<f32x4>(bias_, boff_ + bj * 512 + n * 16);
    }
    __device__ __forceinline__ void operator()(AccRef acc, const pg8::Unit& u, int wr, int wc, int fr, int fq, const Pre& pre) const {
        const float* ss = (const float*)(wsb + ss_off); const float* bias = (const float*)(wsb + WS_BIAS) + bias_off;
        float* ZB = (float*)(wsb + WS_ZB); bf16_t* ACT = (bf16_t*)(wsb + WS_ACT);
        const int cond = cond_of_tile(u.pm);
        const unsigned nb = u.pn * 256 + wc * 32 + 8 * fq;
        const unsigned boff = (cond * FF2 + nb) * 4u;
#pragma unroll
        for (int ai = 0; ai < 2; ++ai)
#pragma unroll
            for (int m = 0; m < 4; ++m) {
                const float rr = __builtin_amdgcn_rsqf(pre.ssr[ai * 4 + m] * (1.0f / DM) + EPS);
#pragma unroll
                for (int bj = 0; bj < 2; ++bj)
#pragma unroll
                    for (int n = 0; n < 2; ++n) acc[ai][bj][m][n] = acc[ai][bj][m][n] * rr + pre.bv[bj][n];
            }
        if (wr == 0 && fr < 2) {
            const unsigned zo = ((u.pm * 4 + fr) * FF2 + nb) * 4u;
#pragma unroll
            for (int bj = 0; bj < 2; ++bj)
#pragma unroll
                for (int n = 0; n < 2; ++n) stg<f32x4>(ZB, zo + bj * 512 + n * 16, acc[0][bj][0][n]);
        }
        if (wr == 1 && fr >= 14) {
            const unsigned zo = ((u.pm * 4 + 2 + (fr - 14)) * FF2 + nb) * 4u;
#pragma unroll
            for (int bj = 0; bj < 2; ++bj)
#pragma unroll
                for (int n = 0; n < 2; ++n) stg<f32x4>(ZB, zo + bj * 512 + n * 16, acc[1][bj][3][n]);
        }
        LAS float* my = xch + (wr * 4 + wc) * 256 + 8 * fq;
        if (fr == 0) {
#pragma unroll
            for (int ai = 0; ai < 2; ++ai)
#pragma unroll
                for (int bj = 0; bj < 2; ++bj)
#pragma unroll
                    for (int n = 0; n < 2; ++n) *(LAS f32x4*)(my + ai * 128 + bj * 32 + 4 * n) = acc[ai][bj][0][n];
        }
        if (fr == 15) {
#pragma unroll
            for (int ai = 0; ai < 2; ++ai)
#pragma unroll
                for (int bj = 0; bj < 2; ++bj)
#pragma unroll
                    for (int n = 0; n < 2; ++n) *(LAS f32x4*)(my + ai * 128 + 64 + bj * 32 + 4 * n) = acc[ai][bj][3][n];
        }
        asm volatile("s_waitcnt lgkmcnt(0)" ::: "memory"); __builtin_amdgcn_s_barrier(); asm volatile("" ::: "memory");
        const unsigned chb = u.pn * 128 + wc * 32 + 8 * fq;
        const float* cw1 = cw + FF2; const float* cw2 = cw + 2 * FF2;
#pragma unroll
        for (int n = 0; n < 2; ++n) {
            const unsigned cia = (chb + 4 * n) * 4u, cig = (FF + chb + 4 * n) * 4u;
            const f32x4 wa0 = ldg<f32x4>(cw, cia), wa1 = ldg<f32x4>(cw1, cia), wa2 = ldg<f32x4>(cw2, cia), cba = ldg<f32x4>(cbias, cia);
            const f32x4 wg0 = ldg<f32x4>(cw, cig), wg1 = ldg<f32x4>(cw1, cig), wg2 = ldg<f32x4>(cw2, cig), cbg = ldg<f32x4>(cbias, cig);
#pragma unroll
            for (int ai = 0; ai < 2; ++ai) {
                const bool hasp = !(ai == 0 && wr == 0), hasn = !(ai == 1 && wr == 1);
                const LAS float* pp = xch + ((wr == 1 ? 0 : 4) + wc) * 256 + (wr == 1 ? ai : 0) * 128 + 64 + 8 * fq;
                const LAS float* pn = xch + ((wr == 0 ? 4 : 0) + wc) * 256 + (wr == 0 ? ai : 1) * 128 + 8 * fq;
                const unsigned arow = ((u.pm * 256 + ai * 128 + wr * 64 + fr) * FF + chb) * 2u;
                f32x4 sg[4];
#pragma unroll
                for (int pass = 0; pass < 2; ++pass) {
                    const int bj = 1 - pass;
                    const f32x4 w0 = pass == 0 ? wg0 : wa0, w1 = pass == 0 ? wg1 : wa1, w2 = pass == 0 ? wg2 : wa2, cb = pass == 0 ? cbg : cba;
                    f32x4 hp = (f32x4){0.f, 0.f, 0.f, 0.f}, hn = (f32x4){0.f, 0.f, 0.f, 0.f};
                    if (hasp) hp = *(const LAS f32x4*)(pp + bj * 32 + 4 * n);
                    if (hasn) hn = *(const LAS f32x4*)(pn + bj * 32 + 4 * n);
                    f32x4 prevsrc = hp;
#pragma unroll
                    for (int m = 0; m < 4; ++m) {
                        const f32x4 zc = acc[ai][bj][m][n];
                        const f32x4 nsrc = m < 3 ? acc[ai][bj][m < 3 ? m + 1 : 3][n] : hn;
                        f32x4 sp, sn;
#pragma unroll
                        for (int i = 0; i < 4; ++i) { sp[i] = fr == 15 ? prevsrc[i] : zc[i]; sn[i] = fr == 0 ? nsrc[i] : zc[i]; }
                        f32x4 res = cb + w1 * zc;
                        conv_taps(res, sp, sn, w0, w2);
                        prevsrc = zc;
                        if (pass == 0) {
#pragma unroll
                            for (int i = 0; i < 4; ++i) res[i] = silu_f(res[i]);
                            sg[m] = res;
                        } else {
                            res = res * sg[m];
                            stg<u32x2>(ACT, arow + m * (16 * FF * 2) + n * 8, (u32x2){cvt_pk_bf16(res[0], res[1]), cvt_pk_bf16(res[2], res[3])});
                        }
                    }
                }
                asm volatile("" ::: "memory");
            }
        }
    }
};

__device__ __forceinline__ int crow(int r, int hi) { return (r & 3) + 8 * (r >> 2) + 4 * hi; }
__device__ __forceinline__ void attn_unit(LAS unsigned char* lds, const bf16_t* Q, int qstride, bf16_t* O, int ostride,
                                          const bf16_t* K0, int ks0, const bf16_t* V0, int vs0, int t0lo, int nt0,
                                          const bf16_t* K1, int ks1, const bf16_t* V1, int vs1, int nt1,
                                          float m_init, float l_init, int win_q0, const int tid) {
    const int lane = tid & 63, r32 = lane & 31, hi = lane >> 5, wid = __builtin_amdgcn_readfirstlane(tid >> 6);
    const int qrow = wid * 32 + r32;
    bf16x8 qf[4];
#pragma unroll
    for (int d0 = 0; d0 < 4; ++d0) qf[d0] = *(const bf16x8*)(Q + (size_t)qrow * qstride + d0 * 16 + hi * 8);
    float mrun = m_init;
    f32x16 o0 = {}, o1 = {}, lacc, negm;
#pragma unroll
    for (int r = 0; r < 16; ++r) { lacc[r] = l_init; negm[r] = -m_init; }
    const bf16x8 ones = {0x3F80, 0x3F80, 0x3F80, 0x3F80, 0x3F80, 0x3F80, 0x3F80, 0x3F80};
    const int NT = nt0 + nt1;
    const int lrow = 8 * wid + (lane >> 3), lch = (lane & 7) ^ ((lrow >> 1) & 7);
    auto dma = [&](int t) {
        const bf16_t* kp; const bf16_t* vp;
        if (t < nt0) { kp = K0 + (size_t)((t0lo + t) * 64 + lrow) * ks0 + lch * 8; vp = V0 + (size_t)lrow * vs0 + (t0lo + t) * 64 + lch * 8; }
        else { kp = K1 + (size_t)((t - nt0) * 64 + lrow) * ks1 + lch * 8; vp = V1 + (size_t)lrow * vs1 + (t - nt0) * 64 + lch * 8; }
        LAS unsigned char* dst = lds + (t % 6) * 16384 + wid * 1024;
        __builtin_amdgcn_global_load_lds((const unsigned*)kp, (LAS unsigned*)dst, 16, 0, 0);
        __builtin_amdgcn_global_load_lds((const unsigned*)vp, (LAS unsigned*)(dst + 8192), 16, 0, 0);
    };
    const int krow = (r32 & 0x13) | ((r32 & 4) << 1) | ((r32 & 8) >> 1);
    const int koff = krow * 128 + ((hi ^ ((krow >> 1) & 7)) << 4);
    const int voff = 8192 + r32 * 128 + ((hi ^ ((r32 >> 1) & 7)) << 4);
    dma(0); if (NT > 1) dma(1); if (NT > 2) dma(2); if (NT > 3) dma(3); if (NT > 4) dma(4);
    for (int t = 0; t < NT; ++t) {
        if (t + 4 < NT) asm volatile("s_waitcnt vmcnt(8)" ::: "memory");
        else if (t + 3 < NT) asm volatile("s_waitcnt vmcnt(6)" ::: "memory");
        else if (t + 2 < NT) asm volatile("s_waitcnt vmcnt(4)" ::: "memory");
        else if (t + 1 < NT) asm volatile("s_waitcnt vmcnt(2)" ::: "memory");
        else asm volatile("s_waitcnt vmcnt(0)" ::: "memory");
        __builtin_amdgcn_s_barrier(); asm volatile("" ::: "memory");
        if (t + 5 < NT) dma(t + 5);
        bool active = true;
        int key0 = 0;
        if (win_q0 >= 0 && t < nt0) {
            key0 = (t0lo + t) * 64;
            const int qw0 = win_q0 + wid * 32;
            active = !(key0 + 63 < qw0 - 128 || key0 > qw0 + 31 + 128);
        }
        if (active) {
            const LAS unsigned char* sb = lds + (t % 6) * 16384;
            f32x16 p0 = negm, p1 = negm;
#pragma unroll
            for (int d0 = 0; d0 < 4; ++d0) {
                const bf16x8 k0 = *(const LAS bf16x8*)(sb + (koff ^ (d0 << 5)));
                const bf16x8 k1 = *(const LAS bf16x8*)(sb + (koff ^ (d0 << 5)) + 32 * 128);
                p0 = __builtin_amdgcn_mfma_f32_32x32x16_bf16(k0, qf[d0], p0, 0, 0, 0);
                p1 = __builtin_amdgcn_mfma_f32_32x32x16_bf16(k1, qf[d0], p1, 0, 0, 0);
            }
            if (win_q0 >= 0 && t < nt0) {
                const int qw0 = win_q0 + wid * 32;
                const int bb = key0 + 8 * hi - (win_q0 + qrow);
                if (key0 < qw0 + 31 - 128) {
#pragma unroll
                    for (int r = 0; r < 16; ++r) { const int c = 16 * (r >> 3) + (r & 7); if (bb < -128 - c) p0[r] = -INFINITY; if (bb < -160 - c) p1[r] = -INFINITY; }
                }
                if (key0 + 63 > qw0 + 128) {
#pragma unroll
                    for (int r = 0; r < 16; ++r) { const int c = 16 * (r >> 3) + (r & 7); if (bb > 128 - c) p0[r] = -INFINITY; if (bb > 96 - c) p1[r] = -INFINITY; }
                }
            }
            float mx = __builtin_fmaxf(__builtin_fmaxf(p0[0], p1[0]), __builtin_fmaxf(p0[1], p1[1]));
#pragma unroll
            for (int r = 2; r < 16; r += 2) mx = __builtin_fmaxf(__builtin_fmaxf(mx, p0[r]), __builtin_fmaxf(p1[r], __builtin_fmaxf(p0[r + 1], p1[r + 1])));
            mx = __builtin_fmaxf(mx, __shfl_xor(mx, 32));
            if (__any(mx > 8.0f)) {
                const float dl = mx > 8.0f ? mx : 0.f;
                const float f = __builtin_amdgcn_exp2f(-dl);
                mrun += dl;
                p0 = p0 - dl; p1 = p1 - dl; negm = negm - dl;
#pragma unroll
                for (int r = 0; r < 16; ++r) { o0[r] *= f; o1[r] *= f; lacc[r] *= f; }
            }
#pragma unroll
            for (int r = 0; r < 16; ++r) { p0[r] = __builtin_amdgcn_exp2f(p0[r]); p1[r] = __builtin_amdgcn_exp2f(p1[r]); }
            bf16x8 pw[4];
#pragma unroll
            for (int ks = 0; ks < 4; ++ks) {
                u32x4 w;
                if (ks < 2) { w.x = cvt_pk_bf16(p0[8 * ks + 0], p0[8 * ks + 1]); w.y = cvt_pk_bf16(p0[8 * ks + 2], p0[8 * ks + 3]); w.z = cvt_pk_bf16(p0[8 * ks + 4], p0[8 * ks + 5]); w.w = cvt_pk_bf16(p0[8 * ks + 6], p0[8 * ks + 7]); }
                else { const int k2 = ks - 2; w.x = cvt_pk_bf16(p1[8 * k2 + 0], p1[8 * k2 + 1]); w.y = cvt_pk_bf16(p1[8 * k2 + 2], p1[8 * k2 + 3]); w.z = cvt_pk_bf16(p1[8 * k2 + 4], p1[8 * k2 + 5]); w.w = cvt_pk_bf16(p1[8 * k2 + 6], p1[8 * k2 + 7]); }
                pw[ks] = __builtin_bit_cast(bf16x8, w);
            }
#pragma unroll
            for (int ks = 0; ks < 4; ++ks) {
                const bf16x8 va = *(const LAS bf16x8*)(sb + (voff ^ (ks << 5)));
                const bf16x8 vbb = *(const LAS bf16x8*)(sb + (voff ^ (ks << 5)) + 32 * 128);
                o0 = __builtin_amdgcn_mfma_f32_32x32x16_bf16(va, pw[ks], o0, 0, 0, 0);
                o1 = __builtin_amdgcn_mfma_f32_32x32x16_bf16(vbb, pw[ks], o1, 0, 0, 0);
                lacc = __builtin_amdgcn_mfma_f32_32x32x16_bf16(ones, pw[ks], lacc, 0, 0, 0);
            }
        }
    }
    const float inv = 1.0f / lacc[0];
    bf16_t* orow = O + (size_t)qrow * ostride;
#pragma unroll
    for (int r4 = 0; r4 < 4; ++r4) {
        u32x2 w0, w1;
        w0.x = cvt_pk_bf16(o0[4 * r4 + 0] * inv, o0[4 * r4 + 1] * inv); w0.y = cvt_pk_bf16(o0[4 * r4 + 2] * inv, o0[4 * r4 + 3] * inv);
        w1.x = cvt_pk_bf16(o1[4 * r4 + 0] * inv, o1[4 * r4 + 1] * inv); w1.y = cvt_pk_bf16(o1[4 * r4 + 2] * inv, o1[4 * r4 + 3] * inv);
        *(u32x2*)(orow + 8 * r4 + 4 * hi) = w0;
        *(u32x2*)(orow + 32 + 8 * r4 + 4 * hi) = w1;
    }
    asm volatile("s_waitcnt vmcnt(0) lgkmcnt(0)" ::: "memory"); __builtin_amdgcn_s_barrier(); asm volatile("" ::: "memory");
}

__device__ __forceinline__ void spatial_unit(LAS unsigned char* lds, int chunk, int g, const float* w_s, const float* b_s, const float* v_gain, const float* ssv, const bf16_t* VbT, bf16_t* MIX, const int tid) {
    const int lane = tid & 63, r32 = lane & 31, hi = lane >> 5, wid = __builtin_amdgcn_readfirstlane(tid >> 6);
    const int pblk = wid & 3, chalf = wid >> 2;
    const int p = 32 * pblk + r32;
    bf16x8 yf[8];
#pragma unroll
    for (int ks = 0; ks < 8; ++ks) {
        const int q = 16 * ks + 8 * hi;
        const f32x4 w0 = *(const f32x4*)(w_s + ((size_t)g * 128 + p) * 128 + q), w1 = *(const f32x4*)(w_s + ((size_t)g * 128 + p) * 128 + q + 4);
        const f32x4 s0 = *(const f32x4*)(ssv + chunk * 128 + q), s1 = *(const f32x4*)(ssv + chunk * 128 + q + 4);
        f32x4 a, b;
#pragma unroll
        for (int i = 0; i < 4; ++i) { a[i] = w0[i] * __builtin_amdgcn_rsqf(s0[i] * (1.0f / 512.0f) + EPS); b[i] = w1[i] * __builtin_amdgcn_rsqf(s1[i] * (1.0f / 512.0f) + EPS); }
        yf[ks] = __builtin_bit_cast(bf16x8, pack8(a, b));
    }
    const float bs = b_s[g * 128 + p];
    LAS float* stg = (LAS float*)(lds + wid * 8704);
#pragma unroll
    for (int cbk = 0; cbk < 2; ++cbk) {
        const int cblk = 2 * chalf + cbk;
        const bf16_t* xr = VbT + ((size_t)chunk * 512 + 128 * g + 32 * cblk + r32) * 128 + 8 * hi;
        f32x16 acc = {};
#pragma unroll
        for (int ks = 0; ks < 8; ++ks) { const bf16x8 xf = *(const bf16x8*)(xr + 16 * ks); acc = __builtin_amdgcn_mfma_f32_32x32x16_bf16(xf, yf[ks], acc, 0, 0, 0); }
#pragma unroll
        for (int r4 = 0; r4 < 4; ++r4) {
            const int c4 = 32 * cbk + 8 * r4 + 4 * hi;
            const f32x4 gn = *(const f32x4*)(v_gain + 128 * g + 64 * chalf + c4);
            *(LAS f32x4*)(stg + r32 * 68 + c4) = (f32x4){gn[0] * acc[4 * r4 + 0] + bs, gn[1] * acc[4 * r4 + 1] + bs, gn[2] * acc[4 * r4 + 2] + bs, gn[3] * acc[4 * r4 + 3] + bs};
        }
    }
    asm volatile("s_waitcnt lgkmcnt(0)" ::: "memory");
#pragma unroll
    for (int i = 0; i < 4; ++i) {
        const int prow = i * 8 + (lane >> 3), ch8 = (lane & 7) * 8;
        const f32x4 m0 = *(const LAS f32x4*)(stg + prow * 68 + ch8), m1 = *(const LAS f32x4*)(stg + prow * 68 + ch8 + 4);
        bf16_t* up = MIX + (size_t)(chunk * 128 + 32 * pblk + prow) * DM + 512 + 128 * g + 64 * chalf + ch8;
        const u32x4 uu = *(const u32x4*)up;
        f32x4 a, b;
        a[0] = __uint_as_float(uu.x << 16) * m0[0]; a[1] = __uint_as_float(uu.x & 0xffff0000u) * m0[1]; a[2] = __uint_as_float(uu.y << 16) * m0[2]; a[3] = __uint_as_float(uu.y & 0xffff0000u) * m0[3];
        b[0] = __uint_as_float(uu.z << 16) * m1[0]; b[1] = __uint_as_float(uu.z & 0xffff0000u) * m1[1]; b[2] = __uint_as_float(uu.w << 16) * m1[2]; b[3] = __uint_as_float(uu.w & 0xffff0000u) * m1[3];
        *(u32x4*)up = pack8(a, b);
    }
    asm volatile("s_waitcnt lgkmcnt(0)" ::: "memory"); __builtin_amdgcn_s_barrier(); asm volatile("" ::: "memory");
}

__device__ __forceinline__ unsigned f2bf(float f) { unsigned u = __builtin_bit_cast(unsigned, f); return (u + 0x7fffu + ((u >> 16) & 1u)) >> 16; }
__device__ __forceinline__ unsigned pk2(float lo, float hi) { return f2bf(lo) | (f2bf(hi) << 16); }
__device__ __forceinline__ float wave_sum(float v) {
#pragma unroll
    for (int o = 1; o < 64; o <<= 1) v += __shfl_xor(v, o);
    return v;
}
__device__ __forceinline__ void transpose_item(const float* W, int K, int N, bf16_t* WT, int k0, int n0, int drow, LAS float* scr, int lane) {
    float tv[32];
#pragma unroll
    for (int i = 0; i < 32; ++i) tv[i] = W[(size_t)(k0 + 2 * i + (lane >> 5)) * N + n0 + (lane & 31)];
#pragma unroll
    for (int i = 0; i < 32; ++i) scr[(2 * i + (lane >> 5)) * 33 + (lane & 31)] = tv[i];
    asm volatile("s_waitcnt lgkmcnt(0)" ::: "memory");
    const int c = lane & 7;
#pragma unroll
    for (int j = 0; j < 4; ++j) { const int n = (lane >> 3) + 8 * j; const LAS float* s = scr + (8 * c) * 33 + n;
        u32x4 o; o.x = pk2(s[0 * 33], s[1 * 33]); o.y = pk2(s[2 * 33], s[3 * 33]); o.z = pk2(s[4 * 33], s[5 * 33]); o.w = pk2(s[6 * 33], s[7 * 33]);
        *(u32x4*)(WT + (size_t)(drow + n) * K + k0 + 8 * c) = o; }
    asm volatile("s_waitcnt lgkmcnt(0)" ::: "memory");
}
__device__ __forceinline__ int perm_in(int n0) { const int pn = n0 >> 8, rem = n0 & 255; return pn * 256 + ((rem & 63) >> 5) * 128 + (rem >> 6) * 32; }
__device__ __forceinline__ int perm_up(int n0) { const int half = n0 / FF, ch = n0 % FF; return (ch >> 7) * 256 + half * 128 + (ch & 127); }


#define XB_TMO      128
#define XB_XCNT(j)  (256  + 64 * (j))
#define XB_XSUB(j)  (1280 + 64 * (j))
#define XB_XGEN(j)  (2304 + 64 * (j))
#define XB_TOP      3328
#define XB_TOPGEN   3392
#define XCD_BAR_WORDS 3456
#define XB_SPIN_CAP (1u << 18)
__device__ __forceinline__ unsigned xb_ld(unsigned* p)              { return __hip_atomic_load(p, __ATOMIC_RELAXED, __HIP_MEMORY_SCOPE_AGENT); }
__device__ __forceinline__ unsigned xb_add(unsigned* p, unsigned v) { return __hip_atomic_fetch_add(p, v, __ATOMIC_RELAXED, __HIP_MEMORY_SCOPE_AGENT); }
__device__ __forceinline__ unsigned xb_xcc_id() { return (unsigned)__builtin_amdgcn_s_getreg((3 << 11) | 20) & 0xFu; }
#define XB_SPIN(cond, bar) do { unsigned _sp = 0; while (cond) { __builtin_amdgcn_s_sleep(1); \
    if ((++_sp & 255u) == 0u) { if (xb_ld(&(bar)[XB_TMO])) break; if (_sp > XB_SPIN_CAP) { atomicAdd(&(bar)[XB_TMO], 1u); break; } } } } while (0)
struct XcdBarrier { unsigned* bar; unsigned x; volatile LAS unsigned* st; };
__device__ __forceinline__ XcdBarrier xcd_barrier_post(unsigned* bar, volatile LAS unsigned* st) {
    XcdBarrier b; b.bar = bar; b.x = xb_xcc_id(); b.st = st;
    if (threadIdx.x == 0) (void)xb_add(&bar[XB_XCNT(b.x)], 1u);
    return b;
}
__device__ __forceinline__ void xcd_barrier_complete(unsigned* bar, unsigned x, unsigned& nloc, unsigned& nx) {
    const unsigned G = gridDim.x * gridDim.y * gridDim.z;
    unsigned sum, cnt, mine, sp = 0u;
    for (;;) {
        sum = 0u; cnt = 0u; mine = 0u;
#pragma unroll
        for (unsigned j = 0; j < 16; ++j) { const unsigned c = xb_ld(&bar[XB_XCNT(j)]); sum += c; cnt += (c > 0u) ? 1u : 0u; mine = (j == x) ? c : mine; }
        if (sum == G) break;
        __builtin_amdgcn_s_sleep(1);
        if ((++sp & 255u) == 0u) { if (xb_ld(&bar[XB_TMO])) break; if (sp > XB_SPIN_CAP) { atomicAdd(&bar[XB_TMO], 1u); break; } }
    }
    nloc = mine > 0u ? mine : 1u; nx = cnt > 0u ? cnt : 1u;
}
__device__ __forceinline__ void xcd_barrier(const XcdBarrier& b) {
    asm volatile("s_waitcnt vmcnt(0)" ::: "memory");
    __syncthreads();
    if (threadIdx.x == 0) {
        unsigned* bar = b.bar;
        __builtin_amdgcn_s_waitcnt(0);
        unsigned nloc = b.st[0], nx = b.st[1];
        if (nloc == 0u) { xcd_barrier_complete(bar, b.x, nloc, nx); b.st[0] = nloc; b.st[1] = nx; }
        const unsigned old = xb_add(&bar[XB_XSUB(b.x)], 1u);
        const unsigned gen = old / nloc;
        if (old + 1u == (gen + 1u) * nloc) {
            __builtin_amdgcn_fence(__ATOMIC_RELEASE, "agent");
            asm volatile("s_waitcnt vmcnt(0)" ::: "memory");
            const unsigned og = xb_add(&bar[XB_TOP], 1u);
            const unsigned tg = og / nx;
            if (og + 1u == (tg + 1u) * nx) xb_add(&bar[XB_TOPGEN], 1u);
            else XB_SPIN(xb_ld(&bar[XB_TOPGEN]) == tg, bar);
            __builtin_amdgcn_fence(__ATOMIC_ACQUIRE, "agent");
            xb_add(&bar[XB_XGEN(b.x)], 1u);
            asm volatile("s_waitcnt vmcnt(0)" ::: "memory");
        } else {
            XB_SPIN(xb_ld(&bar[XB_XGEN(b.x)]) == gen, bar);
            __builtin_amdgcn_fence(__ATOMIC_ACQUIRE, "agent");
            asm volatile("s_waitcnt vmcnt(0)" ::: "memory");
        }
    }
    __syncthreads();
}

template <bool COOP>
__global__ void __launch_bounds__(512, 2) mk_fwd(Params P) {
    extern __shared__ __attribute__((aligned(16))) unsigned char lds_raw[];
    LAS unsigned char* lds = (LAS unsigned char*)lds_raw;
    const int tid = threadIdx.x, lane = tid & 63, wave = __builtin_amdgcn_readfirstlane(tid >> 6);
    const int G = gridDim.x, bx = blockIdx.x;
    const int gw = bx * 8 + wave, NGW = G * 8;
    unsigned char* ws = P.ws;
    float* out = P.out;
    typedef const float* cfp_t; typedef __attribute__((address_space(4))) const cfp_t* kargp_t;
#define INP(i) ({ kargp_t kp_ = (kargp_t)__builtin_amdgcn_kernarg_segment_ptr(); asm volatile("" : "+s"(kp_)); kp_[i]; })
#define out_ka (out + (size_t)MTOK * DM)
#define out_va (out + (size_t)MTOK * DM + NCTX * 128)
#define out_kc (out + (size_t)MTOK * DM + NCTX * 256)
#define out_vc (out + (size_t)MTOK * DM + NCTX * 512)
#define mod ((float*)(ws + WS_MOD))
#define ss0 ((float*)(ws + WS_SS0))
#define ss1 ((float*)(ws + WS_SS1))
#define ss2 ((float*)(ws + WS_SS2))
#define ss3 ((float*)(ws + WS_SS3))
#define ssv ((float*)(ws + WS_SSV))
#define rope ((float*)(ws + WS_ROPE))
#define biasw ((float*)(ws + WS_BIAS))
#define ZB ((float*)(ws + WS_ZB))
#define CK_A ((bf16_t*)(ws + WS_CK_A))
#define CVT_A ((bf16_t*)(ws + WS_CVT_A))
#define CK_C ((bf16_t*)(ws + WS_CK_C))
#define CVT_C ((bf16_t*)(ws + WS_CVT_C))
#define W_INE ((bf16_t*)(ws + WS_W_INE))
#define W_OUTE ((bf16_t*)(ws + WS_W_OUTE))
#define W_INO ((bf16_t*)(ws + WS_W_INO))
#define W_OUTO ((bf16_t*)(ws + WS_W_OUTO))
#define W_UP ((bf16_t*)(ws + WS_W_UP))
#define W_DN ((bf16_t*)(ws + WS_W_DN))
#define Abuf ((bf16_t*)(ws + WS_A))
#define ACT ((bf16_t*)(ws + WS_ACT))
#define MIX ((bf16_t*)(ws + WS_MIX))
#define Qb ((bf16_t*)(ws + WS_Q))
#define KE ((bf16_t*)(ws + WS_KE))
#define VTE ((bf16_t*)(ws + WS_VTE))
#define VBT ((bf16_t*)(ws + WS_VBT))
#define KO ((bf16_t*)(ws + WS_KO))
#define VTO ((bf16_t*)(ws + WS_VTO))
    LAS float* spare = (LAS float*)(lds + LDS_SPARE);

    const int lo = P.ph_lo, hi = P.ph_hi;
#define TSTAMP(k) do { if (MK_TP_LO >= 0 && blockIdx.x == 0 && threadIdx.x == 0) { if ((k) == MK_TP_LO) ((unsigned long long*)(P.ws + WS_TS))[0] = __builtin_amdgcn_s_memrealtime(); if ((k) == MK_TP_HI + 1) ((unsigned long long*)(P.ws + WS_TS))[1] = __builtin_amdgcn_s_memrealtime(); } } while (0)
    XcdBarrier xbar; xbar.bar = (unsigned*)(ws + WS_BAR); xbar.x = 0; xbar.st = (volatile LAS unsigned*)(lds + LDS_SPARE + 12288);
    if constexpr (COOP) {
        if (tid < 2) ((LAS unsigned*)(lds + LDS_SPARE + 12288))[tid] = 0u;
        __syncthreads();
        xbar = xcd_barrier_post((unsigned*)(ws + WS_BAR), (volatile LAS unsigned*)(lds + LDS_SPARE + 12288));
        if (P.ph_lo < 0) cg::this_grid().sync();
    }
#ifndef MK_PHMASK
#define MK_PHMASK 0x7fff
#endif
#define IN(k) ((((MK_PHMASK) >> (k)) & 1) && lo <= (k) && (k) < hi)
#define SEAM(k) do { if constexpr (COOP) { if (IN(k) && IN((k) + 1)) { xcd_barrier(xbar); } } } while (0)

    if constexpr (!COOP) { TSTAMP(lo); }
    if (IN(0)) {
        const float* c_in = INP(6); const float* c_ctx = INP(7); const float* w_mod = INP(8); const float* b_mod = INP(9);
        for (int it = bx; it < 2 * 24 * 16; it += G) {
            const int l = it / 384, cbk = (it % 384) / 16, ksp = it % 16;
            __syncthreads();
            for (int i = tid; i < NCOND * 64; i += 512) { const int cd = i >> 6, k = ksp * 64 + (i & 63); const float v = cd == 0 ? c_ctx[k] : c_in[(cd - 1) * DM + k]; spare[i] = v / (1.0f + __expf(-v)); }
            __syncthreads();
            const int col = cbk * 256 + (tid & 255), kh = tid >> 8;
            float a[NCOND];
#pragma unroll
            for (int cd = 0; cd < NCOND; ++cd) a[cd] = 0.f;
            const float* wp = w_mod + ((size_t)l * DM + ksp * 64 + kh * 32) * MODW + col;
#pragma unroll 1
            for (int k0 = 0; k0 < 32; k0 += 8) {
                float wv[8];
#pragma unroll
                for (int k = 0; k < 8; ++k) wv[k] = wp[(size_t)(k0 + k) * MODW];
#pragma unroll
                for (int k = 0; k < 8; ++k) {
#pragma unroll
                    for (int cd = 0; cd < NCOND; ++cd) a[cd] += spare[cd * 64 + kh * 32 + k0 + k] * wv[k]; }
            }
            const float bm = (ksp == 0 && kh == 0) ? b_mod[l * MODW + col] : 0.f;
#pragma unroll
            for (int cd = 0; cd < NCOND; ++cd) atomicAdd(mod + ((size_t)l * NCOND + cd) * MODW + col, a[cd] + bm);
        }
        __syncthreads();
        {
            const float* w_in_even = INP(10); const float* w_out_even = INP(16); const float* w_in_odd = INP(17); const float* w_out_odd = INP(21); const float* w_up = INP(22); const float* w_down = INP(25);
            LAS float* scr = (LAS float*)(lds + wave * 16384);
            constexpr int I_INE = 16 * 56, I_OUT = 16 * 32, I_INO = 16 * 48, I_UP = 16 * 176, I_DN = 44 * 32;
            constexpr int NIT = I_INE + 2 * I_OUT + I_INO + 2 * I_UP + 2 * I_DN;
            for (int it = gw; it < NIT; it += NGW) {
                int r = it;
                if (r < I_INE) { const int kb = r / 56, nb = r % 56; transpose_item(w_in_even, DM, EVEN_IN, W_INE, 64 * kb, 32 * nb, perm_in(32 * nb), scr, lane); continue; } r -= I_INE;
                if (r < I_OUT) { const int kb = r / 32, nb = r % 32; transpose_item(w_out_even, DM, DM, W_OUTE, 64 * kb, 32 * nb, 32 * nb, scr, lane); continue; } r -= I_OUT;
                if (r < I_INO) { const int kb = r / 48, nb = r % 48; transpose_item(w_in_odd, DM, ODD_IN, W_INO, 64 * kb, 32 * nb, perm_in(32 * nb), scr, lane); continue; } r -= I_INO;
                if (r < I_OUT) { const int kb = r / 32, nb = r % 32; transpose_item(w_out_odd, DM, DM, W_OUTO, 64 * kb, 32 * nb, 32 * nb, scr, lane); continue; } r -= I_OUT;
                if (r < 2 * I_UP) { const int l = r / I_UP, q = r % I_UP, kb = q / 176, nb = q % 176; transpose_item(w_up + (size_t)l * DM * FF2, DM, FF2, W_UP + (size_t)l * FF2 * DM, 64 * kb, 32 * nb, perm_up(32 * nb), scr, lane); continue; } r -= 2 * I_UP;
                { const int l = r / I_DN, q = r % I_DN, kb = q / 32, nb = q % 32; transpose_item(w_down + (size_t)l * FF * DM, FF, DM, W_DN + (size_t)l * DM * FF, 64 * kb, 32 * nb, 32 * nb, scr, lane); }
            }
        }
        {
            const float* cache_k_attn = INP(2); const float* cache_v_attn = INP(3); const float* cache_k_swa = INP(4); const float* cache_v_swa = INP(5);
            const int gt = bx * 512 + tid, NT_ = G * 512;
            for (int i = gt; i < 8 * 512 * 128 / 4; i += NT_) { const f32x4 v = *(const f32x4*)(cache_k_attn + (size_t)i * 4); *(u32x2*)(CK_A + (size_t)i * 4) = (u32x2){pk2(v[0], v[1]), pk2(v[2], v[3])}; }
            for (int i = gt; i < 8 * 512 * 256 / 4; i += NT_) { const f32x4 v = *(const f32x4*)(cache_k_swa + (size_t)i * 4); *(u32x2*)(CK_C + (size_t)i * 4) = (u32x2){pk2(v[0], v[1]), pk2(v[2], v[3])}; }
            for (int i = gt; i < 8 * 64 * 128; i += NT_) { const int cd = i & 127, pc = (i >> 7) & 63, b = i >> 13; const float* s = cache_v_attn + ((size_t)b * 512 + pc * 8) * 128 + cd;
                u32x4 o; o.x = pk2(s[0], s[128]); o.y = pk2(s[256], s[384]); o.z = pk2(s[512], s[640]); o.w = pk2(s[768], s[896]);
                *(u32x4*)(CVT_A + ((size_t)b * 128 + cd) * 512 + pc * 8) = o; }
            for (int i = gt; i < 8 * 64 * 256; i += NT_) { const int cd = i & 255, pc = (i >> 8) & 63, b = i >> 14; const float* s = cache_v_swa + ((size_t)b * 512 + pc * 8) * 256 + cd;
                u32x4 o; o.x = pk2(s[0], s[256]); o.y = pk2(s[512], s[768]); o.z = pk2(s[1024], s[1280]); o.w = pk2(s[1536], s[1792]);
                *(u32x4*)(CVT_C + ((size_t)b * 256 + cd) * 512 + pc * 8) = o; }
            if (gt < 1024) { const int pos = gt >> 4, f = gt & 15; const float inv = exp2f(-(float)f * (13.287712379549449f / 16.0f)); const float ang = (float)pos * inv;
                rope[gt * 2] = cosf(ang); rope[gt * 2 + 1] = sinf(ang); }
        }
    }
    SEAM(0);
    if (IN(1)) {
        const float* x_prompt = INP(0); const float* x_sample = INP(1);
        for (int row0 = gw; row0 < MTOK; row0 += 2 * NGW) {
            f32x4 v[2][4]; float sq[2];
#pragma unroll
            for (int u = 0; u < 2; ++u) {
                const int row = row0 + u * NGW; sq[u] = 0.f;
                if (row < MTOK) {
                    const float* xr = row < NCTX ? x_prompt + (size_t)row * DM : x_sample + (size_t)(row - NCTX) * DM;
#pragma unroll
                    for (int j = 0; j < 4; ++j) v[u][j] = *(const f32x4*)(xr + 256 * j + 4 * lane);
                }
            }
#pragma unroll
            for (int u = 0; u < 2; ++u) {
                if (row0 + u * NGW < MTOK) {
#pragma unroll
                    for (int j = 0; j < 4; ++j) sq[u] += (v[u][j][0] * v[u][j][0] + v[u][j][1] * v[u][j][1]) + (v[u][j][2] * v[u][j][2] + v[u][j][3] * v[u][j][3]);
                }
            }
#pragma unroll
            for (int o = 1; o < 64; o <<= 1) { sq[0] += __shfl_xor(sq[0], o); sq[1] += __shfl_xor(sq[1], o); }
#pragma unroll
            for (int u = 0; u < 2; ++u) {
                const int row = row0 + u * NGW;
                if (row < MTOK) {
                    const int cond = row < NCTX ? 0 : 1 + ((row - NCTX) >> 11);
                    const float* sc = mod + (size_t)cond * MODW + 1024;
                    if (lane == 0) ss0[row] = sq[u];
#pragma unroll
                    for (int j = 0; j < 4; ++j) { const f32x4 s4 = *(const f32x4*)(sc + 256 * j + 4 * lane); const f32x4 h = v[u][j] * (s4 + 1.0f);
                        *(u32x2*)(Abuf + (size_t)row * DM + 256 * j + 4 * lane) = (u32x2){cvt_pk_bf16(h[0], h[1]), cvt_pk_bf16(h[2], h[3])}; }
                }
            }
        }
        constexpr int NB0 = 1792 / 16, NB1 = 5632 / 16, NB2 = 1536 / 16, NBT = NB0 + 2 * NB1 + NB2;
        for (int it = gw; it < NCOND * NBT; it += NGW) {
            const int cond = it / NBT; int r = it % NBT;
            const bf16_t* Wt; const float* sh; float* dst; int N;
            if (r < NB0) { Wt = W_INE; sh = mod + (size_t)cond * MODW; dst = biasw + BIAS_INE; N = 1792; }
            else if ((r -= NB0) < NB1) { Wt = W_UP; sh = mod + (size_t)cond * MODW + 3072; dst = biasw + BIAS_UP0; N = 5632; }
            else if ((r -= NB1) < NB2) { Wt = W_INO; sh = mod + (size_t)(NCOND + cond) * MODW; dst = biasw + BIAS_INO; N = 1536; }
            else { r -= NB2; Wt = W_UP + (size_t)FF2 * DM; sh = mod + (size_t)(NCOND + cond) * MODW + 3072; dst = biasw + BIAS_UP1; N = 5632; }
            float sv[16];
#pragma unroll
            for (int j = 0; j < 4; ++j) { const f32x4 t4 = *(const f32x4*)(sh + 16 * lane + 4 * j); sv[4 * j] = t4[0]; sv[4 * j + 1] = t4[1]; sv[4 * j + 2] = t4[2]; sv[4 * j + 3] = t4[3]; }
            for (int n = 0; n < 16; n += 8) {
                float d[8];
#pragma unroll
                for (int q = 0; q < 8; ++q) {
                    const bf16_t* wr_ = Wt + (size_t)(r * 16 + n + q) * DM + 16 * lane;
                    const u32x4 w0 = *(const u32x4*)wr_, w1 = *(const u32x4*)(wr_ + 8);
                    float dd = 0.f;
#pragma unroll
                    for (int j = 0; j < 4; ++j) { dd += sv[2 * j] * __uint_as_float(w0[j] << 16) + sv[2 * j + 1] * __uint_as_float(w0[j] & 0xffff0000u); dd += sv[8 + 2 * j] * __uint_as_float(w1[j] << 16) + sv[8 + 2 * j + 1] * __uint_as_float(w1[j] & 0xffff0000u); }
                    d[q] = dd;
                }
#pragma unroll
                for (int o = 1; o < 64; o <<= 1) {
#pragma unroll
                    for (int q = 0; q < 8; ++q) d[q] += __shfl_xor(d[q], o);
                }
                if (lane == 0) {
#pragma unroll
                    for (int q = 0; q < 8; ++q) dst[(size_t)cond * N + r * 16 + n + q] = d[q];
                }
            }
        }
    }
    SEAM(1);
    pg8::StaticOrder S;
    for (int ph = (lo > 2 ? lo : 2); ph < hi; ++ph) {
        if (((MK_PHMASK >> ph) & 1) != 0) {
#pragma unroll 1
        for (int slot_ = 0; slot_ < 3; ++slot_) {
            const int slot = ((ph == 4 || ph == 10) && (bx & 1) && slot_ < 2) ? 1 - slot_ : slot_;
            int st = -1, pm0 = 32, nM = 64, c0 = 0, nc = G;
            const bool g256 = (G == 256);
            switch (ph * 4 + slot) {
                case 2 * 4 + 0: st = 0; break;
                case 2 * 4 + 1: st = 0; pm0 = 0; nM = 9; if (g256) { c0 = 192; nc = 64; } break;
                case 3 * 4 + 0: st = 1; break;
                case 3 * 4 + 1: st = 0; pm0 = 9; nM = 23; if (g256) nc = 168; break;
                case 4 * 4 + 0: st = 2; break;
                case 4 * 4 + 1: st = 1; pm0 = 0; nM = 32; break;
                case 5 * 4 + 0: st = 3; break;
                case 5 * 4 + 1: st = 2; pm0 = 0; nM = 32; if (g256) { c0 = 128; nc = 128; } break;
                case 6 * 4 + 0: st = 4; break;
                case 7 * 4 + 0: st = 5; break;
                case 7 * 4 + 1: st = 3; pm0 = 0; nM = 32; break;
                case 8 * 4 + 0: st = 6; if (g256) { c0 = 128; nc = 128; } break;
                case 8 * 4 + 1: st = 5; pm0 = 0; nM = 32; if (g256) nc = 128; break;
                case 9 * 4 + 0: st = 7; break;
                case 9 * 4 + 1: st = 6; pm0 = 0; nM = 32; if (g256) nc = 192; break;
                case 10 * 4 + 0: st = 8; break;
                case 10 * 4 + 1: st = 7; pm0 = 0; nM = 32; break;
                case 11 * 4 + 0: st = 9; break;
                case 11 * 4 + 1: st = 8; pm0 = 0; nM = 32; if (g256) { c0 = 128; nc = 128; } break;
                case 12 * 4 + 0: st = 10; break;
                case 13 * 4 + 0: st = 11; pm0 = 32; nM = 32; if (g256) { c0 = 128; nc = 128; } break;
                case 13 * 4 + 1: st = 9; pm0 = 0; nM = 23; if (g256) nc = 128; break;
                case 13 * 4 + 2: st = 9; pm0 = 23; nM = 9; if (g256) { c0 = 128; nc = 128; } break;
                case 14 * 4 + 0: st = 11; pm0 = 64; nM = 32; if (g256) { c0 = 128; nc = 128; } break;
                case 14 * 4 + 1: st = 11; pm0 = 0; nM = 32; if (g256) nc = 128; break;
                default: break;
            }
            const bool lat = pm0 >= 32;
            if (st < 0) continue;
            unsigned char* ws = P.ws; asm volatile("" : "+s"(ws));
            float* out = P.out; asm volatile("" : "+s"(out));
            int tid = threadIdx.x; asm volatile("" : "+v"(tid));
            LAS unsigned char* lds = (LAS unsigned char*)lds_raw; { unsigned l_ = (unsigned)(uintptr_t)lds; asm volatile("" : "+s"(l_)); lds = (LAS unsigned char*)(uintptr_t)l_; }
            LAS float* spare = (LAS float*)(lds + LDS_SPARE);
            const int rel = (bx - c0 + G) % G;
            const int L = st >= 6 ? 1 : 0;
            float* modL = mod + (size_t)L * NCOND * MODW;
            if (st == 0) {
                pg8::Gemm g{Abuf, W_INE, MTOK, EVEN_IN, DM}; S.init(pm0, nM, EVEN_IN, G, bx, c0, nc);
                EpiIn<true> E{ws, out, INP(11), INP(12)};
                pg8::gemm_phase<EpiIn<true>, true>(lds, g, S, E, tid);
            } else if (st == 6) {
                pg8::Gemm g{Abuf, W_INO, MTOK, ODD_IN, DM}; S.init(pm0, nM, ODD_IN, G, bx, c0, nc);
                EpiIn<false> E{ws, out, INP(18), INP(19)};
                pg8::gemm_phase<EpiIn<false>, true>(lds, g, S, E, tid);
            } else if (st == 2 || st == 5 || st == 8 || st == 11) {
                const bool dn = (st == 5 || st == 11);
                pg8::Gemm g{dn ? ACT : MIX, dn ? W_DN + (size_t)L * DM * FF : (L ? W_OUTO : W_OUTE), MTOK, DM, dn ? FF : DM}; S.init(pm0, nM, DM, G, bx, c0, nc);
                EpiRes E;
                if (st == 2) { E.xp = INP(0); E.xs = INP(1); } else { E.xp = out; E.xs = out + (size_t)NCTX * DM; }
                E.out = out; E.gate = modL + (dn ? 5120 : 2048);
                E.nscale = st == 11 ? nullptr : (dn ? mod + (size_t)NCOND * MODW + 1024 : modL + 4096);
                E.An = st == 11 ? nullptr : Abuf;
                E.ssn = st == 2 ? ss1 : st == 5 ? ss2 : st == 8 ? ss3 : nullptr;
                pg8::gemm_phase<EpiRes, true>(lds, g, S, E, tid);
            } else if (st == 3 || st == 9) {
                pg8::Gemm g{Abuf, W_UP + (size_t)L * FF2 * DM, MTOK, FF2, DM}; S.init(pm0, nM, FF2, G, bx, c0, nc);
                EpiUp E{ws, (unsigned)(L ? WS_SS3 : WS_SS1), (unsigned)(L ? BIAS_UP1 : BIAS_UP0), INP(23) + (size_t)L * 3 * FF2, INP(24) + (size_t)L * FF2, spare};
                pg8::gemm_phase<EpiUp, true>(lds, g, S, E, tid);
            } else if (st == 4 || st == 10) {
                if (lat) {
                    const float* cw = INP(23) + (size_t)L * 3 * FF2; const float* cb = INP(24) + (size_t)L * FF2;
                    for (int i = bx * 512 + tid; i < 8 * 7 * 2 * FF; i += G * 512) {
                        const int ch = i % FF, rs = i / FF, which = rs & 1, sm = (rs >> 1) % 7, b = rs / 14;
                        const int pmA = 32 + b * 8 + sm;
                        const int zc = (ch >> 7) * 256 + (ch & 127);
                        const float* zA = ZB + (size_t)pmA * 4 * FF2; const float* zB = ZB + (size_t)(pmA + 1) * 4 * FF2;
                        float ra, rg;
                        if (which == 0) {
                            ra = cb[ch] + cw[ch] * zA[2 * FF2 + zc] + cw[FF2 + ch] * zA[3 * FF2 + zc] + cw[2 * FF2 + ch] * zB[zc];
                            rg = cb[FF + ch] + cw[FF + ch] * zA[2 * FF2 + zc + 128] + cw[FF2 + FF + ch] * zA[3 * FF2 + zc + 128] + cw[2 * FF2 + FF + ch] * zB[zc + 128];
                        } else {
                            ra = cb[ch] + cw[ch] * zA[3 * FF2 + zc] + cw[FF2 + ch] * zB[zc] + cw[2 * FF2 + ch] * zB[FF2 + zc];
                            rg = cb[FF + ch] + cw[FF + ch] * zA[3 * FF2 + zc + 128] + cw[FF2 + FF + ch] * zB[zc + 128] + cw[2 * FF2 + FF + ch] * zB[FF2 + zc + 128];
                        }
                        const int row = pmA * 256 + 255 + which;
                        ACT[(size_t)row * FF + ch] = (bf16_t)(cvt_pk_bf16(ra * silu_f(rg), 0.f) & 0xffffu);
                    }
                }
            } else if (st == 1) {
                const float* w_spatial = INP(14); const float* b_spatial = INP(15); const float* v_norm_b = INP(13);
                if (lat) {
                    for (int it = rel; it < 512; it += nc) {
                        const int b = it >> 6, h = (it >> 3) & 7, qb = it & 7, kvh = h >> 2;
                        const size_t row0 = NCTX + (size_t)b * 2048 + qb * 256;
                        attn_unit(lds, Qb + row0 * 512 + h * 64, 512, MIX + row0 * DM + h * 64, DM,
                                  KE + ((size_t)NCTX + (size_t)b * 2048) * 128 + kvh * 64, 128, VTE + (size_t)NCTX * 128 + (size_t)(b * 2 + kvh) * 64 * 2048, 2048, 0, 32,
                                  CK_A + (size_t)b * 512 * 128 + kvh * 64, 128, CVT_A + (size_t)(b * 2 + kvh) * 64 * 512, 512, 8, 0.f, 0.f, -1, tid);
                    }
                    if (G == 256) {
                        if (bx >= 168) { for (int j = 0; j < 4; ++j) { const int e = (bx - 168) * 4 + j; spatial_unit(lds, 64 + (e >> 2), e & 3, w_spatial, b_spatial, v_norm_b, ssv, VBT, MIX, tid); } }
                        else if (bx < 160) { const int e = 352 + bx; spatial_unit(lds, 64 + (e >> 2), e & 3, w_spatial, b_spatial, v_norm_b, ssv, VBT, MIX, tid); }
                    } else {
                        for (int e = rel; e < 512; e += nc) spatial_unit(lds, 64 + (e >> 2), e & 3, w_spatial, b_spatial, v_norm_b, ssv, VBT, MIX, tid);
                    }
                } else {
                    for (int it = rel; it < 256 + 256; it += nc) {
                        if (it < 256) {
                            const int b = it >> 3, h = it & 7, kvh = h >> 2;
                            const size_t row0 = (size_t)b * 256;
                            attn_unit(lds, Qb + row0 * 512 + h * 64, 512, MIX + row0 * DM + h * 64, DM,
                                      KE + row0 * 128 + kvh * 64, 128, VTE + (size_t)(b * 2 + kvh) * 64 * 256, 256, 0, 4,
                                      nullptr, 0, nullptr, 0, 0, 0.f, 0.f, -1, tid);
                        } else { const int e = it - 256; spatial_unit(lds, e >> 2, e & 3, w_spatial, b_spatial, v_norm_b, ssv, VBT, MIX, tid); }
                    }
                }
            } else if (st == 7) {
                const float* sink_c = INP(20);
                if (lat) {
                    for (int it = rel; it < 1024; it += nc) {
                        const int b = it >> 7, h = (it >> 3) & 15, qb = it & 7, kvh = h >> 2;
                        const size_t row0 = NCTX + (size_t)b * 2048 + qb * 256;
                        const int q0 = qb * 256; int klo = q0 - 128; if (klo < 0) klo = 0; int khi = q0 + 384; if (khi > 2048) khi = 2048;
                        attn_unit(lds, Qb + row0 * 1024 + h * 64, 1024, MIX + row0 * DM + h * 64, DM,
                                  KO + ((size_t)NCTX + (size_t)b * 2048) * 256 + kvh * 64, 256, VTO + (size_t)NCTX * 256 + (size_t)(b * 4 + kvh) * 64 * 2048, 2048, klo >> 6, (khi - klo) >> 6,
                                  CK_C + (size_t)b * 512 * 256 + kvh * 64, 256, CVT_C + (size_t)(b * 4 + kvh) * 64 * 512, 512, 8, sink_c[h] * LOG2E, 1.0f, q0, tid);
                    }
                } else {
                    for (int it = rel; it < 512; it += nc) {
                        const int b = it >> 4, h = it & 15, kvh = h >> 2;
                        const size_t row0 = (size_t)b * 256;
                        attn_unit(lds, Qb + row0 * 1024 + h * 64, 1024, MIX + row0 * DM + h * 64, DM,
                                  KO + row0 * 256 + kvh * 64, 256, VTO + (size_t)(b * 4 + kvh) * 64 * 256, 256, 0, 4,
                                  nullptr, 0, nullptr, 0, 0, sink_c[h] * LOG2E, 1.0f, -1, tid);
                    }
                }
            }
        }
        }
        if constexpr (COOP) {
            if (ph + 1 < hi) { XcdBarrier xb = xbar; asm volatile("" : "+s"(xb.bar), "+s"(xb.x)); xcd_barrier(xb); }
        }
    }
    if (!COOP && MK_TP_LO >= 0 && lo == 14 && blockIdx.x == 0 && threadIdx.x == 0) {
        const unsigned long long* ts = (const unsigned long long*)(P.ws + WS_TS);
        float* o = P.out + (size_t)MTOK * DM;
        o[0] += (float)(ts[1] - ts[0]) * 1e-4f;
    }
#undef IN
#undef SEAM
}

constexpr int N_PHASES = 15;

extern "C" void kernel_launch(void* const* d_in, const int* in_sizes, int n_in, void* d_out, int out_size, void* d_ws, size_t ws_size, hipStream_t stream) {
    static int grid = 0;
    if (grid == 0) {
        int dev = 0, cus = 0;
        hipGetDevice(&dev);
        hipDeviceGetAttribute(&cus, hipDeviceAttributeMultiprocessorCount, dev);
        hipFuncSetAttribute((const void*)mk_fwd<true>, hipFuncAttributeMaxDynamicSharedMemorySize, LDS_BYTES);
        hipFuncSetAttribute((const void*)mk_fwd<false>, hipFuncAttributeMaxDynamicSharedMemorySize, LDS_BYTES);
        int per_cu = 0;
        hipOccupancyMaxActiveBlocksPerMultiprocessor(&per_cu, (const void*)mk_fwd<true>, 512, LDS_BYTES);
        (void)hipGetLastError();
        if (per_cu < 1) fprintf(stderr, "kernel_launch: occupancy query says %d blocks/CU\n", per_cu);
        grid = cus > 0 ? cus : 256;
        if (n_in != 26 || ws_size < WS_END) { fprintf(stderr, "kernel_launch: unexpected n_in %d / ws %zu\n", n_in, ws_size); }
    }
    hipMemsetAsync((char*)d_ws, 0, WS_ZERO_BYTES, stream);
    Params p{};
    for (int i = 0; i < 26; ++i) p.in[i] = (const float*)d_in[i];
    p.out = (float*)d_out; p.ws = (unsigned char*)d_ws;
#if MK_COOP
    p.ph_lo = 0; p.ph_hi = N_PHASES;
    void* args[] = {&p};
    hipError_t e = hipLaunchCooperativeKernel((const void*)mk_fwd<true>, dim3(grid), dim3(512), args, LDS_BYTES, stream);
    if (e != hipSuccess) fprintf(stderr, "cooperative launch failed: %s (grid %d)\n", hipGetErrorString(e), grid);
#else
    for (int ph = 0; ph < N_PHASES; ++ph) {
        p.ph_lo = ph; p.ph_hi = ph + 1;
        hipLaunchKernelGGL(mk_fwd<false>, dim3(grid), dim3(512), LDS_BYTES, stream, p);
        if (ph == MK_DUP) hipLaunchKernelGGL(mk_fwd<false>, dim3(grid), dim3(512), LDS_BYTES, stream, p);
    }
#endif
}
```
